# Optimizing an MI355X kernel written in HIP

```python
import math
import jax, jax.numpy as jnp
from jax import lax
import numpy as np


D_MODEL = 1024
BATCH = 8
SEQ = 4096
DEPTH = 1

D_INNER = 2 * D_MODEL
ATTN_HEADS = 16
ATTN_HEAD_DIM = 64
D_ATTN = ATTN_HEADS * ATTN_HEAD_DIM
DILATED_PATTERNS = ((128, 1), (512, 4), (2048, 16))
ATTN_BLOCK = 128
D_SSM = D_INNER - D_ATTN
SSM_HEAD_DIM = 64
SSM_HEADS = D_SSM // SSM_HEAD_DIM
SSM_GROUPS = 2
D_STATE = 128
CONV_K = 4
CHUNK = 128
D_CONV = D_SSM + 2 * SSM_GROUPS * D_STATE
D_IN_PROJ = 4 * D_ATTN + D_SSM + D_CONV + SSM_HEADS
NORM_EPS = 1e-6
DT_MIN = 1e-3
DT_MAX = 1e-1

kernel_name = 'hymba_dilated_attn_mamba2_hybrid'


def rms_norm(x, w):
    xf = x.astype(jnp.float32)
    y = xf * lax.rsqrt(jnp.mean(xf * xf, axis=-1, keepdims=True) + NORM_EPS)
    return (y * w.astype(jnp.float32)).astype(x.dtype)


def dilated_window_attention(q, k, v, window, dilation):
    b, s, h, dh = q.shape
    n = s // dilation
    nb = -(-n // ATTN_BLOCK)
    n_pad = nb * ATTN_BLOCK
    span = window // dilation

    def to_sub(t):
        t = t.reshape(b, n, dilation, h, dh).transpose(0, 2, 3, 1, 4)
        t = jnp.pad(t, ((0, 0), (0, 0), (0, 0), (0, n_pad - n), (0, 0)))
        return t.reshape(b, dilation, h, nb, ATTN_BLOCK, dh)

    def with_prev(t):
        prev = jnp.pad(t, ((0, 0), (0, 0), (0, 0), (1, 0), (0, 0), (0, 0)))[:, :, :, :-1]
        return jnp.concatenate([prev, t], axis=4)

    qb = to_sub(q)
    kw = with_prev(to_sub(k))
    vw = with_prev(to_sub(v))
    scores = jnp.einsum('bdhnqc,bdhnkc->bdhnqk', qb, kw, preferred_element_type=jnp.float32)

    qi = jnp.arange(ATTN_BLOCK)[:, None]
    kj = jnp.arange(2 * ATTN_BLOCK)[None, :]
    dist = ATTN_BLOCK + qi - kj
    key_idx = jnp.arange(nb)[:, None, None] * ATTN_BLOCK - ATTN_BLOCK + kj[None]
    valid = (dist >= 0) & (dist <= span) & (key_idx >= 0)
    scores = jnp.where(valid, scores, -jnp.inf)

    m = jnp.max(scores, axis=-1, keepdims=True)
    p = jnp.exp(scores - m)
    l = jnp.sum(p, axis=-1, keepdims=True)
    o = jnp.einsum('bdhnqk,bdhnkc->bdhnqc', p, vw.astype(jnp.float32)) / l
    lse = (m + jnp.log(l))[..., 0]

    o = o.reshape(b, dilation, h, n_pad, dh)[:, :, :, :n].transpose(0, 3, 1, 2, 4).reshape(b, s, h, dh)
    lse = lse.reshape(b, dilation, h, n_pad)[:, :, :, :n].transpose(0, 3, 1, 2).reshape(b, s, h)
    return o, lse


def mixture_of_dilations(q, k, v):
    outs, lses = [], []
    for window, dilation in DILATED_PATTERNS:
        o, lse = dilated_window_attention(q, k, v, window, dilation)
        outs.append(o)
        lses.append(lse)
    weights = jax.nn.softmax(jnp.stack(lses), axis=0)
    return jnp.einsum('pbsh,pbshd->bshd', weights, jnp.stack(outs))


def causal_depthwise_conv(x, w, bias):
    c = x.shape[-1]
    y = lax.conv_general_dilated(
        x, w[:, None, :].astype(x.dtype), window_strides=(1,), padding=[(CONV_K - 1, 0)],
        dimension_numbers=('NWC', 'WIO', 'NWC'), feature_group_count=c)
    return y + bias.astype(x.dtype)


def ssd_chunked(x, dt, a, b_mat, c_mat):
    bsz, s, h, p = x.shape
    g = SSM_GROUPS
    e = h // g
    n = b_mat.shape[-1]
    nc = s // CHUNK
    xdt = (x.astype(jnp.float32) * dt[..., None]).reshape(bsz, nc, CHUNK, g, e, p)
    a_dt = (dt * a).reshape(bsz, nc, CHUNK, g, e).transpose(0, 3, 4, 1, 2)
    bc = b_mat.astype(jnp.float32).reshape(bsz, nc, CHUNK, g, n)
    cc = c_mat.astype(jnp.float32).reshape(bsz, nc, CHUNK, g, n)
    a_cs = jnp.cumsum(a_dt, axis=-1)

    causal = jnp.tril(jnp.ones((CHUNK, CHUNK), dtype=bool))
    seg = a_cs[..., :, None] - a_cs[..., None, :]
    decay = jnp.exp(jnp.where(causal, seg, -jnp.inf))
    cb = jnp.einsum('bclgn,bcsgn->bgcls', cc, bc)
    y_diag = jnp.einsum('bgecls,bcsgep->bclgep', cb[:, :, None] * decay, xdt)

    decay_states = jnp.exp(a_cs[..., -1:] - a_cs)
    states = jnp.einsum('bclgn,bgecl,bclgep->bcgepn', bc, decay_states, xdt)

    chunk_decay = jnp.exp(a_cs[..., -1])

    def step(h_prev, inp):
        st, dec = inp
        return h_prev * dec[..., None, None] + st, h_prev

    init = jnp.zeros((bsz, g, e, p, n), jnp.float32)
    _, prev = lax.scan(step, init, (states.transpose(1, 0, 2, 3, 4, 5), chunk_decay.transpose(3, 0, 1, 2)))
    prev = prev.transpose(1, 0, 2, 3, 4, 5)

    y_off = jnp.einsum('bclgn,bcgepn,bgecl->bclgep', cc, prev, jnp.exp(a_cs))
    return (y_diag + y_off).reshape(bsz, s, h, p)


def gated_group_rms_norm(y, z, w):
    yz = y.astype(jnp.float32) * jax.nn.silu(z.astype(jnp.float32))
    shp = yz.shape
    yz = yz.reshape(shp[:-1] + (SSM_GROUPS, shp[-1] // SSM_GROUPS))
    yz = yz * lax.rsqrt(jnp.mean(yz * yz, axis=-1, keepdims=True) + NORM_EPS)
    return yz.reshape(shp) * w.astype(jnp.float32)


def hybrid_layer(hid, norm_pre_w, w_in, conv_w, conv_b, dt_bias, a_log, d_skip, ssm_norm_w, w_out, norm_post_w):
    bsz, s, _ = hid.shape
    u = rms_norm(hid, norm_pre_w)
    proj = jnp.einsum('bsd,de->bse', u, w_in.astype(u.dtype))
    sizes = [D_ATTN, D_ATTN, D_ATTN, D_ATTN, D_SSM, D_CONV]
    q, k, v, g_attn, z, xbc, dt_raw = jnp.split(proj, np.cumsum(sizes).tolist(), axis=-1)

    q = q.reshape(bsz, s, ATTN_HEADS, ATTN_HEAD_DIM) * (ATTN_HEAD_DIM ** -0.5)
    k = k.reshape(bsz, s, ATTN_HEADS, ATTN_HEAD_DIM)
    v = v.reshape(bsz, s, ATTN_HEADS, ATTN_HEAD_DIM)
    attn = mixture_of_dilations(q, k, v).reshape(bsz, s, D_ATTN)
    attn = attn * jax.nn.silu(g_attn.astype(jnp.float32))

    xbc = jax.nn.silu(causal_depthwise_conv(xbc, conv_w, conv_b))
    xs, b_mat, c_mat = jnp.split(xbc, [D_SSM, D_SSM + SSM_GROUPS * D_STATE], axis=-1)
    xs = xs.reshape(bsz, s, SSM_HEADS, SSM_HEAD_DIM)
    b_mat = b_mat.reshape(bsz, s, SSM_GROUPS, D_STATE)
    c_mat = c_mat.reshape(bsz, s, SSM_GROUPS, D_STATE)
    dt = jax.nn.softplus(dt_raw.astype(jnp.float32) + dt_bias.astype(jnp.float32))
    a = -jnp.exp(a_log.astype(jnp.float32))
    y = ssd_chunked(xs, dt, a, b_mat, c_mat) + d_skip.astype(jnp.float32)[:, None] * xs.astype(jnp.float32)
    y = gated_group_rms_norm(y.reshape(bsz, s, D_SSM), z, ssm_norm_w)

    mix = jnp.concatenate([attn, y], axis=-1).astype(hid.dtype)
    out = jnp.einsum('bse,ed->bsd', mix, w_out.astype(mix.dtype))
    return hid + rms_norm(out, norm_post_w)


def setup_inputs(seed: int = 0) -> dict:
    key = jax.random.key(seed)
    ks = jax.random.split(key, 12)
    f32 = jnp.float32
    x = jax.random.normal(ks[0], (BATCH, SEQ, D_MODEL), f32)
    norm_pre_w = 1.0 + 0.1 * jax.random.normal(ks[1], (DEPTH, D_MODEL), f32)
    w_in = jax.random.normal(ks[2], (DEPTH, D_MODEL, D_IN_PROJ), f32) * D_MODEL ** -0.5
    conv_w = jax.random.normal(ks[3], (DEPTH, CONV_K, D_CONV), f32) * CONV_K ** -0.5
    conv_b = 0.02 * jax.random.normal(ks[4], (DEPTH, D_CONV), f32)
    dt0 = jnp.exp(jax.random.uniform(ks[5], (DEPTH, SSM_HEADS), f32, math.log(DT_MIN), math.log(DT_MAX)))
    dt_bias = dt0 + jnp.log(-jnp.expm1(-dt0))
    a_log = jnp.log(jax.random.uniform(ks[6], (DEPTH, SSM_HEADS), f32, 1.0, 16.0))
    d_skip = 1.0 + 0.1 * jax.random.normal(ks[7], (DEPTH, SSM_HEADS), f32)
    ssm_norm_w = 1.0 + 0.1 * jax.random.normal(ks[8], (DEPTH, D_SSM), f32)
    w_out = jax.random.normal(ks[9], (DEPTH, D_INNER, D_MODEL), f32) * D_INNER ** -0.5
    norm_post_w = 1.0 + 0.1 * jax.random.normal(ks[10], (DEPTH, D_MODEL), f32)
    return {'x': x, 'norm_pre_w': norm_pre_w, 'w_in': w_in, 'conv_w': conv_w, 'conv_b': conv_b,
            'dt_bias': dt_bias, 'a_log': a_log, 'd_skip': d_skip, 'ssm_norm_w': ssm_norm_w,
            'w_out': w_out, 'norm_post_w': norm_post_w}


def reference(x, norm_pre_w, w_in, conv_w, conv_b, dt_bias, a_log, d_skip, ssm_norm_w, w_out, norm_post_w):
    hid = x
    for layer in range(DEPTH):
        hid = hybrid_layer(hid, norm_pre_w[layer], w_in[layer], conv_w[layer], conv_b[layer],
                           dt_bias[layer], a_log[layer], d_skip[layer], ssm_norm_w[layer],
                           w_out[layer], norm_post_w[layer])
    return hid
```

```cpp
#include <hip/hip_runtime.h>
#include <hip/hip_cooperative_groups.h>
#include <cstdio>
#include <cstdint>
namespace cg = cooperative_groups;
namespace pg8 {
#define PG8_LAS __attribute__((address_space(3)))
typedef unsigned short bf16_t;
typedef short bf16x8 __attribute__((ext_vector_type(8)));
typedef float f32x4 __attribute__((ext_vector_type(4)));
typedef unsigned u32x4 __attribute__((ext_vector_type(4)));
constexpr int BM = 256, BK = 64, HALF = 128, HTB = HALF * BK * 2  , STAGE_BYTES = 8 * HTB, NXCD = 8, WGM = 8;

__host__ __device__ __forceinline__ int lds_byte(int r, int c) { const int st = (r >> 4) * 2 + (c >> 5), rr = r & 15, cc = c & 31, ob = rr * 64 + cc * 2; return st * 1024 + (ob ^ (((ob >> 9) & 1) << 5)); }
__host__ __device__ __forceinline__ void stage_rc(int b, int& R, int& C) { const int st = b / 1024, sb = b % 1024, swz = sb ^ (((sb >> 9) & 1) << 5); R = (st >> 1) * 16 + swz / 64; C = (st & 1) * 32 + (swz % 64) / 2; }
__host__ __device__ __forceinline__ int perm32(int rho) { const int n = rho >> 4, i = rho & 15; return 8 * (i >> 2) + 4 * n + (i & 3); }

struct Unit { int pm, pn; };
struct Gemm { const bf16_t* A; const bf16_t* Bt; int M, N, K; };

struct StaticOrder {
    int nM, nN, nwg, G, c;
    __host__ __device__ void init(int M, int N, int G_, int c_) { nM = M / BM; nN = N / BM; nwg = nM * nN; G = G_; c = c_; }
    __host__ __device__ bool next(int i, Unit& u) const {
        const long L = (long)i * G + c; if (L >= nwg) return false;
        int wgid = (int)L; { const int q = nwg / NXCD, r = nwg % NXCD, xcd = wgid % NXCD, off = wgid / NXCD; wgid = (xcd < r ? xcd * (q + 1) : r * (q + 1) + (xcd - r) * q) + off; }
        const int nig = WGM * nN, gid = wgid / nig, fm = gid * WGM, gsz = (nM - fm) < WGM ? (nM - fm) : WGM;
        u.pm = fm + ((wgid % nig) % gsz); u.pn = (wgid % nig) / gsz; return true;
    }
    __device__ __forceinline__ void a_ready(const Unit&) const {}
    __device__ __forceinline__ void done(const Unit&) const {}
};

__device__ __forceinline__ unsigned cvt_pk_bf16(float lo, float hi) { unsigned r; asm volatile("v_cvt_pk_bf16_f32 %0, %1, %2" : "=v"(r) : "v"(lo), "v"(hi)); return r; }
template <class Epi, class Sched, bool ALIGN_EPI = false, bool SP2 = false>
__device__ __forceinline__ void gemm_phase(PG8_LAS unsigned char* lds, const Gemm g, const Sched& S, const Epi& E) {
    const int tid = threadIdx.x, wid = __builtin_amdgcn_readfirstlane(tid >> 6), lane = tid & 63, wr = wid >> 2, wc = wid & 3, fr = lane & 15, fq = lane >> 4;
    const int K = g.K, nt = K / BK;
    unsigned voffA[2], voffB[2];
#pragma unroll
    for (int i = 0; i < 2; ++i) { int R, C; stage_rc(tid * 16 + i * 8192, R, C); const int Rb = Epi::PERM ? ((R & ~31) + perm32(R & 31)) : R;
        voffA[i] = (unsigned)(R * K + C) * 2u; voffB[i] = (unsigned)(Rb * K + C) * 2u; }
    const size_t kstep = (size_t)(BK * 2);
    const size_t hstep = (size_t)HALF * K * 2;
    const size_t tstep = 2 * hstep;
    const unsigned ldsw = (unsigned)wid * 1024u;
    const int aoff = lds_byte(wr * 64 + fr, fq * 8), boff = lds_byte(wc * 32 + fr, fq * 8);
#define PG8_SA(b, h) (((b) * 2 + (h)) * HTB)
#define PG8_SB(b, h) ((4 + (b) * 2 + (h)) * HTB)
#define PG8_STAGE(bufoff, gbase, voff) do { _Pragma("unroll") for (int _i = 0; _i < 2; ++_i) \
        __builtin_amdgcn_global_load_lds((const unsigned*)((const char*)(gbase) + (voff)[_i]), (PG8_LAS unsigned*)(lds + (bufoff) + ldsw + _i * 8192), 16, 0, 0); } while (0)
#define PG8_LDA(dst, b, h) do { _Pragma("unroll") for (int m = 0; m < 4; ++m) _Pragma("unroll") for (int k = 0; k < 2; ++k) dst[m][k] = *(const PG8_LAS bf16x8*)(lds + PG8_SA(b, h) + aoff + m * 2048 + k * 1024); } while (0)
#define PG8_LDB(dst, b, h) do { _Pragma("unroll") for (int n = 0; n < 2; ++n) _Pragma("unroll") for (int k = 0; k < 2; ++k) dst[n][k] = *(const PG8_LAS bf16x8*)(lds + PG8_SB(b, h) + boff + n * 2048 + k * 1024); } while (0)
#define PG8_MMA(ai, bj, At, Bt) do { __builtin_amdgcn_s_setprio(1); _Pragma("unroll") for (int m = 0; m < 4; ++m) _Pragma("unroll") for (int n = 0; n < 2; ++n) _Pragma("unroll") for (int k = 0; k < 2; ++k) \
        acc[ai][bj][m][n] = __builtin_amdgcn_mfma_f32_16x16x32_bf16(Bt[n][k], At[m][k], acc[ai][bj][m][n], 0, 0, 0); __builtin_amdgcn_s_setprio(0); } while (0)
#define PG8_WAIT_V(n) asm volatile("s_waitcnt vmcnt(" #n ")" ::: "memory")
#define PG8_WAIT_L(n) asm volatile("s_waitcnt lgkmcnt(" #n ")" ::: "memory")
#define PG8_BAR __builtin_amdgcn_s_barrier()
#define PG8_SCHED __builtin_amdgcn_sched_barrier(0)
    Unit cur, nxt; int ui = 0;
    if (!S.next(0, cur)) return;
    f32x4 acc[2][2][4][2];
#pragma unroll
    for (int a = 0; a < 2; ++a)
#pragma unroll
        for (int b = 0; b < 2; ++b)
#pragma unroll
            for (int m = 0; m < 4; ++m)
#pragma unroll
                for (int n = 0; n < 2; ++n) acc[a][b][m][n] = (f32x4){0.f, 0.f, 0.f, 0.f};
    bf16x8 At[4][2], B0[2][2], B1[2][2];
    const char* cA = (const char*)g.A + (size_t)cur.pm * tstep; const char* cB = (const char*)g.Bt + (size_t)cur.pn * tstep;
    S.a_ready(cur);
    if constexpr (SP2) {
        PG8_STAGE(PG8_SB(0, 0), cB, voffB); PG8_STAGE(PG8_SB(0, 1), cB + hstep, voffB); PG8_STAGE(PG8_SA(0, 0), cA, voffA); PG8_STAGE(PG8_SA(0, 1), cA + hstep, voffA);
        if (wr == 1) PG8_BAR;
        PG8_WAIT_V(2); PG8_BAR;
        PG8_STAGE(PG8_SB(1, 0), cB + kstep, voffB); PG8_STAGE(PG8_SA(1, 0), cA + kstep, voffA); PG8_STAGE(PG8_SB(1, 1), cB + hstep + kstep, voffB);
        PG8_WAIT_V(6); PG8_BAR;
    } else {
        PG8_STAGE(PG8_SB(0, 0), cB, voffB); PG8_STAGE(PG8_SA(0, 0), cA, voffA); PG8_STAGE(PG8_SB(0, 1), cB + hstep, voffB); PG8_STAGE(PG8_SA(0, 1), cA + hstep, voffA);
        if (wr == 1) PG8_BAR;
        PG8_WAIT_V(4); PG8_BAR;
        PG8_STAGE(PG8_SB(1, 0), cB + kstep, voffB); PG8_STAGE(PG8_SA(1, 0), cA + kstep, voffA); PG8_STAGE(PG8_SB(1, 1), cB + hstep + kstep, voffB);
        PG8_WAIT_V(6); PG8_BAR;
    }
    for (;;) {
        const bool has_next = S.next(ui + 1, nxt);
        const char* nA = has_next ? (const char*)g.A + (size_t)nxt.pm * tstep : cA; const char* nB = has_next ? (const char*)g.Bt + (size_t)nxt.pn * tstep : cB;
        for (int t = 0; t < nt; t += 2) {
            const bool last = (t == nt - 2);
            const char* a1 = cA + (size_t)(t + 1) * kstep;
            const char* a2 = last ? nA : cA + (size_t)(t + 2) * kstep; const char* b2 = last ? nB : cB + (size_t)(t + 2) * kstep;
            const char* a3 = a2 + kstep; const char* b3 = b2 + kstep;
            if (last && has_next) S.a_ready(nxt);
            if constexpr (SP2) {
            PG8_LDB(B0, 0, 0); PG8_LDB(B1, 0, 1); PG8_SCHED; PG8_LDA(At, 0, 0); PG8_STAGE(PG8_SA(1, 1), a1 + hstep, voffA);
            PG8_WAIT_V(8); PG8_WAIT_L(0); PG8_BAR; PG8_MMA(0, 0, At, B0); PG8_MMA(0, 1, At, B1); PG8_BAR; PG8_SCHED;
            PG8_LDA(At, 0, 1); PG8_STAGE(PG8_SB(0, 0), b2, voffB); PG8_STAGE(PG8_SB(0, 1), b2 + hstep, voffB); PG8_STAGE(PG8_SA(0, 0), a2, voffA);
            PG8_WAIT_V(8); PG8_WAIT_L(0); PG8_BAR; PG8_MMA(1, 0, At, B0); PG8_MMA(1, 1, At, B1); PG8_BAR; PG8_SCHED;
            PG8_LDB(B0, 1, 0); PG8_LDB(B1, 1, 1); PG8_SCHED; PG8_LDA(At, 1, 0); PG8_STAGE(PG8_SA(0, 1), a2 + hstep, voffA);
            PG8_WAIT_V(8); PG8_WAIT_L(0); PG8_BAR; PG8_MMA(0, 0, At, B0); PG8_MMA(0, 1, At, B1); PG8_BAR; PG8_SCHED;
            PG8_LDA(At, 1, 1); PG8_STAGE(PG8_SB(1, 0), b3, voffB); PG8_STAGE(PG8_SB(1, 1), b3 + hstep, voffB); PG8_STAGE(PG8_SA(1, 0), a3, voffA);
            PG8_WAIT_V(8); PG8_WAIT_L(0); PG8_BAR; PG8_MMA(1, 0, At, B0); PG8_MMA(1, 1, At, B1); PG8_BAR; PG8_SCHED;
            } else {
            PG8_LDB(B0, 0, 0); PG8_SCHED; PG8_LDA(At, 0, 0); PG8_STAGE(PG8_SA(1, 1), a1 + hstep, voffA);
            PG8_WAIT_L(8); PG8_BAR; PG8_WAIT_L(0); PG8_MMA(0, 0, At, B0); PG8_BAR; PG8_SCHED;
            PG8_LDB(B1, 0, 1); PG8_STAGE(PG8_SB(0, 0), b2, voffB);
            PG8_BAR; PG8_WAIT_L(0); PG8_MMA(0, 1, At, B1); PG8_BAR;
            PG8_LDA(At, 0, 1); PG8_STAGE(PG8_SA(0, 0), a2, voffA);
            PG8_BAR; PG8_WAIT_L(0); PG8_MMA(1, 0, At, B0); PG8_BAR; PG8_SCHED;
            PG8_STAGE(PG8_SB(0, 1), b2 + hstep, voffB);
            PG8_WAIT_V(6); PG8_BAR; PG8_MMA(1, 1, At, B1); PG8_BAR;
            PG8_LDB(B0, 1, 0); PG8_SCHED; PG8_LDA(At, 1, 0); PG8_STAGE(PG8_SA(0, 1), a2 + hstep, voffA);
            PG8_WAIT_L(8); PG8_BAR; PG8_WAIT_L(0); PG8_MMA(0, 0, At, B0); PG8_BAR; PG8_SCHED;
            PG8_LDB(B1, 1, 1); PG8_STAGE(PG8_SB(1, 0), b3, voffB);
            PG8_BAR; PG8_WAIT_L(0); PG8_MMA(0, 1, At, B1); PG8_BAR;
            PG8_LDA(At, 1, 1); PG8_STAGE(PG8_SA(1, 0), a3, voffA);
            PG8_BAR; PG8_WAIT_L(0); PG8_MMA(1, 0, At, B0); PG8_BAR; PG8_SCHED;
            PG8_STAGE(PG8_SB(1, 1), b3 + hstep, voffB);
            PG8_WAIT_V(6); PG8_BAR; PG8_MMA(1, 1, At, B1); PG8_BAR;
            }
        }
        if constexpr (ALIGN_EPI) { if (wr == 0) PG8_BAR; }
        if constexpr (!Epi::AFTER_DRAIN) { E(acc, cur, wr, wc, fr, fq); S.done(cur); }
        if (!has_next) break;
#pragma unroll
        for (int a = 0; a < 2; ++a)
#pragma unroll
            for (int b = 0; b < 2; ++b)
#pragma unroll
                for (int m = 0; m < 4; ++m)
#pragma unroll
                    for (int n = 0; n < 2; ++n) acc[a][b][m][n] = (f32x4){0.f, 0.f, 0.f, 0.f};
        cur = nxt; cA = nA; cB = nB; ++ui;
        if constexpr (ALIGN_EPI) { if (wr == 1) PG8_BAR; }
    }
    PG8_WAIT_V(0);
    if constexpr (!ALIGN_EPI) { if (wr == 0) PG8_BAR; }
    PG8_BAR;
    if constexpr (Epi::AFTER_DRAIN) { E.fused(acc, cur, wr, wc, fr, fq, lds, wid, lane); S.done(cur); }
#undef PG8_SA
#undef PG8_SB
#undef PG8_STAGE
#undef PG8_LDA
#undef PG8_LDB
#undef PG8_MMA
#undef PG8_WAIT_V
#undef PG8_WAIT_L
#undef PG8_BAR
#undef PG8_SCHED
}
}
#define GAS __attribute__((address_space(1)))
#define LAS __attribute__((address_space(3)))
typedef unsigned short bf16;
typedef float f32x4 __attribute__((ext_vector_type(4)));
typedef short bf16x8 __attribute__((ext_vector_type(8)));
typedef short s16x4 __attribute__((ext_vector_type(4)));
typedef unsigned u32x4 __attribute__((ext_vector_type(4)));
typedef unsigned u32x2 __attribute__((ext_vector_type(2)));
constexpr int NB = 8, SEQ = 4096, DM = 1024, M = NB * SEQ;
constexpr int NH = 16, HD = 64, DSSM = 1024, DCONV = 1536, NST = 128, CHK = 128, NCHK = SEQ / CHK, NPROJ = 6672, NPADN = 6912, DINNER = 2048;
constexpr float EPS = 1e-6f;
constexpr float LOG2E = 1.4426950408889634f;
constexpr float QSCALE = 0.125f * LOG2E;
constexpr int NT = 512, NWV = 8;
constexpr size_t MiB = 1u << 20;
constexpr size_t WS_RSTD = MiB / 2;
constexpr size_t WS_WINT = 1 * MiB;
constexpr size_t WS_WOUTT = 15 * MiB;
constexpr size_t WS_DTRAW = 19 * MiB;
constexpr size_t WS_ACS = 21 * MiB;
constexpr size_t WS_DTS = 23 * MiB;
constexpr size_t WS_LSE = 25 * MiB;
constexpr size_t WS_XB = 32 * MiB;
constexpr size_t WS_ST = 32 * MiB;
constexpr size_t WS_V = 96 * MiB, WS_G = 160 * MiB;
constexpr size_t WS_OUTPRE = 96 * MiB;
constexpr size_t WS_Z = 224 * MiB;
constexpr size_t WS_XBC = 288 * MiB;
constexpr size_t WS_MIX = 384 * MiB;
constexpr size_t WS_END = 512 * MiB;
constexpr int LDS_BYTES = 147456;

struct Args { const float *x, *npw, *w_in, *conv_w, *conv_b, *dt_bias, *a_log, *d_skip, *ssm_nw, *w_out, *npost_w; float* out; unsigned char* ws; int ph_lo, ph_hi; };

__device__ __forceinline__ float bf2f(unsigned u) { return __builtin_bit_cast(float, u << 16); }
__device__ __forceinline__ unsigned f2bf(float f) { unsigned u = __builtin_bit_cast(unsigned, f); return (u + 0x7fffu + ((u >> 16) & 1u)) >> 16; }
__device__ __forceinline__ unsigned pk2(float lo, float hi) { return f2bf(lo) | (f2bf(hi) << 16); }
__device__ __forceinline__ float wave_sum(float v) {
#pragma unroll
    for (int o = 1; o < 64; o <<= 1) v += __shfl_xor(v, o);
    return v;
}
__device__ __forceinline__ float silu_f(float v) { return v / (1.f + __expf(-v)); }
__device__ __forceinline__ float softplus_f(float v) { return v > 20.f ? v : log1pf(__expf(v)); }
#define LDS_WAIT() asm volatile("s_waitcnt lgkmcnt(0)" ::: "memory")

namespace pg8 {
struct EpiProj {
    static constexpr bool PERM = true, AFTER_DRAIN = false;
    bf16 *d0, *d1, *d2, *d3, *d4; bf16* xbc; float* dtraw; const float* rstd;
    __device__ __forceinline__ void operator()(const f32x4 (&acc)[2][2][4][2], const Unit& u, int wr, int wc, int fr, int fq) const {
        const int row0 = u.pm * BM + wr * 64 + fr; const int pn = u.pn;
        if (pn == 26) {
            if (wc == 0 && fq < 2) {
#pragma unroll
                for (int ai = 0; ai < 2; ++ai)
#pragma unroll
                    for (int m = 0; m < 4; ++m) { const int row = row0 + ai * HALF + m * 16; const float rs = rstd[row];
                        float* p = dtraw + (size_t)row * 16 + 8 * fq; *(f32x4*)p = acc[ai][0][m][0] * rs; *(f32x4*)(p + 4) = acc[ai][0][m][1] * rs; }
            }
            return;
        }
        bf16* base; int ldc, colt; float sc = 1.f;
        if (pn < 20) { const int sel = pn >> 2; base = sel == 0 ? d0 : sel == 1 ? d1 : sel == 2 ? d2 : sel == 3 ? d3 : d4; ldc = 1024; colt = (pn & 3) * BM; if (pn < 4) sc = QSCALE; }
        else { base = xbc; ldc = DCONV; colt = (pn - 20) * BM; }
        const int col0 = colt + wc * 32 + 8 * fq;
#pragma unroll
        for (int ai = 0; ai < 2; ++ai)
#pragma unroll
            for (int m = 0; m < 4; ++m) { const int row = row0 + ai * HALF + m * 16; const float rs = rstd[row] * sc; bf16* rowp = base + (size_t)row * ldc + col0;
#pragma unroll
                for (int bj = 0; bj < 2; ++bj) { const f32x4 v0 = acc[ai][bj][m][0] * rs, v1 = acc[ai][bj][m][1] * rs;
                    u32x4 w; w.x = cvt_pk_bf16(v0[0], v0[1]); w.y = cvt_pk_bf16(v0[2], v0[3]); w.z = cvt_pk_bf16(v1[0], v1[1]); w.w = cvt_pk_bf16(v1[2], v1[3]);
                    *(u32x4*)(rowp + bj * HALF) = w; } }
    }
};
struct EpiF32 {
    static constexpr bool PERM = true, AFTER_DRAIN = false;
    float* O; int ldc;
    __device__ __forceinline__ void operator()(const f32x4 (&acc)[2][2][4][2], const Unit& u, int wr, int wc, int fr, int fq) const {
        const int row0 = u.pm * BM + wr * 64 + fr, col0 = u.pn * BM + wc * 32 + 8 * fq;
#pragma unroll
        for (int ai = 0; ai < 2; ++ai)
#pragma unroll
            for (int m = 0; m < 4; ++m) { float* rowp = O + (size_t)(row0 + ai * HALF + m * 16) * ldc + col0;
#pragma unroll
                for (int bj = 0; bj < 2; ++bj) { *(f32x4*)(rowp + bj * HALF) = acc[ai][bj][m][0]; *(f32x4*)(rowp + bj * HALF + 4) = acc[ai][bj][m][1]; } }
    }
};
}
__device__ __forceinline__ void transpose_item(const float* W, int K, int N, bf16* WT, const float* kscale, LAS float* scr, int item, int lane) {
    const int nblk = (N + 31) / 32, kb = item / nblk, nb = item % nblk, k0 = 64 * kb, n0 = 32 * nb;
    const int nn = n0 + (lane & 31);
#pragma unroll 8
    for (int i = 0; i < 32; ++i) { const int kk = 2 * i + (lane >> 5); float v = (nn < N) ? W[(size_t)(k0 + kk) * N + nn] : 0.f; if (kscale) v *= kscale[k0 + kk]; scr[kk * 33 + (lane & 31)] = v; }
    LDS_WAIT();
    const int c = lane & 7;
#pragma unroll
    for (int j = 0; j < 4; ++j) { const int n = (lane >> 3) + 8 * j; const LAS float* s = scr + (8 * c) * 33 + n;
        u32x4 o; o.x = pk2(s[0 * 33], s[1 * 33]); o.y = pk2(s[2 * 33], s[3 * 33]); o.z = pk2(s[4 * 33], s[5 * 33]); o.w = pk2(s[6 * 33], s[7 * 33]);
        if (n0 + n < N) *(u32x4*)(WT + (size_t)(n0 + n) * K + k0 + 8 * c) = o; }
    LDS_WAIT();
}
__device__ __forceinline__ void phase_prep(const Args& a, LAS unsigned char* lds, int gw, int NGW, int wave, int lane) {
    LAS float* scr = (LAS float*)(lds + wave * 16384);
    bf16* WINT = (bf16*)(a.ws + WS_WINT); bf16* WOUTT = (bf16*)(a.ws + WS_WOUTT); bf16* XB = (bf16*)(a.ws + WS_XB); float* RSTD = (float*)(a.ws + WS_RSTD);
    constexpr int I_IN = (DM / 64) * ((NPROJ + 31) / 32), I_OUT = (DINNER / 64) * (DM / 32);
    for (int it = gw; it < I_IN + I_OUT; it += NGW) {
        if (it < I_IN) transpose_item(a.w_in, DM, NPROJ, WINT, a.npw, scr, it, lane);
        else transpose_item(a.w_out, DINNER, DM, WOUTT, nullptr, scr, it - I_IN, lane);
    }
    for (int m = gw; m < M; m += NGW) {
        const f32x4* xr = (const f32x4*)(a.x + (size_t)m * DM) + lane;
        f32x4 v[4]; float s = 0.f;
#pragma unroll
        for (int j = 0; j < 4; ++j) { v[j] = xr[64 * j]; s += (v[j].x * v[j].x + v[j].y * v[j].y) + (v[j].z * v[j].z + v[j].w * v[j].w); }
        s = wave_sum(s);
        if (lane == 0) RSTD[m] = 1.f / sqrtf(s * (1.f / DM) + EPS);
        u32x2* o8 = (u32x2*)(XB + (size_t)m * DM) + lane;
#pragma unroll
        for (int j = 0; j < 4; ++j) { u32x2 o; o.x = pk2(v[j].x, v[j].y); o.y = pk2(v[j].z, v[j].w); o8[64 * j] = o; }
    }
}

__device__ __forceinline__ void naive_attn(const Args& a, int gw, int NGW, int lane) {
    const bf16* Q = (const bf16*)a.out; const bf16* K = Q + (size_t)M * 1024; const bf16* V = (const bf16*)(a.ws + WS_V); const bf16* G = (const bf16*)(a.ws + WS_G);
    bf16* MIX = (bf16*)(a.ws + WS_MIX);
    for (int it = gw; it < M * NH; it += NGW) {
        const int row = it >> 4, h = it & 15, t = row & (SEQ - 1), b = row >> 12;
        const float q = bf2f(Q[(size_t)row * 1024 + h * 64 + lane]);
        float op[3], lsep[3];
#pragma unroll
        for (int p = 0; p < 3; ++p) {
            const int d = (p == 0) ? 1 : (p == 1 ? 4 : 16);
            float m = -INFINITY, l = 0.f, o = 0.f;
            for (int j = 0; j <= 128; ++j) {
                const int tk = t - j * d; if (tk < 0) break;
                const size_t kr = ((size_t)(b * SEQ + tk)) * 1024 + h * 64 + lane;
                const float s = wave_sum(q * bf2f(K[kr]));
                const float mn = fmaxf(m, s), sc = exp2f(m - mn), pe = exp2f(s - mn);
                l = l * sc + pe; o = o * sc + pe * bf2f(V[kr]); m = mn;
            }
            op[p] = o / l; lsep[p] = m + log2f(l);
        }
        const float mm = fmaxf(lsep[0], fmaxf(lsep[1], lsep[2]));
        const float w0 = exp2f(lsep[0] - mm), w1 = exp2f(lsep[1] - mm), w2 = exp2f(lsep[2] - mm);
        float r = (w0 * op[0] + w1 * op[1] + w2 * op[2]) / (w0 + w1 + w2);
        r *= silu_f(bf2f(G[(size_t)row * 1024 + h * 64 + lane]));
        MIX[(size_t)row * DINNER + h * 64 + lane] = (bf16)f2bf(r);
    }
}
__device__ __forceinline__ void naive_conv(const Args& a, int gt, int NGT) {
    const bf16* XBC = (const bf16*)(a.ws + WS_XBC); bf16* XC = (bf16*)a.out; const float* DTRAW = (const float*)(a.ws + WS_DTRAW); float* DTS = (float*)(a.ws + WS_DTS);
    for (size_t i = gt; i < (size_t)M * DCONV; i += NGT) {
        const int row = (int)(i / DCONV), ch = (int)(i % DCONV), t = row & (SEQ - 1);
        float acc = a.conv_b[ch];
#pragma unroll
        for (int k = 0; k < 4; ++k) { const int tt = t - 3 + k; if (tt >= 0) acc += a.conv_w[k * DCONV + ch] * bf2f(XBC[(size_t)(row - 3 + k) * DCONV + ch]); }
        XC[i] = (bf16)f2bf(silu_f(acc));
    }
    for (int i = gt; i < M * NH; i += NGT) DTS[i] = softplus_f(DTRAW[i] + a.dt_bias[i & 15]);
}
__device__ __forceinline__ void naive_ssd(const Args& a, int gw, int NGW, int lane) {
    const bf16* XC = (const bf16*)a.out; const float* DTS = (const float*)(a.ws + WS_DTS); float* Y = (float*)(a.ws + WS_OUTPRE);
    for (int it = gw; it < NB * NH * HD; it += NGW) {
        const int p = it & 63, h = (it >> 6) & 15, b = it >> 10, g = h >> 3;
        const float av = -__expf(a.a_log[h]), dsk = a.d_skip[h];
        float h0 = 0.f, h1 = 0.f;
        for (int t = 0; t < SEQ; ++t) {
            const size_t row = (size_t)b * SEQ + t; const bf16* xr = XC + row * DCONV;
            const float dt = DTS[row * 16 + h], dA = __expf(dt * av), x = bf2f(xr[h * 64 + p]);
            const float B0 = bf2f(xr[1024 + g * 128 + lane]), B1 = bf2f(xr[1024 + g * 128 + 64 + lane]);
            const float C0 = bf2f(xr[1280 + g * 128 + lane]), C1 = bf2f(xr[1280 + g * 128 + 64 + lane]);
            h0 = h0 * dA + dt * x * B0; h1 = h1 * dA + dt * x * B1;
            const float y = wave_sum(C0 * h0 + C1 * h1) + dsk * x;
            if (lane == 0) Y[row * 1024 + h * 64 + p] = y;
        }
    }
}
__device__ __forceinline__ void naive_gnorm(const Args& a, int gw, int NGW, int lane) {
    const float* Y = (const float*)(a.ws + WS_OUTPRE); const bf16* Z = (const bf16*)(a.ws + WS_Z); bf16* MIX = (bf16*)(a.ws + WS_MIX);
    for (int it = gw; it < M * 2; it += NGW) {
        const int row = it >> 1, g = it & 1; const int c0 = g * 512 + lane * 8;
        float v[8]; float ss = 0.f;
#pragma unroll
        for (int j = 0; j < 8; ++j) { const float y = Y[(size_t)row * 1024 + c0 + j], z = bf2f(Z[(size_t)row * 1024 + c0 + j]); v[j] = y * silu_f(z); ss += v[j] * v[j]; }
        ss = wave_sum(ss); const float r = 1.f / sqrtf(ss * (1.f / 512.f) + EPS);
#pragma unroll
        for (int j = 0; j < 8; ++j) MIX[(size_t)row * DINNER + 1024 + c0 + j] = (bf16)f2bf(v[j] * r * a.ssm_nw[c0 + j]);
    }
}
__device__ __forceinline__ void phase_final(const Args& a, int gw, int NGW, int lane) {
    const float* OP = (const float*)(a.ws + WS_OUTPRE);
    for (int m = gw; m < M; m += NGW) {
        const f32x4* pr = (const f32x4*)(OP + (size_t)m * DM) + lane; const f32x4* xr = (const f32x4*)(a.x + (size_t)m * DM) + lane; const f32x4* wr = (const f32x4*)a.npost_w + lane;
        f32x4 v[4]; float s = 0.f;
#pragma unroll
        for (int j = 0; j < 4; ++j) { v[j] = pr[64 * j]; s += (v[j].x * v[j].x + v[j].y * v[j].y) + (v[j].z * v[j].z + v[j].w * v[j].w); }
        s = wave_sum(s); const float r = 1.f / sqrtf(s * (1.f / DM) + EPS);
        f32x4* orow = (f32x4*)(a.out + (size_t)m * DM) + lane;
#pragma unroll
        for (int j = 0; j < 4; ++j) orow[64 * j] = xr[64 * j] + v[j] * r * wr[64 * j];
    }
}
#ifndef ONE_LAUNCH
#define ONE_LAUNCH 1
#endif
constexpr int NPHASE = 8;
__global__ void __launch_bounds__(NT, 2) hybrid_fwd(Args a) {
    extern __shared__ __attribute__((aligned(16))) unsigned char lds_raw[];
    LAS unsigned char* lds = (LAS unsigned char*)lds_raw;
    const int tid = threadIdx.x, lane = tid & 63, wave = __builtin_amdgcn_readfirstlane(tid >> 6);
    const int G = gridDim.x, gw = blockIdx.x * NWV + wave, NGW = G * NWV, gt = blockIdx.x * NT + tid, NGT = G * NT;
    const int lo = a.ph_lo, hi = a.ph_hi;
#define IN(k) (lo <= (k) && (k) < hi)
#define SEAM(k) do { if (IN(k) && IN((k) + 1)) { cg::this_grid().sync(); } } while (0)
    if (IN(0)) { phase_prep(a, lds, gw, NGW, wave, lane); __syncthreads(); } SEAM(0);
    if (IN(1)) {
        pg8::Gemm g{(const bf16*)(a.ws + WS_XB), (const bf16*)(a.ws + WS_WINT), M, NPADN, DM}; pg8::StaticOrder S; S.init(M, NPADN, G, (int)blockIdx.x);
        pg8::EpiProj E; E.d0 = (bf16*)a.out; E.d1 = (bf16*)a.out + (size_t)M * 1024; E.d2 = (bf16*)(a.ws + WS_V); E.d3 = (bf16*)(a.ws + WS_G); E.d4 = (bf16*)(a.ws + WS_Z);
        E.xbc = (bf16*)(a.ws + WS_XBC); E.dtraw = (float*)(a.ws + WS_DTRAW); E.rstd = (const float*)(a.ws + WS_RSTD);
        pg8::gemm_phase<pg8::EpiProj, pg8::StaticOrder, true, true>(lds, g, S, E);
    } SEAM(1);
    if (IN(2)) naive_attn(a, gw, NGW, lane); SEAM(2);
    if (IN(3)) naive_conv(a, gt, NGT); SEAM(3);
    if (IN(4)) naive_ssd(a, gw, NGW, lane); SEAM(4);
    if (IN(5)) naive_gnorm(a, gw, NGW, lane); SEAM(5);
    if (IN(6)) {
        pg8::Gemm g{(const bf16*)(a.ws + WS_MIX), (const bf16*)(a.ws + WS_WOUTT), M, DM, DINNER}; pg8::StaticOrder S; S.init(M, DM, G, (int)blockIdx.x);
        pg8::EpiF32 E{(float*)(a.ws + WS_OUTPRE), DM};
        pg8::gemm_phase<pg8::EpiF32, pg8::StaticOrder, true, true>(lds, g, S, E);
    } SEAM(6);
    if (IN(7)) phase_final(a, gw, NGW, lane);
#undef IN
#undef SEAM
}

extern "C" void kernel_launch(void* const* d_in, const int* in_sizes, int n_in, void* d_out, int out_size, void* d_ws, size_t ws_size, hipStream_t stream) {
    static int grid = 0;
    if (grid == 0) {
        if (n_in != 11 || out_size != M * DM || ws_size < WS_END) { fprintf(stderr, "kernel_launch: unexpected shapes (n_in %d out %d ws %zu)\n", n_in, out_size, ws_size); grid = -1; return; }
        int dev = 0, cus = 0, per_cu = 0;
        (void)hipGetDevice(&dev); (void)hipDeviceGetAttribute(&cus, hipDeviceAttributeMultiprocessorCount, dev);
        if (hipFuncSetAttribute((const void*)hybrid_fwd, hipFuncAttributeMaxDynamicSharedMemorySize, LDS_BYTES) != hipSuccess) { fprintf(stderr, "kernel_launch: hipFuncSetAttribute failed\n"); grid = -1; return; }
        if (hipOccupancyMaxActiveBlocksPerMultiprocessor(&per_cu, (const void*)hybrid_fwd, NT, LDS_BYTES) != hipSuccess || per_cu < 1) { fprintf(stderr, "kernel_launch: occupancy query says %d\n", per_cu); per_cu = 1; }
        (void)hipGetLastError();
        grid = cus * 1;
        fprintf(stderr, "kernel_launch: cus %d per_cu %d grid %d\n", cus, per_cu, grid);
    }
    if (grid < 0) return;
    Args a{};
    a.x = (const float*)d_in[0]; a.npw = (const float*)d_in[1]; a.w_in = (const float*)d_in[2]; a.conv_w = (const float*)d_in[3]; a.conv_b = (const float*)d_in[4];
    a.dt_bias = (const float*)d_in[5]; a.a_log = (const float*)d_in[6]; a.d_skip = (const float*)d_in[7]; a.ssm_nw = (const float*)d_in[8]; a.w_out = (const float*)d_in[9]; a.npost_w = (const float*)d_in[10];
    a.out = (float*)d_out; a.ws = (unsigned char*)d_ws;
#if ONE_LAUNCH
    a.ph_lo = 0; a.ph_hi = NPHASE;
    void* args[] = {&a};
    hipError_t e = hipLaunchCooperativeKernel((const void*)hybrid_fwd, dim3(grid), dim3(NT), args, LDS_BYTES, stream);
    if (e != hipSuccess) fprintf(stderr, "cooperative launch failed: %s (grid %d)\n", hipGetErrorString(e), grid);
#else
    for (int p = 0; p < NPHASE; ++p) { a.ph_lo = p; a.ph_hi = p + 1; hipLaunchKernelGGL(hybrid_fwd, dim3(grid), dim3(NT), LDS_BYTES, stream, a); }
#endif
}
```

```cpp
#include <hip/hip_runtime.h>
#include <hip/hip_cooperative_groups.h>
#include <cstdio>
#include <cstdint>
namespace cg = cooperative_groups;
namespace pg8 {
#define PG8_LAS __attribute__((address_space(3)))
typedef unsigned short bf16_t;
typedef short bf16x8 __attribute__((ext_vector_type(8)));
typedef float f32x4 __attribute__((ext_vector_type(4)));
typedef unsigned u32x4 __attribute__((ext_vector_type(4)));
constexpr int BM = 256, BK = 64, HALF = 128, HTB = HALF * BK * 2  , STAGE_BYTES = 8 * HTB, NXCD = 8, WGM = 8;

__host__ __device__ __forceinline__ int lds_byte(int r, int c) { const int st = (r >> 4) * 2 + (c >> 5), rr = r & 15, cc = c & 31, ob = rr * 64 + cc * 2; return st * 1024 + (ob ^ (((ob >> 9) & 1) << 5)); }
__host__ __device__ __forceinline__ void stage_rc(int b, int& R, int& C) { const int st = b / 1024, sb = b % 1024, swz = sb ^ (((sb >> 9) & 1) << 5); R = (st >> 1) * 16 + swz / 64; C = (st & 1) * 32 + (swz % 64) / 2; }
__host__ __device__ __forceinline__ int perm32(int rho) { const int n = rho >> 4, i = rho & 15; return 8 * (i >> 2) + 4 * n + (i & 3); }

struct Unit { int pm, pn; };
struct Gemm { const bf16_t* A; const bf16_t* Bt; int M, N, K; };

struct StaticOrder {
    int nM, nN, nwg, G, c;
    __host__ __device__ void init(int M, int N, int G_, int c_) { nM = M / BM; nN = N / BM; nwg = nM * nN; G = G_; c = c_; }
    __host__ __device__ bool next(int i, Unit& u) const {
        const long L = (long)i * G + c; if (L >= nwg) return false;
        int wgid = (int)L; { const int q = nwg / NXCD, r = nwg % NXCD, xcd = wgid % NXCD, off = wgid / NXCD; wgid = (xcd < r ? xcd * (q + 1) : r * (q + 1) + (xcd - r) * q) + off; }
        const int nig = WGM * nN, gid = wgid / nig, fm = gid * WGM, gsz = (nM - fm) < WGM ? (nM - fm) : WGM;
        u.pm = fm + ((wgid % nig) % gsz); u.pn = (wgid % nig) / gsz; return true;
    }
    __device__ __forceinline__ void a_ready(const Unit&) const {}
    __device__ __forceinline__ void done(const Unit&) const {}
};

__device__ __forceinline__ unsigned cvt_pk_bf16(float lo, float hi) { unsigned r; asm volatile("v_cvt_pk_bf16_f32 %0, %1, %2" : "=v"(r) : "v"(lo), "v"(hi)); return r; }
template <class Epi, class Sched, bool ALIGN_EPI = false, bool SP2 = false>
__device__ __forceinline__ void gemm_phase(PG8_LAS unsigned char* lds, const Gemm g, const Sched& S, const Epi& E) {
    const int tid = threadIdx.x, wid = __builtin_amdgcn_readfirstlane(tid >> 6), lane = tid & 63, wr = wid >> 2, wc = wid & 3, fr = lane & 15, fq = lane >> 4;
    const int K = g.K, nt = K / BK;
    unsigned voffA[2], voffB[2];
#pragma unroll
    for (int i = 0; i < 2; ++i) { int R, C; stage_rc(tid * 16 + i * 8192, R, C); const int Rb = Epi::PERM ? ((R & ~31) + perm32(R & 31)) : R;
        voffA[i] = (unsigned)(R * K + C) * 2u; voffB[i] = (unsigned)(Rb * K + C) * 2u; }
    const size_t kstep = (size_t)(BK * 2);
    const size_t hstep = (size_t)HALF * K * 2;
    const size_t tstep = 2 * hstep;
    const unsigned ldsw = (unsigned)wid * 1024u;
    const int aoff = lds_byte(wr * 64 + fr, fq * 8), boff = lds_byte(wc * 32 + fr, fq * 8);
#define PG8_SA(b, h) (((b) * 2 + (h)) * HTB)
#define PG8_SB(b, h) ((4 + (b) * 2 + (h)) * HTB)
#define PG8_STAGE(bufoff, gbase, voff) do { _Pragma("unroll") for (int _i = 0; _i < 2; ++_i) \
        __builtin_amdgcn_global_load_lds((const unsigned*)((const char*)(gbase) + (voff)[_i]), (PG8_LAS unsigned*)(lds + (bufoff) + ldsw + _i * 8192), 16, 0, 0); } while (0)
#define PG8_LDA(dst, b, h) do { _Pragma("unroll") for (int m = 0; m < 4; ++m) _Pragma("unroll") for (int k = 0; k < 2; ++k) dst[m][k] = *(const PG8_LAS bf16x8*)(lds + PG8_SA(b, h) + aoff + m * 2048 + k * 1024); } while (0)
#define PG8_LDB(dst, b, h) do { _Pragma("unroll") for (int n = 0; n < 2; ++n) _Pragma("unroll") for (int k = 0; k < 2; ++k) dst[n][k] = *(const PG8_LAS bf16x8*)(lds + PG8_SB(b, h) + boff + n * 2048 + k * 1024); } while (0)
#define PG8_MMA(ai, bj, At, Bt) do { __builtin_amdgcn_s_setprio(1); _Pragma("unroll") for (int m = 0; m < 4; ++m) _Pragma("unroll") for (int n = 0; n < 2; ++n) _Pragma("unroll") for (int k = 0; k < 2; ++k) \
        acc[ai][bj][m][n] = __builtin_amdgcn_mfma_f32_16x16x32_bf16(Bt[n][k], At[m][k], acc[ai][bj][m][n], 0, 0, 0); __builtin_amdgcn_s_setprio(0); } while (0)
#define PG8_WAIT_V(n) asm volatile("s_waitcnt vmcnt(" #n ")" ::: "memory")
#define PG8_WAIT_L(n) asm volatile("s_waitcnt lgkmcnt(" #n ")" ::: "memory")
#define PG8_BAR __builtin_amdgcn_s_barrier()
#define PG8_SCHED __builtin_amdgcn_sched_barrier(0)
    Unit cur, nxt; int ui = 0;
    if (!S.next(0, cur)) return;
    f32x4 acc[2][2][4][2];
#pragma unroll
    for (int a = 0; a < 2; ++a)
#pragma unroll
        for (int b = 0; b < 2; ++b)
#pragma unroll
            for (int m = 0; m < 4; ++m)
#pragma unroll
                for (int n = 0; n < 2; ++n) acc[a][b][m][n] = (f32x4){0.f, 0.f, 0.f, 0.f};
    bf16x8 At[4][2], B0[2][2], B1[2][2];
    const char* cA = (const char*)g.A + (size_t)cur.pm * tstep; const char* cB = (const char*)g.Bt + (size_t)cur.pn * tstep;
    S.a_ready(cur);
    if constexpr (SP2) {
        PG8_STAGE(PG8_SB(0, 0), cB, voffB); PG8_STAGE(PG8_SB(0, 1), cB + hstep, voffB); PG8_STAGE(PG8_SA(0, 0), cA, voffA); PG8_STAGE(PG8_SA(0, 1), cA + hstep, voffA);
        if (wr == 1) PG8_BAR;
        PG8_WAIT_V(2); PG8_BAR;
        PG8_STAGE(PG8_SB(1, 0), cB + kstep, voffB); PG8_STAGE(PG8_SA(1, 0), cA + kstep, voffA); PG8_STAGE(PG8_SB(1, 1), cB + hstep + kstep, voffB);
        PG8_WAIT_V(6); PG8_BAR;
    } else {
        PG8_STAGE(PG8_SB(0, 0), cB, voffB); PG8_STAGE(PG8_SA(0, 0), cA, voffA); PG8_STAGE(PG8_SB(0, 1), cB + hstep, voffB); PG8_STAGE(PG8_SA(0, 1), cA + hstep, voffA);
        if (wr == 1) PG8_BAR;
        PG8_WAIT_V(4); PG8_BAR;
        PG8_STAGE(PG8_SB(1, 0), cB + kstep, voffB); PG8_STAGE(PG8_SA(1, 0), cA + kstep, voffA); PG8_STAGE(PG8_SB(1, 1), cB + hstep + kstep, voffB);
        PG8_WAIT_V(6); PG8_BAR;
    }
    for (;;) {
        const bool has_next = S.next(ui + 1, nxt);
        const char* nA = has_next ? (const char*)g.A + (size_t)nxt.pm * tstep : cA; const char* nB = has_next ? (const char*)g.Bt + (size_t)nxt.pn * tstep : cB;
        for (int t = 0; t < nt; t += 2) {
            const bool last = (t == nt - 2);
            const char* a1 = cA + (size_t)(t + 1) * kstep;
            const char* a2 = last ? nA : cA + (size_t)(t + 2) * kstep; const char* b2 = last ? nB : cB + (size_t)(t + 2) * kstep;
            const char* a3 = a2 + kstep; const char* b3 = b2 + kstep;
            if (last && has_next) S.a_ready(nxt);
            if constexpr (SP2) {
            PG8_LDB(B0, 0, 0); PG8_LDB(B1, 0, 1); PG8_SCHED; PG8_LDA(At, 0, 0); PG8_STAGE(PG8_SA(1, 1), a1 + hstep, voffA);
            PG8_WAIT_V(8); PG8_WAIT_L(0); PG8_BAR; PG8_MMA(0, 0, At, B0); PG8_MMA(0, 1, At, B1); PG8_BAR; PG8_SCHED;
            PG8_LDA(At, 0, 1); PG8_STAGE(PG8_SB(0, 0), b2, voffB); PG8_STAGE(PG8_SB(0, 1), b2 + hstep, voffB); PG8_STAGE(PG8_SA(0, 0), a2, voffA);
            PG8_WAIT_V(8); PG8_WAIT_L(0); PG8_BAR; PG8_MMA(1, 0, At, B0); PG8_MMA(1, 1, At, B1); PG8_BAR; PG8_SCHED;
            PG8_LDB(B0, 1, 0); PG8_LDB(B1, 1, 1); PG8_SCHED; PG8_LDA(At, 1, 0); PG8_STAGE(PG8_SA(0, 1), a2 + hstep, voffA);
            PG8_WAIT_V(8); PG8_WAIT_L(0); PG8_BAR; PG8_MMA(0, 0, At, B0); PG8_MMA(0, 1, At, B1); PG8_BAR; PG8_SCHED;
            PG8_LDA(At, 1, 1); PG8_STAGE(PG8_SB(1, 0), b3, voffB); PG8_STAGE(PG8_SB(1, 1), b3 + hstep, voffB); PG8_STAGE(PG8_SA(1, 0), a3, voffA);
            PG8_WAIT_V(8); PG8_WAIT_L(0); PG8_BAR; PG8_MMA(1, 0, At, B0); PG8_MMA(1, 1, At, B1); PG8_BAR; PG8_SCHED;
            } else {
            PG8_LDB(B0, 0, 0); PG8_SCHED; PG8_LDA(At, 0, 0); PG8_STAGE(PG8_SA(1, 1), a1 + hstep, voffA);
            PG8_WAIT_L(8); PG8_BAR; PG8_WAIT_L(0); PG8_MMA(0, 0, At, B0); PG8_BAR; PG8_SCHED;
            PG8_LDB(B1, 0, 1); PG8_STAGE(PG8_SB(0, 0), b2, voffB);
            PG8_BAR; PG8_WAIT_L(0); PG8_MMA(0, 1, At, B1); PG8_BAR;
            PG8_LDA(At, 0, 1); PG8_STAGE(PG8_SA(0, 0), a2, voffA);
            PG8_BAR; PG8_WAIT_L(0); PG8_MMA(1, 0, At, B0); PG8_BAR; PG8_SCHED;
            PG8_STAGE(PG8_SB(0, 1), b2 + hstep, voffB);
            PG8_WAIT_V(6); PG8_BAR; PG8_MMA(1, 1, At, B1); PG8_BAR;
            PG8_LDB(B0, 1, 0); PG8_SCHED; PG8_LDA(At, 1, 0); PG8_STAGE(PG8_SA(0, 1), a2 + hstep, voffA);
            PG8_WAIT_L(8); PG8_BAR; PG8_WAIT_L(0); PG8_MMA(0, 0, At, B0); PG8_BAR; PG8_SCHED;
            PG8_LDB(B1, 1, 1); PG8_STAGE(PG8_SB(1, 0), b3, voffB);
            PG8_BAR; PG8_WAIT_L(0); PG8_MMA(0, 1, At, B1); PG8_BAR;
            PG8_LDA(At, 1, 1); PG8_STAGE(PG8_SA(1, 0), a3, voffA);
            PG8_BAR; PG8_WAIT_L(0); PG8_MMA(1, 0, At, B0); PG8_BAR; PG8_SCHED;
            PG8_STAGE(PG8_SB(1, 1), b3 + hstep, voffB);
            PG8_WAIT_V(6); PG8_BAR; PG8_MMA(1, 1, At, B1); PG8_BAR;
            }
        }
        if constexpr (ALIGN_EPI) { if (wr == 0) PG8_BAR; }
        if constexpr (!Epi::AFTER_DRAIN) { E(acc, cur, wr, wc, fr, fq); S.done(cur); }
        if (!has_next) break;
#pragma unroll
        for (int a = 0; a < 2; ++a)
#pragma unroll
            for (int b = 0; b < 2; ++b)
#pragma unroll
                for (int m = 0; m < 4; ++m)
#pragma unroll
                    for (int n = 0; n < 2; ++n) acc[a][b][m][n] = (f32x4){0.f, 0.f, 0.f, 0.f};
        cur = nxt; cA = nA; cB = nB; ++ui;
        if constexpr (ALIGN_EPI) { if (wr == 1) PG8_BAR; }
    }
    PG8_WAIT_V(0);
    if constexpr (!ALIGN_EPI) { if (wr == 0) PG8_BAR; }
    PG8_BAR;
    if constexpr (Epi::AFTER_DRAIN) { E.fused(acc, cur, wr, wc, fr, fq, lds, wid, lane); S.done(cur); }
#undef PG8_SA
#undef PG8_SB
#undef PG8_STAGE
#undef PG8_LDA
#undef PG8_LDB
#undef PG8_MMA
#undef PG8_WAIT_V
#undef PG8_WAIT_L
#undef PG8_BAR
#undef PG8_SCHED
}
}
#define GAS __attribute__((address_space(1)))
#define LAS __attribute__((address_space(3)))
typedef unsigned short bf16;
typedef float f32x4 __attribute__((ext_vector_type(4)));
typedef short bf16x8 __attribute__((ext_vector_type(8)));
typedef short s16x4 __attribute__((ext_vector_type(4)));
typedef unsigned u32x4 __attribute__((ext_vector_type(4)));
typedef unsigned u32x2 __attribute__((ext_vector_type(2)));
constexpr int NB = 8, SEQ = 4096, DM = 1024, M = NB * SEQ;
constexpr int NH = 16, HD = 64, DSSM = 1024, DCONV = 1536, NST = 128, CHK = 128, NCHK = SEQ / CHK, NPROJ = 6672, NPADN = 6912, DINNER = 2048;
constexpr float EPS = 1e-6f;
constexpr float LOG2E = 1.4426950408889634f;
constexpr float QSCALE = 0.125f * LOG2E;
constexpr int NT = 512, NWV = 8;
constexpr size_t MiB = 1u << 20;
constexpr size_t WS_RSTD = MiB / 2;
constexpr size_t WS_WINT = 1 * MiB;
constexpr size_t WS_WOUTT = 15 * MiB;
constexpr size_t WS_DTRAW = 19 * MiB;
constexpr size_t WS_ACS = 21 * MiB;
constexpr size_t WS_DTS = 23 * MiB;
constexpr size_t WS_LSE = 25 * MiB;
constexpr size_t WS_XB = 32 * MiB;
constexpr size_t WS_ST = 32 * MiB;
constexpr size_t WS_V = 96 * MiB, WS_G = 160 * MiB;
constexpr size_t WS_OUTPRE = 96 * MiB;
constexpr size_t WS_Z = 224 * MiB;
constexpr size_t WS_XBC = 288 * MiB;
constexpr size_t WS_MIX = 384 * MiB;
constexpr size_t WS_END = 512 * MiB;
constexpr int LDS_BYTES = 147456;

struct Args { const float *x, *npw, *w_in, *conv_w, *conv_b, *dt_bias, *a_log, *d_skip, *ssm_nw, *w_out, *npost_w; float* out; unsigned char* ws; int ph_lo, ph_hi; };

__device__ __forceinline__ float bf2f(unsigned u) { return __builtin_bit_cast(float, u << 16); }
__device__ __forceinline__ unsigned f2bf(float f) { unsigned u = __builtin_bit_cast(unsigned, f); return (u + 0x7fffu + ((u >> 16) & 1u)) >> 16; }
__device__ __forceinline__ unsigned pk2(float lo, float hi) { return f2bf(lo) | (f2bf(hi) << 16); }
__device__ __forceinline__ float wave_sum(float v) {
#pragma unroll
    for (int o = 1; o < 64; o <<= 1) v += __shfl_xor(v, o);
    return v;
}
__device__ __forceinline__ float silu_f(float v) { return v / (1.f + __expf(-v)); }
__device__ __forceinline__ float softplus_f(float v) { return v > 20.f ? v : log1pf(__expf(v)); }
#define LDS_WAIT() asm volatile("s_waitcnt lgkmcnt(0)" ::: "memory")

namespace pg8 {
struct EpiProj {
    static constexpr bool PERM = true, AFTER_DRAIN = false;
    bf16 *d0, *d1, *d2, *d3, *d4; bf16* xbc; float* dtraw; const float* rstd;
    __device__ __forceinline__ void operator()(const f32x4 (&acc)[2][2][4][2], const Unit& u, int wr, int wc, int fr, int fq) const {
        const int row0 = u.pm * BM + wr * 64 + fr; const int pn = u.pn;
        if (pn == 26) {
            if (wc == 0 && fq < 2) {
#pragma unroll
                for (int ai = 0; ai < 2; ++ai)
#pragma unroll
                    for (int m = 0; m < 4; ++m) { const int row = row0 + ai * HALF + m * 16; const float rs = rstd[row];
                        float* p = dtraw + (size_t)row * 16 + 8 * fq; *(f32x4*)p = acc[ai][0][m][0] * rs; *(f32x4*)(p + 4) = acc[ai][0][m][1] * rs; }
            }
            return;
        }
        bf16* base; int ldc, colt; float sc = 1.f;
        if (pn < 20) { const int sel = pn >> 2; base = sel == 0 ? d0 : sel == 1 ? d1 : sel == 2 ? d2 : sel == 3 ? d3 : d4; ldc = 1024; colt = (pn & 3) * BM; if (pn < 4) sc = QSCALE; }
        else { base = xbc; ldc = DCONV; colt = (pn - 20) * BM; }
        const int col0 = colt + wc * 32 + 8 * fq;
#pragma unroll
        for (int ai = 0; ai < 2; ++ai)
#pragma unroll
            for (int m = 0; m < 4; ++m) { const int row = row0 + ai * HALF + m * 16; const float rs = rstd[row] * sc; bf16* rowp = base + (size_t)row * ldc + col0;
#pragma unroll
                for (int bj = 0; bj < 2; ++bj) { const f32x4 v0 = acc[ai][bj][m][0] * rs, v1 = acc[ai][bj][m][1] * rs;
                    u32x4 w; w.x = cvt_pk_bf16(v0[0], v0[1]); w.y = cvt_pk_bf16(v0[2], v0[3]); w.z = cvt_pk_bf16(v1[0], v1[1]); w.w = cvt_pk_bf16(v1[2], v1[3]);
                    *(u32x4*)(rowp + bj * HALF) = w; } }
    }
};
struct EpiF32 {
    static constexpr bool PERM = true, AFTER_DRAIN = false;
    float* O; int ldc;
    __device__ __forceinline__ void operator()(const f32x4 (&acc)[2][2][4][2], const Unit& u, int wr, int wc, int fr, int fq) const {
        const int row0 = u.pm * BM + wr * 64 + fr, col0 = u.pn * BM + wc * 32 + 8 * fq;
#pragma unroll
        for (int ai = 0; ai < 2; ++ai)
#pragma unroll
            for (int m = 0; m < 4; ++m) { float* rowp = O + (size_t)(row0 + ai * HALF + m * 16) * ldc + col0;
#pragma unroll
                for (int bj = 0; bj < 2; ++bj) { *(f32x4*)(rowp + bj * HALF) = acc[ai][bj][m][0]; *(f32x4*)(rowp + bj * HALF + 4) = acc[ai][bj][m][1]; } }
    }
};
}
__device__ __forceinline__ void transpose_item(const float* W, int K, int N, bf16* WT, const float* kscale, LAS float* scr, int item, int lane) {
    const int nblk = (N + 31) / 32, kb = item / nblk, nb = item % nblk, k0 = 64 * kb, n0 = 32 * nb;
    const int nn = n0 + (lane & 31);
#pragma unroll 8
    for (int i = 0; i < 32; ++i) { const int kk = 2 * i + (lane >> 5); float v = (nn < N) ? W[(size_t)(k0 + kk) * N + nn] : 0.f; if (kscale) v *= kscale[k0 + kk]; scr[kk * 33 + (lane & 31)] = v; }
    LDS_WAIT();
    const int c = lane & 7;
#pragma unroll
    for (int j = 0; j < 4; ++j) { const int n = (lane >> 3) + 8 * j; const LAS float* s = scr + (8 * c) * 33 + n;
        u32x4 o; o.x = pk2(s[0 * 33], s[1 * 33]); o.y = pk2(s[2 * 33], s[3 * 33]); o.z = pk2(s[4 * 33], s[5 * 33]); o.w = pk2(s[6 * 33], s[7 * 33]);
        if (n0 + n < N) *(u32x4*)(WT + (size_t)(n0 + n) * K + k0 + 8 * c) = o; }
    LDS_WAIT();
}
__device__ __forceinline__ void phase_prep(const Args& a, LAS unsigned char* lds, int gw, int NGW, int wave, int lane) {
    LAS float* scr = (LAS float*)(lds + wave * 16384);
    bf16* WINT = (bf16*)(a.ws + WS_WINT); bf16* WOUTT = (bf16*)(a.ws + WS_WOUTT); bf16* XB = (bf16*)(a.ws + WS_XB); float* RSTD = (float*)(a.ws + WS_RSTD);
    constexpr int I_IN = (DM / 64) * ((NPROJ + 31) / 32), I_OUT = (DINNER / 64) * (DM / 32);
    for (int it = gw; it < I_IN + I_OUT; it += NGW) {
        if (it < I_IN) transpose_item(a.w_in, DM, NPROJ, WINT, a.npw, scr, it, lane);
        else transpose_item(a.w_out, DINNER, DM, WOUTT, nullptr, scr, it - I_IN, lane);
    }
    for (int m = gw; m < M; m += NGW) {
        const f32x4* xr = (const f32x4*)(a.x + (size_t)m * DM) + lane;
        f32x4 v[4]; float s = 0.f;
#pragma unroll
        for (int j = 0; j < 4; ++j) { v[j] = xr[64 * j]; s += (v[j].x * v[j].x + v[j].y * v[j].y) + (v[j].z * v[j].z + v[j].w * v[j].w); }
        s = wave_sum(s);
        if (lane == 0) RSTD[m] = 1.f / sqrtf(s * (1.f / DM) + EPS);
        u32x2* o8 = (u32x2*)(XB + (size_t)m * DM) + lane;
#pragma unroll
        for (int j = 0; j < 4; ++j) { u32x2 o; o.x = pk2(v[j].x, v[j].y); o.y = pk2(v[j].z, v[j].w); o8[64 * j] = o; }
    }
}

__device__ __forceinline__ void naive_attn(const Args& a, int gw, int NGW, int lane) {
    const bf16* Q = (const bf16*)a.out; const bf16* K = Q + (size_t)M * 1024; const bf16* V = (const bf16*)(a.ws + WS_V); const bf16* G = (const bf16*)(a.ws + WS_G);
    bf16* MIX = (bf16*)(a.ws + WS_MIX);
    for (int it = gw; it < M * NH; it += NGW) {
        const int row = it >> 4, h = it & 15, t = row & (SEQ - 1), b = row >> 12;
        const float q = bf2f(Q[(size_t)row * 1024 + h * 64 + lane]);
        float op[3], lsep[3];
#pragma unroll
        for (int p = 0; p < 3; ++p) {
            const int d = (p == 0) ? 1 : (p == 1 ? 4 : 16);
            float m = -INFINITY, l = 0.f, o = 0.f;
            for (int j = 0; j <= 128; ++j) {
                const int tk = t - j * d; if (tk < 0) break;
                const size_t kr = ((size_t)(b * SEQ + tk)) * 1024 + h * 64 + lane;
                const float s = wave_sum(q * bf2f(K[kr]));
                const float mn = fmaxf(m, s), sc = exp2f(m - mn), pe = exp2f(s - mn);
                l = l * sc + pe; o = o * sc + pe * bf2f(V[kr]); m = mn;
            }
            op[p] = o / l; lsep[p] = m + log2f(l);
        }
        const float mm = fmaxf(lsep[0], fmaxf(lsep[1], lsep[2]));
        const float w0 = exp2f(lsep[0] - mm), w1 = exp2f(lsep[1] - mm), w2 = exp2f(lsep[2] - mm);
        float r = (w0 * op[0] + w1 * op[1] + w2 * op[2]) / (w0 + w1 + w2);
        r *= silu_f(bf2f(G[(size_t)row * 1024 + h * 64 + lane]));
        MIX[(size_t)row * DINNER + h * 64 + lane] = (bf16)f2bf(r);
    }
}
__device__ __forceinline__ void naive_conv(const Args& a, int gt, int NGT) {
    const bf16* XBC = (const bf16*)(a.ws + WS_XBC); bf16* XC = (bf16*)a.out; const float* DTRAW = (const float*)(a.ws + WS_DTRAW); float* DTS = (float*)(a.ws + WS_DTS);
    for (size_t i = gt; i < (size_t)M * DCONV; i += NGT) {
        const int row = (int)(i / DCONV), ch = (int)(i % DCONV), t = row & (SEQ - 1);
        float acc = a.conv_b[ch];
#pragma unroll
        for (int k = 0; k < 4; ++k) { const int tt = t - 3 + k; if (tt >= 0) acc += a.conv_w[k * DCONV + ch] * bf2f(XBC[(size_t)(row - 3 + k) * DCONV + ch]); }
        XC[i] = (bf16)f2bf(silu_f(acc));
    }
    for (int i = gt; i < M * NH; i += NGT) DTS[i] = softplus_f(DTRAW[i] + a.dt_bias[i & 15]);
}
__device__ __forceinline__ void naive_ssd(const Args& a, int gw, int NGW, int lane) {
    const bf16* XC = (const bf16*)a.out; const float* DTS = (const float*)(a.ws + WS_DTS); float* Y = (float*)(a.ws + WS_OUTPRE);
    for (int it = gw; it < NB * NH * HD; it += NGW) {
        const int p = it & 63, h = (it >> 6) & 15, b = it >> 10, g = h >> 3;
        const float av = -__expf(a.a_log[h]), dsk = a.d_skip[h];
        float h0 = 0.f, h1 = 0.f;
        for (int t = 0; t < SEQ; ++t) {
            const size_t row = (size_t)b * SEQ + t; const bf16* xr = XC + row * DCONV;
            const float dt = DTS[row * 16 + h], dA = __expf(dt * av), x = bf2f(xr[h * 64 + p]);
            const float B0 = bf2f(xr[1024 + g * 128 + lane]), B1 = bf2f(xr[1024 + g * 128 + 64 + lane]);
            const float C0 = bf2f(xr[1280 + g * 128 + lane]), C1 = bf2f(xr[1280 + g * 128 + 64 + lane]);
            h0 = h0 * dA + dt * x * B0; h1 = h1 * dA + dt * x * B1;
            const float y = wave_sum(C0 * h0 + C1 * h1) + dsk * x;
            if (lane == 0) Y[row * 1024 + h * 64 + p] = y;
        }
    }
}
__device__ __forceinline__ void naive_gnorm(const Args& a, int gw, int NGW, int lane) {
    const float* Y = (const float*)(a.ws + WS_OUTPRE); const bf16* Z = (const bf16*)(a.ws + WS_Z); bf16* MIX = (bf16*)(a.ws + WS_MIX);
    for (int it = gw; it < M * 2; it += NGW) {
        const int row = it >> 1, g = it & 1; const int c0 = g * 512 + lane * 8;
        float v[8]; float ss = 0.f;
#pragma unroll
        for (int j = 0; j < 8; ++j) { const float y = Y[(size_t)row * 1024 + c0 + j], z = bf2f(Z[(size_t)row * 1024 + c0 + j]); v[j] = y * silu_f(z); ss += v[j] * v[j]; }
        ss = wave_sum(ss); const float r = 1.f / sqrtf(ss * (1.f / 512.f) + EPS);
#pragma unroll
        for (int j = 0; j < 8; ++j) MIX[(size_t)row * DINNER + 1024 + c0 + j] = (bf16)f2bf(v[j] * r * a.ssm_nw[c0 + j]);
    }
}
__device__ __forceinline__ void phase_final(const Args& a, int gw, int NGW, int lane) {
    const float* OP = (const float*)(a.ws + WS_OUTPRE);
    for (int m = gw; m < M; m += NGW) {
        const f32x4* pr = (const f32x4*)(OP + (size_t)m * DM) + lane; const f32x4* xr = (const f32x4*)(a.x + (size_t)m * DM) + lane; const f32x4* wr = (const f32x4*)a.npost_w + lane;
        f32x4 v[4]; float s = 0.f;
#pragma unroll
        for (int j = 0; j < 4; ++j) { v[j] = pr[64 * j]; s += (v[j].x * v[j].x + v[j].y * v[j].y) + (v[j].z * v[j].z + v[j].w * v[j].w); }
        s = wave_sum(s); const float r = 1.f / sqrtf(s * (1.f / DM) + EPS);
        f32x4* orow = (f32x4*)(a.out + (size_t)m * DM) + lane;
#pragma unroll
        for (int j = 0; j < 4; ++j) orow[64 * j] = xr[64 * j] + v[j] * r * wr[64 * j];
    }
}
constexpr int AP2 = 144;
constexpr int ATT_Q = 0, ATT_K = 128 * AP2, ATT_V = ATT_K + 256 * AP2, ATT_END = ATT_V + 272 * AP2;
static_assert(ATT_END <= 131072, "attention LDS");
#define MFMA16(a, b, c) __builtin_amdgcn_mfma_f32_16x16x32_bf16((a), (b), (c), 0, 0, 0)
__device__ __forceinline__ s16x4 tr_read(const LAS unsigned char* p) { return __builtin_bit_cast(s16x4, __builtin_amdgcn_ds_read_tr16_b64_v4i16((LAS s16x4*)p)); }
__device__ __forceinline__ bf16x8 cat8(s16x4 lo, s16x4 hi) { return (bf16x8){lo[0], lo[1], lo[2], lo[3], hi[0], hi[1], hi[2], hi[3]}; }
__device__ __forceinline__ bf16x8 pack8(f32x4 lo, f32x4 hi) { u32x4 w; w.x = pk2(lo[0], lo[1]); w.y = pk2(lo[2], lo[3]); w.z = pk2(hi[0], hi[1]); w.w = pk2(hi[2], hi[3]); return __builtin_bit_cast(bf16x8, w); }
__device__ __forceinline__ f32x4 unpack4(u32x2 v) { return (f32x4){bf2f(v.x & 0xffffu), bf2f(v.x >> 16), bf2f(v.y & 0xffffu), bf2f(v.y >> 16)}; }
__device__ __forceinline__ u32x2 pack4(f32x4 v) { u32x2 o; o.x = pk2(v[0], v[1]); o.y = pk2(v[2], v[3]); return o; }

__device__ __forceinline__ void phase_attn(const Args& a, LAS unsigned char* lds, int tid, int wave, int lane) {
    const bf16* Q = (const bf16*)a.out; const bf16* K = Q + (size_t)M * 1024; const bf16* V = (const bf16*)(a.ws + WS_V); const bf16* Gt = (const bf16*)(a.ws + WS_G);
    bf16* MIX = (bf16*)(a.ws + WS_MIX); float* LSE = (float*)(a.ws + WS_LSE);
    const int li = lane & 15, quad = lane >> 4;
    for (int i = tid; i < 16 * AP2 / 4; i += NT) ((LAS unsigned*)(lds + ATT_V + 256 * AP2))[i] = 0u;
    for (int unit = blockIdx.x; unit < NB * NH * 2; unit += gridDim.x) {
        const int half = unit & 1, h = (unit >> 1) & 15, b = unit >> 5;
        const size_t rowb = (size_t)b * SEQ;
        for (int st = 0; st < 48; ++st) {
            int d, r, qi0;
            if (st < 16) { d = 16; r = st; qi0 = half * 128; }
            else if (st < 32) { d = 4; r = (st - 16) >> 2; qi0 = half * 512 + ((st - 16) & 3) * 128; }
            else { d = 1; r = 0; qi0 = half * 2048 + (st - 32) * 128; }
            const int kb0 = qi0 - 128;
            __syncthreads();
            {   const int c = tid & 7, r0 = tid >> 3;
#pragma unroll
                for (int i = 0; i < 2; ++i) { const int rr = r0 + 64 * i; const size_t grow = rowb + (size_t)(qi0 + rr) * d + r;
                    *(LAS u32x4*)(lds + ATT_Q + rr * AP2 + c * 16) = *(const u32x4*)(Q + grow * 1024 + h * 64 + c * 8); }
#pragma unroll
                for (int i = 0; i < 4; ++i) { const int rr = r0 + 64 * i; const int ks = kb0 + rr; u32x4 kv = {0u, 0u, 0u, 0u}, vv = {0u, 0u, 0u, 0u};
                    if (ks >= 0) { const size_t grow = rowb + (size_t)ks * d + r; kv = *(const u32x4*)(K + grow * 1024 + h * 64 + c * 8); vv = *(const u32x4*)(V + grow * 1024 + h * 64 + c * 8); }
                    *(LAS u32x4*)(lds + ATT_K + rr * AP2 + c * 16) = kv; *(LAS u32x4*)(lds + ATT_V + rr * AP2 + c * 16) = vv; }
            }
            __syncthreads();
            const LAS unsigned char* qp = lds + ATT_Q + (16 * wave + li) * AP2 + quad * 16;
            const bf16x8 bq0 = *(const LAS bf16x8*)qp, bq1 = *(const LAS bf16x8*)(qp + 64);
            f32x4 sc[9];
#pragma unroll
            for (int kt = 0; kt < 9; ++kt) { const LAS unsigned char* kp = lds + ATT_K + (16 * (wave + kt) + li) * AP2 + quad * 16;
                const bf16x8 a0 = *(const LAS bf16x8*)kp, a1 = *(const LAS bf16x8*)(kp + 64);
                f32x4 z = {0.f, 0.f, 0.f, 0.f}; z = MFMA16(a0, bq0, z); z = MFMA16(a1, bq1, z); sc[kt] = z; }
            float mx = -INFINITY;
#pragma unroll
            for (int kt = 0; kt < 9; ++kt)
#pragma unroll
                for (int j = 0; j < 4; ++j) { const int rel = 16 * kt + quad * 4 + j - li, kabs = kb0 + 16 * (wave + kt) + quad * 4 + j;
                    const bool valid = (rel >= 0) && (rel <= 128) && (kabs >= 0);
                    const float s = valid ? sc[kt][j] : -INFINITY; sc[kt][j] = s; mx = fmaxf(mx, s); }
            mx = fmaxf(mx, __shfl_xor(mx, 16)); mx = fmaxf(mx, __shfl_xor(mx, 32));
            float l = 0.f;
#pragma unroll
            for (int kt = 0; kt < 9; ++kt)
#pragma unroll
                for (int j = 0; j < 4; ++j) { const float p = __builtin_amdgcn_exp2f(sc[kt][j] - mx); sc[kt][j] = p; l += p; }
            l += __shfl_xor(l, 16); l += __shfl_xor(l, 32);
            bf16x8 bp[5];
#pragma unroll
            for (int kp = 0; kp < 4; ++kp) bp[kp] = pack8(sc[2 * kp], sc[2 * kp + 1]);
            bp[4] = pack8(sc[8], (f32x4){0.f, 0.f, 0.f, 0.f});
            f32x4 o[4];
            const LAS unsigned char* vb = lds + ATT_V + (16 * wave + 4 * quad + (li >> 2)) * AP2 + (li & 3) * 8;
#pragma unroll
            for (int dt = 0; dt < 4; ++dt) { f32x4 acc = {0.f, 0.f, 0.f, 0.f};
#pragma unroll
                for (int kp = 0; kp < 5; ++kp) { const LAS unsigned char* p1 = vb + (32 * kp) * AP2 + dt * 32;
                    const s16x4 lo = tr_read(p1), hi = tr_read(p1 + 16 * AP2); acc = MFMA16(cat8(lo, hi), bp[kp], acc); }
                o[dt] = acc; }
            const size_t grow = rowb + (size_t)(qi0 + 16 * wave + li) * d + r;
            bf16* mp = MIX + grow * DINNER + h * 64 + 4 * quad;
            const float lse_t = mx + __builtin_amdgcn_logf(l), inv_l = 1.f / l;
            if (st < 16) {
#pragma unroll
                for (int dt = 0; dt < 4; ++dt) *(u32x2*)(mp + 16 * dt) = pack4(o[dt] * inv_l);
                if (quad == 0) LSE[grow * 16 + h] = lse_t;
            } else {
                const float lse_p = LSE[grow * 16 + h], mm = fmaxf(lse_p, lse_t), wa = __builtin_amdgcn_exp2f(lse_p - mm), wb = __builtin_amdgcn_exp2f(lse_t - mm);
                const float inv = 1.f / (wa + wb), ca = wa * inv, cb = wb * inv * inv_l;
#pragma unroll
                for (int dt = 0; dt < 4; ++dt) { f32x4 v = unpack4(*(const u32x2*)(mp + 16 * dt)) * ca + o[dt] * cb;
                    if (st >= 32) { const f32x4 g = unpack4(*(const u32x2*)(Gt + grow * 1024 + h * 64 + 4 * quad + 16 * dt));
                        v[0] *= silu_f(g[0]); v[1] *= silu_f(g[1]); v[2] *= silu_f(g[2]); v[3] *= silu_f(g[3]); }
                    *(u32x2*)(mp + 16 * dt) = pack4(v); }
                if (st < 32 && quad == 0) LSE[grow * 16 + h] = mm + __builtin_amdgcn_logf(wa + wb);
            }
            asm volatile("s_waitcnt vmcnt(0)" ::: "memory");
        }
    }
    __syncthreads();
}
__device__ __forceinline__ void conv8(const bf16* XBC, size_t row, int t, int ch0, const float* cw, const float* cb, f32x4& o0, f32x4& o1) {
    f32x4 a0 = *(const f32x4*)(cb + ch0), a1 = *(const f32x4*)(cb + ch0 + 4);
#pragma unroll
    for (int k = 0; k < 4; ++k) {
        if (t - 3 + k >= 0) { const u32x4 v = *(const u32x4*)(XBC + (row - 3 + k) * DCONV + ch0);
            const f32x4 w0 = *(const f32x4*)(cw + k * DCONV + ch0), w1 = *(const f32x4*)(cw + k * DCONV + ch0 + 4);
            a0 += w0 * (f32x4){bf2f(v.x & 0xffffu), bf2f(v.x >> 16), bf2f(v.y & 0xffffu), bf2f(v.y >> 16)};
            a1 += w1 * (f32x4){bf2f(v.z & 0xffffu), bf2f(v.z >> 16), bf2f(v.w & 0xffffu), bf2f(v.w >> 16)}; }
    }
    o0 = (f32x4){silu_f(a0[0]), silu_f(a0[1]), silu_f(a0[2]), silu_f(a0[3])}; o1 = (f32x4){silu_f(a1[0]), silu_f(a1[1]), silu_f(a1[2]), silu_f(a1[3])};
}
constexpr int BP2 = 272;
constexpr int SS_B = 0, SS_C = 128 * BP2, SS_XS = 2 * 128 * BP2, SS_XD = SS_XS + 128 * AP2, SS_XW = SS_XD + 128 * AP2, SS_ACS = SS_XW + 128 * AP2, SS_DT = SS_ACS + 4096, SS_END = SS_DT + 4096;
static_assert(SS_END <= LDS_BYTES, "ssd LDS");

__device__ __forceinline__ void phase_ssd_chunk(const Args& a, LAS unsigned char* lds, int tid, int wave, int lane) {
    const bf16* XBC = (const bf16*)(a.ws + WS_XBC); const float* DTRAW = (const float*)(a.ws + WS_DTRAW); float* ACS = (float*)(a.ws + WS_ACS);
    bf16* MIX = (bf16*)(a.ws + WS_MIX); bf16* ST = (bf16*)(a.ws + WS_ST);
    const int li = lane & 15, quad = lane >> 4, w = wave;
    LAS float* ACSs = (LAS float*)(lds + SS_ACS); LAS float* DTs = (LAS float*)(lds + SS_DT);
    for (int unit = blockIdx.x; unit < NB * NCHK * 2; unit += gridDim.x) {
        const int g = unit & 1, c = (unit >> 1) & 31, b = unit >> 6;
        const size_t row0 = (size_t)b * SEQ + c * CHK; const int t0 = c * CHK;
        __syncthreads();
#pragma unroll 2
        for (int i = 0; i < 8; ++i) { const int item = i * NT + tid, cc = item & 31, l = item >> 5;
            const int ch0 = (cc < 16) ? (1024 + g * 128 + cc * 8) : (1280 + g * 128 + (cc - 16) * 8);
            f32x4 o0, o1; conv8(XBC, row0 + l, t0 + l, ch0, a.conv_w, a.conv_b, o0, o1);
            *(LAS bf16x8*)(lds + ((cc < 16) ? SS_B : SS_C) + l * BP2 + (cc & 15) * 16) = pack8(o0, o1); }
        {   const int hh = 8 * g + w; const float av = -__expf(a.a_log[hh]), db = a.dt_bias[hh];
            const float d0 = softplus_f(DTRAW[(row0 + 2 * lane) * 16 + hh] + db), d1 = softplus_f(DTRAW[(row0 + 2 * lane + 1) * 16 + hh] + db);
            const float s = (d0 + d1) * av; float inc = s;
#pragma unroll
            for (int o = 1; o < 64; o <<= 1) { const float t = __shfl_up(inc, o); if (lane >= o) inc += t; }
            const float c0 = inc - s + d0 * av, c1 = inc;
            ACSs[w * 128 + 2 * lane] = c0; ACSs[w * 128 + 2 * lane + 1] = c1; DTs[w * 128 + 2 * lane] = d0; DTs[w * 128 + 2 * lane + 1] = d1;
            ACS[(row0 + 2 * lane) * 16 + hh] = c0; ACS[(row0 + 2 * lane + 1) * 16 + hh] = c1; }
        __syncthreads();
        const int npair = (w >> 1) + 1;
        f32x4 cbt[8];
        {   bf16x8 bc[4];
#pragma unroll
            for (int ks = 0; ks < 4; ++ks) bc[ks] = *(const LAS bf16x8*)(lds + SS_C + (16 * w + li) * BP2 + ks * 64 + quad * 16);
#pragma unroll
            for (int st = 0; st < 8; ++st) { f32x4 z = {0.f, 0.f, 0.f, 0.f};
                if (st < 2 * npair) {
#pragma unroll
                    for (int ks = 0; ks < 4; ++ks) z = MFMA16(*(const LAS bf16x8*)(lds + SS_B + (16 * st + li) * BP2 + ks * 64 + quad * 16), bc[ks], z); }
                cbt[st] = z; } }
        for (int hh = 0; hh < 8; ++hh) {
            const int h = 8 * g + hh; const float dsk = a.d_skip[h];
            __syncthreads();
            const float alast = ACSs[hh * 128 + 127];
#pragma unroll
            for (int i = 0; i < 2; ++i) { const int item = i * NT + tid, cc = item & 7, l = item >> 3;
                f32x4 o0, o1; conv8(XBC, row0 + l, t0 + l, h * 64 + cc * 8, a.conv_w, a.conv_b, o0, o1);
                const float dt = DTs[hh * 128 + l], dw = dt * __expf(alast - ACSs[hh * 128 + l]);
                *(LAS bf16x8*)(lds + SS_XS + l * AP2 + cc * 16) = pack8(o0, o1);
                *(LAS bf16x8*)(lds + SS_XD + l * AP2 + cc * 16) = pack8(o0 * dt, o1 * dt);
                *(LAS bf16x8*)(lds + SS_XW + l * AP2 + cc * 16) = pack8(o0 * dw, o1 * dw); }
            __syncthreads();
            const float al = ACSs[hh * 128 + 16 * w + li];
            f32x4 o[4];
#pragma unroll
            for (int pt = 0; pt < 4; ++pt) o[pt] = (f32x4){0.f, 0.f, 0.f, 0.f};
            const LAS unsigned char* xdb = lds + SS_XD + (4 * quad + (li >> 2)) * AP2 + (li & 3) * 8;
#pragma unroll
            for (int kp = 0; kp < 4; ++kp) {
                if (kp < npair) {
                    f32x4 lt[2];
#pragma unroll
                    for (int t = 0; t < 2; ++t) { const f32x4 as = *(const LAS f32x4*)(ACSs + hh * 128 + 16 * (2 * kp + t) + 4 * quad);
#pragma unroll
                        for (int e = 0; e < 4; ++e) { const int s = 16 * (2 * kp + t) + 4 * quad + e; lt[t][e] = (s <= 16 * w + li) ? cbt[2 * kp + t][e] * __expf(al - as[e]) : 0.f; } }
                    const bf16x8 bp = pack8(lt[0], lt[1]);
#pragma unroll
                    for (int pt = 0; pt < 4; ++pt) { const LAS unsigned char* p1 = xdb + (32 * kp) * AP2 + pt * 32;
                        o[pt] = MFMA16(cat8(tr_read(p1), tr_read(p1 + 16 * AP2)), bp, o[pt]); }
                }
            }
#pragma unroll
            for (int pt = 0; pt < 4; ++pt) { const f32x4 xs = unpack4(*(const LAS u32x2*)(lds + SS_XS + (16 * w + li) * AP2 + (16 * pt + 4 * quad) * 2));
                *(u32x2*)(MIX + (row0 + 16 * w + li) * DINNER + 1024 + h * 64 + 16 * pt + 4 * quad) = pack4(o[pt] + xs * dsk); }
            f32x4 sa[4];
#pragma unroll
            for (int pt = 0; pt < 4; ++pt) sa[pt] = (f32x4){0.f, 0.f, 0.f, 0.f};
            const LAS unsigned char* bb = lds + SS_B + (8 * quad + (li >> 2)) * BP2 + (16 * w + 4 * (li & 3)) * 2;
            const LAS unsigned char* xwb = lds + SS_XW + (8 * quad + (li >> 2)) * AP2 + (li & 3) * 8;
#pragma unroll
            for (int ks = 0; ks < 4; ++ks) { const bf16x8 aB = cat8(tr_read(bb + (32 * ks) * BP2), tr_read(bb + (32 * ks + 4) * BP2));
#pragma unroll
                for (int pt = 0; pt < 4; ++pt) { const LAS unsigned char* p1 = xwb + (32 * ks) * AP2 + pt * 32;
                    sa[pt] = MFMA16(aB, cat8(tr_read(p1), tr_read(p1 + 4 * AP2)), sa[pt]); } }
            bf16* stp = ST + ((((size_t)b * NCHK + c) * NH + h) * HD) * NST;
#pragma unroll
            for (int pt = 0; pt < 4; ++pt) *(u32x2*)(stp + (size_t)(16 * pt + li) * NST + 16 * w + 4 * quad) = pack4(sa[pt]);
        }
    }
    __syncthreads();
}
__device__ __forceinline__ void phase_scan(const Args& a, int gt, int NGT) {
    bf16* ST = (bf16*)(a.ws + WS_ST); const float* ACS = (const float*)(a.ws + WS_ACS);
    for (int idx = gt; idx < NB * NH * HD * 16; idx += NGT) {
        const int n8 = idx & 15, p = (idx >> 4) & 63, h = (idx >> 10) & 15, b = idx >> 14;
        f32x4 s0 = {0.f, 0.f, 0.f, 0.f}, s1 = {0.f, 0.f, 0.f, 0.f};
        for (int c0 = 0; c0 < NCHK; c0 += 8) {
            u32x4 v[8]; float dec[8];
#pragma unroll
            for (int j = 0; j < 8; ++j) { const int c = c0 + j; v[j] = *(const u32x4*)(ST + ((((size_t)b * NCHK + c) * NH + h) * HD + p) * NST + n8 * 8);
                dec[j] = __expf(ACS[((size_t)b * SEQ + c * CHK + 127) * 16 + h]); }
#pragma unroll
            for (int j = 0; j < 8; ++j) { const int c = c0 + j;
                u32x4 o; o.x = pk2(s0[0], s0[1]); o.y = pk2(s0[2], s0[3]); o.z = pk2(s1[0], s1[1]); o.w = pk2(s1[2], s1[3]);
                *(u32x4*)(ST + ((((size_t)b * NCHK + c) * NH + h) * HD + p) * NST + n8 * 8) = o;
                s0 = s0 * dec[j] + (f32x4){bf2f(v[j].x & 0xffffu), bf2f(v[j].x >> 16), bf2f(v[j].y & 0xffffu), bf2f(v[j].y >> 16)};
                s1 = s1 * dec[j] + (f32x4){bf2f(v[j].z & 0xffffu), bf2f(v[j].z >> 16), bf2f(v[j].w & 0xffffu), bf2f(v[j].w >> 16)}; }
        }
    }
}
__device__ __forceinline__ void phase_ssd_out(const Args& a, LAS unsigned char* lds, int tid, int wave, int lane) {
    const bf16* XBC = (const bf16*)(a.ws + WS_XBC); const float* ACS = (const float*)(a.ws + WS_ACS); const bf16* Z = (const bf16*)(a.ws + WS_Z);
    bf16* MIX = (bf16*)(a.ws + WS_MIX); const bf16* ST = (const bf16*)(a.ws + WS_ST);
    const int li = lane & 15, quad = lane >> 4, w = wave;
    for (int unit = blockIdx.x; unit < NB * NCHK * 2; unit += gridDim.x) {
        const int g = unit & 1, c = (unit >> 1) & 31, b = unit >> 6;
        const size_t row0 = (size_t)b * SEQ + c * CHK; const int t0 = c * CHK;
        __syncthreads();
#pragma unroll 2
        for (int i = 0; i < 4; ++i) { const int item = i * NT + tid, cc = item & 15, l = item >> 4;
            f32x4 o0, o1; conv8(XBC, row0 + l, t0 + l, 1280 + g * 128 + cc * 8, a.conv_w, a.conv_b, o0, o1);
            *(LAS bf16x8*)(lds + SS_C + l * BP2 + cc * 16) = pack8(o0, o1); }
        __syncthreads();
        bf16x8 bc[4];
#pragma unroll
        for (int ks = 0; ks < 4; ++ks) bc[ks] = *(const LAS bf16x8*)(lds + SS_C + (16 * w + li) * BP2 + ks * 64 + quad * 16);
        const size_t row = row0 + 16 * w + li;
        f32x4 yz[8][4]; float ss = 0.f;
#pragma unroll
        for (int hh = 0; hh < 8; ++hh) {
            const int h = 8 * g + hh; const float el = __expf(ACS[row * 16 + h]);
            const bf16* pv = ST + ((((size_t)b * NCHK + c) * NH + h) * HD) * NST;
#pragma unroll
            for (int pt = 0; pt < 4; ++pt) { f32x4 acc = {0.f, 0.f, 0.f, 0.f};
#pragma unroll
                for (int ks = 0; ks < 4; ++ks) acc = MFMA16(*(const bf16x8*)(pv + (size_t)(16 * pt + li) * NST + ks * 32 + quad * 8), bc[ks], acc);
                const int col = h * 64 + 16 * pt + 4 * quad;
                const f32x4 yd = unpack4(*(const u32x2*)(MIX + row * DINNER + 1024 + col)), z = unpack4(*(const u32x2*)(Z + row * 1024 + col));
                f32x4 y = acc * el + yd; y[0] *= silu_f(z[0]); y[1] *= silu_f(z[1]); y[2] *= silu_f(z[2]); y[3] *= silu_f(z[3]);
                ss += (y[0] * y[0] + y[1] * y[1]) + (y[2] * y[2] + y[3] * y[3]); yz[hh][pt] = y; }
        }
        ss += __shfl_xor(ss, 16); ss += __shfl_xor(ss, 32);
        const float r = 1.f / sqrtf(ss * (1.f / 512.f) + EPS);
#pragma unroll
        for (int hh = 0; hh < 8; ++hh)
#pragma unroll
            for (int pt = 0; pt < 4; ++pt) { const int col = (8 * g + hh) * 64 + 16 * pt + 4 * quad; const f32x4 wv = *(const f32x4*)(a.ssm_nw + col);
                *(u32x2*)(MIX + row * DINNER + 1024 + col) = pack4(yz[hh][pt] * wv * r); }
    }
    __syncthreads();
}
#ifndef ONE_LAUNCH
#define ONE_LAUNCH 1
#endif
constexpr int NPHASE = 8;
__global__ void __launch_bounds__(NT, 2) hybrid_fwd(Args a) {
    extern __shared__ __attribute__((aligned(16))) unsigned char lds_raw[];
    LAS unsigned char* lds = (LAS unsigned char*)lds_raw;
    const int tid = threadIdx.x, lane = tid & 63, wave = __builtin_amdgcn_readfirstlane(tid >> 6);
    const int G = gridDim.x, gw = blockIdx.x * NWV + wave, NGW = G * NWV, gt = blockIdx.x * NT + tid, NGT = G * NT;
    const int lo = a.ph_lo, hi = a.ph_hi;
#define IN(k) (lo <= (k) && (k) < hi)
#define SEAM(k) do { if (IN(k) && IN((k) + 1)) { cg::this_grid().sync(); } } while (0)
    if (IN(0)) { phase_prep(a, lds, gw, NGW, wave, lane); __syncthreads(); } SEAM(0);
    if (IN(1)) {
        pg8::Gemm g{(const bf16*)(a.ws + WS_XB), (const bf16*)(a.ws + WS_WINT), M, NPADN, DM}; pg8::StaticOrder S; S.init(M, NPADN, G, (int)blockIdx.x);
        pg8::EpiProj E; E.d0 = (bf16*)a.out; E.d1 = (bf16*)a.out + (size_t)M * 1024; E.d2 = (bf16*)(a.ws + WS_V); E.d3 = (bf16*)(a.ws + WS_G); E.d4 = (bf16*)(a.ws + WS_Z);
        E.xbc = (bf16*)(a.ws + WS_XBC); E.dtraw = (float*)(a.ws + WS_DTRAW); E.rstd = (const float*)(a.ws + WS_RSTD);
        pg8::gemm_phase<pg8::EpiProj, pg8::StaticOrder, true, true>(lds, g, S, E);
    } SEAM(1);
    if (IN(2)) phase_attn(a, lds, tid, wave, lane); SEAM(2);
    if (IN(3)) phase_ssd_chunk(a, lds, tid, wave, lane); SEAM(3);
    if (IN(4)) phase_scan(a, gt, NGT); SEAM(4);
    if (IN(5)) phase_ssd_out(a, lds, tid, wave, lane); SEAM(5);
    if (IN(6)) {
        pg8::Gemm g{(const bf16*)(a.ws + WS_MIX), (const bf16*)(a.ws + WS_WOUTT), M, DM, DINNER}; pg8::StaticOrder S; S.init(M, DM, G, (int)blockIdx.x);
        pg8::EpiF32 E{(float*)(a.ws + WS_OUTPRE), DM};
        pg8::gemm_phase<pg8::EpiF32, pg8::StaticOrder, true, true>(lds, g, S, E);
    } SEAM(6);
    if (IN(7)) phase_final(a, gw, NGW, lane);
#undef IN
#undef SEAM
}

extern "C" void kernel_launch(void* const* d_in, const int* in_sizes, int n_in, void* d_out, int out_size, void* d_ws, size_t ws_size, hipStream_t stream) {
    static int grid = 0;
    if (grid == 0) {
        if (n_in != 11 || out_size != M * DM || ws_size < WS_END) { fprintf(stderr, "kernel_launch: unexpected shapes (n_in %d out %d ws %zu)\n", n_in, out_size, ws_size); grid = -1; return; }
        int dev = 0, cus = 0, per_cu = 0;
        (void)hipGetDevice(&dev); (void)hipDeviceGetAttribute(&cus, hipDeviceAttributeMultiprocessorCount, dev);
        if (hipFuncSetAttribute((const void*)hybrid_fwd, hipFuncAttributeMaxDynamicSharedMemorySize, LDS_BYTES) != hipSuccess) { fprintf(stderr, "kernel_launch: hipFuncSetAttribute failed\n"); grid = -1; return; }
        if (hipOccupancyMaxActiveBlocksPerMultiprocessor(&per_cu, (const void*)hybrid_fwd, NT, LDS_BYTES) != hipSuccess || per_cu < 1) { fprintf(stderr, "kernel_launch: occupancy query says %d\n", per_cu); per_cu = 1; }
        (void)hipGetLastError();
        grid = cus * 1;
        fprintf(stderr, "kernel_launch: cus %d per_cu %d grid %d\n", cus, per_cu, grid);
    }
    if (grid < 0) return;
    Args a{};
    a.x = (const float*)d_in[0]; a.npw = (const float*)d_in[1]; a.w_in = (const float*)d_in[2]; a.conv_w = (const float*)d_in[3]; a.conv_b = (const float*)d_in[4];
    a.dt_bias = (const float*)d_in[5]; a.a_log = (const float*)d_in[6]; a.d_skip = (const float*)d_in[7]; a.ssm_nw = (const float*)d_in[8]; a.w_out = (const float*)d_in[9]; a.npost_w = (const float*)d_in[10];
    a.out = (float*)d_out; a.ws = (unsigned char*)d_ws;
#if ONE_LAUNCH
    a.ph_lo = 0; a.ph_hi = NPHASE;
    void* args[] = {&a};
    hipError_t e = hipLaunchCooperativeKernel((const void*)hybrid_fwd, dim3(grid), dim3(NT), args, LDS_BYTES, stream);
    if (e != hipSuccess) fprintf(stderr, "cooperative launch failed: %s (grid %d)\n", hipGetErrorString(e), grid);
#else
    for (int p = 0; p < NPHASE; ++p) { a.ph_lo = p; a.ph_hi = p + 1; hipLaunchKernelGGL(hybrid_fwd, dim3(grid), dim3(NT), LDS_BYTES, stream, a); }
#endif
}
```

```cpp
#include <hip/hip_runtime.h>
#include <hip/hip_cooperative_groups.h>
#include <cstdio>
#include <cstdint>
namespace cg = cooperative_groups;
namespace pg8 {
#define PG8_LAS __attribute__((address_space(3)))
typedef unsigned short bf16_t;
typedef short bf16x8 __attribute__((ext_vector_type(8)));
typedef float f32x4 __attribute__((ext_vector_type(4)));
typedef unsigned u32x4 __attribute__((ext_vector_type(4)));
constexpr int BM = 256, BK = 64, HALF = 128, HTB = HALF * BK * 2  , STAGE_BYTES = 8 * HTB, NXCD = 8, WGM = 8;

__host__ __device__ __forceinline__ int lds_byte(int r, int c) { const int st = (r >> 4) * 2 + (c >> 5), rr = r & 15, cc = c & 31, ob = rr * 64 + cc * 2; return st * 1024 + (ob ^ (((ob >> 9) & 1) << 5)); }
__host__ __device__ __forceinline__ void stage_rc(int b, int& R, int& C) { const int st = b / 1024, sb = b % 1024, swz = sb ^ (((sb >> 9) & 1) << 5); R = (st >> 1) * 16 + swz / 64; C = (st & 1) * 32 + (swz % 64) / 2; }
__host__ __device__ __forceinline__ int perm32(int rho) { const int n = rho >> 4, i = rho & 15; return 8 * (i >> 2) + 4 * n + (i & 3); }

struct Unit { int pm, pn; };
struct Gemm { const bf16_t* A; const bf16_t* Bt; int M, N, K; };

struct StaticOrder {
    int nM, nN, nwg, G, c;
    __host__ __device__ void init(int M, int N, int G_, int c_) { nM = M / BM; nN = N / BM; nwg = nM * nN; G = G_; c = c_; }
    __host__ __device__ bool next(int i, Unit& u) const {
        const long L = (long)i * G + c; if (L >= nwg) return false;
        int wgid = (int)L; { const int q = nwg / NXCD, r = nwg % NXCD, xcd = wgid % NXCD, off = wgid / NXCD; wgid = (xcd < r ? xcd * (q + 1) : r * (q + 1) + (xcd - r) * q) + off; }
        const int nig = WGM * nN, gid = wgid / nig, fm = gid * WGM, gsz = (nM - fm) < WGM ? (nM - fm) : WGM;
        u.pm = fm + ((wgid % nig) % gsz); u.pn = (wgid % nig) / gsz; return true;
    }
    __device__ __forceinline__ void a_ready(const Unit&) const {}
    __device__ __forceinline__ void done(const Unit&) const {}
};

__device__ __forceinline__ unsigned cvt_pk_bf16(float lo, float hi) { unsigned r; asm volatile("v_cvt_pk_bf16_f32 %0, %1, %2" : "=v"(r) : "v"(lo), "v"(hi)); return r; }
template <class Epi, class Sched, bool ALIGN_EPI = false, bool SP2 = false>
__device__ __forceinline__ void gemm_phase(PG8_LAS unsigned char* lds, const Gemm g, const Sched& S, const Epi& E) {
    const int tid = threadIdx.x, wid = __builtin_amdgcn_readfirstlane(tid >> 6), lane = tid & 63, wr = wid >> 2, wc = wid & 3, fr = lane & 15, fq = lane >> 4;
    const int K = g.K, nt = K / BK;
    unsigned voffA[2], voffB[2];
#pragma unroll
    for (int i = 0; i < 2; ++i) { int R, C; stage_rc(tid * 16 + i * 8192, R, C); const int Rb = Epi::PERM ? ((R & ~31) + perm32(R & 31)) : R;
        voffA[i] = (unsigned)(R * K + C) * 2u; voffB[i] = (unsigned)(Rb * K + C) * 2u; }
    const size_t kstep = (size_t)(BK * 2);
    const size_t hstep = (size_t)HALF * K * 2;
    const size_t tstep = 2 * hstep;
    const unsigned ldsw = (unsigned)wid * 1024u;
    const int aoff = lds_byte(wr * 64 + fr, fq * 8), boff = lds_byte(wc * 32 + fr, fq * 8);
#define PG8_SA(b, h) (((b) * 2 + (h)) * HTB)
#define PG8_SB(b, h) ((4 + (b) * 2 + (h)) * HTB)
#define PG8_STAGE(bufoff, gbase, voff) do { _Pragma("unroll") for (int _i = 0; _i < 2; ++_i) \
        __builtin_amdgcn_global_load_lds((const unsigned*)((const char*)(gbase) + (voff)[_i]), (PG8_LAS unsigned*)(lds + (bufoff) + ldsw + _i * 8192), 16, 0, 0); } while (0)
#define PG8_LDA(dst, b, h) do { _Pragma("unroll") for (int m = 0; m < 4; ++m) _Pragma("unroll") for (int k = 0; k < 2; ++k) dst[m][k] = *(const PG8_LAS bf16x8*)(lds + PG8_SA(b, h) + aoff + m * 2048 + k * 1024); } while (0)
#define PG8_LDB(dst, b, h) do { _Pragma("unroll") for (int n = 0; n < 2; ++n) _Pragma("unroll") for (int k = 0; k < 2; ++k) dst[n][k] = *(const PG8_LAS bf16x8*)(lds + PG8_SB(b, h) + boff + n * 2048 + k * 1024); } while (0)
#define PG8_MMA(ai, bj, At, Bt) do { __builtin_amdgcn_s_setprio(1); _Pragma("unroll") for (int m = 0; m < 4; ++m) _Pragma("unroll") for (int n = 0; n < 2; ++n) _Pragma("unroll") for (int k = 0; k < 2; ++k) \
        acc[ai][bj][m][n] = __builtin_amdgcn_mfma_f32_16x16x32_bf16(Bt[n][k], At[m][k], acc[ai][bj][m][n], 0, 0, 0); __builtin_amdgcn_s_setprio(0); } while (0)
#define PG8_WAIT_V(n) asm volatile("s_waitcnt vmcnt(" #n ")" ::: "memory")
#define PG8_WAIT_L(n) asm volatile("s_waitcnt lgkmcnt(" #n ")" ::: "memory")
#define PG8_BAR __builtin_amdgcn_s_barrier()
#define PG8_SCHED __builtin_amdgcn_sched_barrier(0)
    Unit cur, nxt; int ui = 0;
    if (!S.next(0, cur)) return;
    f32x4 acc[2][2][4][2];
#pragma unroll
    for (int a = 0; a < 2; ++a)
#pragma unroll
        for (int b = 0; b < 2; ++b)
#pragma unroll
            for (int m = 0; m < 4; ++m)
#pragma unroll
                for (int n = 0; n < 2; ++n) acc[a][b][m][n] = (f32x4){0.f, 0.f, 0.f, 0.f};
    bf16x8 At[4][2], B0[2][2], B1[2][2];
    const char* cA = (const char*)g.A + (size_t)cur.pm * tstep; const char* cB = (const char*)g.Bt + (size_t)cur.pn * tstep;
    S.a_ready(cur);
    if constexpr (SP2) {
        PG8_STAGE(PG8_SB(0, 0), cB, voffB); PG8_STAGE(PG8_SB(0, 1), cB + hstep, voffB); PG8_STAGE(PG8_SA(0, 0), cA, voffA); PG8_STAGE(PG8_SA(0, 1), cA + hstep, voffA);
        if (wr == 1) PG8_BAR;
        PG8_WAIT_V(2); PG8_BAR;
        PG8_STAGE(PG8_SB(1, 0), cB + kstep, voffB); PG8_STAGE(PG8_SA(1, 0), cA + kstep, voffA); PG8_STAGE(PG8_SB(1, 1), cB + hstep + kstep, voffB);
        PG8_WAIT_V(6); PG8_BAR;
    } else {
        PG8_STAGE(PG8_SB(0, 0), cB, voffB); PG8_STAGE(PG8_SA(0, 0), cA, voffA); PG8_STAGE(PG8_SB(0, 1), cB + hstep, voffB); PG8_STAGE(PG8_SA(0, 1), cA + hstep, voffA);
        if (wr == 1) PG8_BAR;
        PG8_WAIT_V(4); PG8_BAR;
        PG8_STAGE(PG8_SB(1, 0), cB + kstep, voffB); PG8_STAGE(PG8_SA(1, 0), cA + kstep, voffA); PG8_STAGE(PG8_SB(1, 1), cB + hstep + kstep, voffB);
        PG8_WAIT_V(6); PG8_BAR;
    }
    for (;;) {
        const bool has_next = S.next(ui + 1, nxt);
        const char* nA = has_next ? (const char*)g.A + (size_t)nxt.pm * tstep : cA; const char* nB = has_next ? (const char*)g.Bt + (size_t)nxt.pn * tstep : cB;
        for (int t = 0; t < nt; t += 2) {
            const bool last = (t == nt - 2);
            const char* a1 = cA + (size_t)(t + 1) * kstep;
            const char* a2 = last ? nA : cA + (size_t)(t + 2) * kstep; const char* b2 = last ? nB : cB + (size_t)(t + 2) * kstep;
            const char* a3 = a2 + kstep; const char* b3 = b2 + kstep;
            if (last && has_next) S.a_ready(nxt);
            if constexpr (SP2) {
            PG8_LDB(B0, 0, 0); PG8_LDB(B1, 0, 1); PG8_SCHED; PG8_LDA(At, 0, 0); PG8_STAGE(PG8_SA(1, 1), a1 + hstep, voffA);
            PG8_WAIT_V(8); PG8_WAIT_L(0); PG8_BAR; PG8_MMA(0, 0, At, B0); PG8_MMA(0, 1, At, B1); PG8_BAR; PG8_SCHED;
            PG8_LDA(At, 0, 1); PG8_STAGE(PG8_SB(0, 0), b2, voffB); PG8_STAGE(PG8_SB(0, 1), b2 + hstep, voffB); PG8_STAGE(PG8_SA(0, 0), a2, voffA);
            PG8_WAIT_V(8); PG8_WAIT_L(0); PG8_BAR; PG8_MMA(1, 0, At, B0); PG8_MMA(1, 1, At, B1); PG8_BAR; PG8_SCHED;
            PG8_LDB(B0, 1, 0); PG8_LDB(B1, 1, 1); PG8_SCHED; PG8_LDA(At, 1, 0); PG8_STAGE(PG8_SA(0, 1), a2 + hstep, voffA);
            PG8_WAIT_V(8); PG8_WAIT_L(0); PG8_BAR; PG8_MMA(0, 0, At, B0); PG8_MMA(0, 1, At, B1); PG8_BAR; PG8_SCHED;
            PG8_LDA(At, 1, 1); PG8_STAGE(PG8_SB(1, 0), b3, voffB); PG8_STAGE(PG8_SB(1, 1), b3 + hstep, voffB); PG8_STAGE(PG8_SA(1, 0), a3, voffA);
            PG8_WAIT_V(8); PG8_WAIT_L(0); PG8_BAR; PG8_MMA(1, 0, At, B0); PG8_MMA(1, 1, At, B1); PG8_BAR; PG8_SCHED;
            } else {
            PG8_LDB(B0, 0, 0); PG8_SCHED; PG8_LDA(At, 0, 0); PG8_STAGE(PG8_SA(1, 1), a1 + hstep, voffA);
            PG8_WAIT_L(8); PG8_BAR; PG8_WAIT_L(0); PG8_MMA(0, 0, At, B0); PG8_BAR; PG8_SCHED;
            PG8_LDB(B1, 0, 1); PG8_STAGE(PG8_SB(0, 0), b2, voffB);
            PG8_BAR; PG8_WAIT_L(0); PG8_MMA(0, 1, At, B1); PG8_BAR;
            PG8_LDA(At, 0, 1); PG8_STAGE(PG8_SA(0, 0), a2, voffA);
            PG8_BAR; PG8_WAIT_L(0); PG8_MMA(1, 0, At, B0); PG8_BAR; PG8_SCHED;
            PG8_STAGE(PG8_SB(0, 1), b2 + hstep, voffB);
            PG8_WAIT_V(6); PG8_BAR; PG8_MMA(1, 1, At, B1); PG8_BAR;
            PG8_LDB(B0, 1, 0); PG8_SCHED; PG8_LDA(At, 1, 0); PG8_STAGE(PG8_SA(0, 1), a2 + hstep, voffA);
            PG8_WAIT_L(8); PG8_BAR; PG8_WAIT_L(0); PG8_MMA(0, 0, At, B0); PG8_BAR; PG8_SCHED;
            PG8_LDB(B1, 1, 1); PG8_STAGE(PG8_SB(1, 0), b3, voffB);
            PG8_BAR; PG8_WAIT_L(0); PG8_MMA(0, 1, At, B1); PG8_BAR;
            PG8_LDA(At, 1, 1); PG8_STAGE(PG8_SA(1, 0), a3, voffA);
            PG8_BAR; PG8_WAIT_L(0); PG8_MMA(1, 0, At, B0); PG8_BAR; PG8_SCHED;
            PG8_STAGE(PG8_SB(1, 1), b3 + hstep, voffB);
            PG8_WAIT_V(6); PG8_BAR; PG8_MMA(1, 1, At, B1); PG8_BAR;
            }
        }
        if constexpr (ALIGN_EPI) { if (wr == 0) PG8_BAR; }
        if constexpr (!Epi::AFTER_DRAIN) { E(acc, cur, wr, wc, fr, fq); S.done(cur); }
        if (!has_next) break;
#pragma unroll
        for (int a = 0; a < 2; ++a)
#pragma unroll
            for (int b = 0; b < 2; ++b)
#pragma unroll
                for (int m = 0; m < 4; ++m)
#pragma unroll
                    for (int n = 0; n < 2; ++n) acc[a][b][m][n] = (f32x4){0.f, 0.f, 0.f, 0.f};
        cur = nxt; cA = nA; cB = nB; ++ui;
        if constexpr (ALIGN_EPI) { if (wr == 1) PG8_BAR; }
    }
    PG8_WAIT_V(0);
    if constexpr (!ALIGN_EPI) { if (wr == 0) PG8_BAR; }
    PG8_BAR;
    if constexpr (Epi::AFTER_DRAIN) { E.fused(acc, cur, wr, wc, fr, fq, lds, wid, lane); S.done(cur); }
#undef PG8_SA
#undef PG8_SB
#undef PG8_STAGE
#undef PG8_LDA
#undef PG8_LDB
#undef PG8_MMA
#undef PG8_WAIT_V
#undef PG8_WAIT_L
#undef PG8_BAR
#undef PG8_SCHED
}
}
#define GAS __attribute__((address_space(1)))
#define LAS __attribute__((address_space(3)))
typedef unsigned short bf16;
typedef float f32x4 __attribute__((ext_vector_type(4)));
typedef short bf16x8 __attribute__((ext_vector_type(8)));
typedef short s16x4 __attribute__((ext_vector_type(4)));
typedef unsigned u32x4 __attribute__((ext_vector_type(4)));
typedef unsigned u32x2 __attribute__((ext_vector_type(2)));
constexpr int NB = 8, SEQ = 4096, DM = 1024, M = NB * SEQ;
constexpr int NH = 16, HD = 64, DSSM = 1024, DCONV = 1536, NST = 128, CHK = 128, NCHK = SEQ / CHK, NPROJ = 6672, NPADN = 6912, DINNER = 2048;
constexpr float EPS = 1e-6f;
constexpr float LOG2E = 1.4426950408889634f;
constexpr float QSCALE = 0.125f * LOG2E;
constexpr int NT = 512, NWV = 8;
constexpr size_t MiB = 1u << 20;
constexpr size_t WS_RSTD = MiB / 2;
constexpr size_t WS_WINT = 1 * MiB;
constexpr size_t WS_WOUTT = 15 * MiB;
constexpr size_t WS_DTRAW = 19 * MiB;
constexpr size_t WS_ACS = 21 * MiB;
constexpr size_t WS_DTS = 23 * MiB;
constexpr size_t WS_LSE = 25 * MiB;
constexpr size_t WS_XB = 32 * MiB;
constexpr size_t WS_ST = 32 * MiB;
constexpr size_t WS_V = 96 * MiB, WS_G = 160 * MiB;
constexpr size_t WS_OUTPRE = 96 * MiB;
constexpr size_t WS_Z = 224 * MiB;
constexpr size_t WS_XBC = 288 * MiB;
constexpr size_t WS_MIX = 384 * MiB;
constexpr size_t WS_END = 512 * MiB;
constexpr int LDS_BYTES = 147456;

struct Args { const float *x, *npw, *w_in, *conv_w, *conv_b, *dt_bias, *a_log, *d_skip, *ssm_nw, *w_out, *npost_w; float* out; unsigned char* ws; int ph_lo, ph_hi; };

__device__ __forceinline__ float bf2f(unsigned u) { return __builtin_bit_cast(float, u << 16); }
__device__ __forceinline__ unsigned f2bf(float f) { unsigned u = __builtin_bit_cast(unsigned, f); return (u + 0x7fffu + ((u >> 16) & 1u)) >> 16; }
typedef float f32x2_t __attribute__((ext_vector_type(2))); typedef __bf16 bf16x2_t __attribute__((ext_vector_type(2)));
__device__ __forceinline__ unsigned pk2(float lo, float hi) { f32x2_t v = {lo, hi}; bf16x2_t b = __builtin_convertvector(v, bf16x2_t); return __builtin_bit_cast(unsigned, b); }
__device__ __forceinline__ float wave_sum(float v) {
#pragma unroll
    for (int o = 1; o < 64; o <<= 1) v += __shfl_xor(v, o);
    return v;
}
__device__ __forceinline__ float silu_f(float v) { return v * __builtin_amdgcn_rcpf(1.f + __builtin_amdgcn_exp2f(-LOG2E * v)); }
__device__ __forceinline__ float softplus_f(float v) { return v > 20.f ? v : log1pf(__expf(v)); }
#define LDS_WAIT() asm volatile("s_waitcnt lgkmcnt(0)" ::: "memory")

namespace pg8 {
struct EpiProj {
    static constexpr bool PERM = true, AFTER_DRAIN = false;
    bf16 *d0, *d1, *d2, *d3, *d4; bf16* xbc; float* dtraw; const float* rstd;
    __device__ __forceinline__ void operator()(const f32x4 (&acc)[2][2][4][2], const Unit& u, int wr, int wc, int fr, int fq) const {
        const int row0 = u.pm * BM + wr * 64 + fr; const int pn = u.pn;
        if (pn == 26) {
            if (wc == 0 && fq < 2) {
#pragma unroll
                for (int ai = 0; ai < 2; ++ai)
#pragma unroll
                    for (int m = 0; m < 4; ++m) { const int row = row0 + ai * HALF + m * 16; const float rs = rstd[row];
                        float* p = dtraw + (size_t)row * 16 + 8 * fq; *(f32x4*)p = acc[ai][0][m][0] * rs; *(f32x4*)(p + 4) = acc[ai][0][m][1] * rs; }
            }
            return;
        }
        bf16* base; int ldc, colt; float sc = 1.f;
        if (pn < 20) { const int sel = pn >> 2; base = sel == 0 ? d0 : sel == 1 ? d1 : sel == 2 ? d2 : sel == 3 ? d3 : d4; ldc = 1024; colt = (pn & 3) * BM; if (pn < 4) sc = QSCALE; }
        else { base = xbc; ldc = DCONV; colt = (pn - 20) * BM; }
        const int col0 = colt + wc * 32 + 8 * fq;
#pragma unroll
        for (int ai = 0; ai < 2; ++ai)
#pragma unroll
            for (int m = 0; m < 4; ++m) { const int row = row0 + ai * HALF + m * 16; const float rs = rstd[row] * sc; bf16* rowp = base + (size_t)row * ldc + col0;
#pragma unroll
                for (int bj = 0; bj < 2; ++bj) { const f32x4 v0 = acc[ai][bj][m][0] * rs, v1 = acc[ai][bj][m][1] * rs;
                    u32x4 w; w.x = cvt_pk_bf16(v0[0], v0[1]); w.y = cvt_pk_bf16(v0[2], v0[3]); w.z = cvt_pk_bf16(v1[0], v1[1]); w.w = cvt_pk_bf16(v1[2], v1[3]);
                    *(u32x4*)(rowp + bj * HALF) = w; } }
    }
};
struct EpiF32 {
    static constexpr bool PERM = true, AFTER_DRAIN = false;
    float* O; int ldc;
    __device__ __forceinline__ void operator()(const f32x4 (&acc)[2][2][4][2], const Unit& u, int wr, int wc, int fr, int fq) const {
        const int row0 = u.pm * BM + wr * 64 + fr, col0 = u.pn * BM + wc * 32 + 8 * fq;
#pragma unroll
        for (int ai = 0; ai < 2; ++ai)
#pragma unroll
            for (int m = 0; m < 4; ++m) { float* rowp = O + (size_t)(row0 + ai * HALF + m * 16) * ldc + col0;
#pragma unroll
                for (int bj = 0; bj < 2; ++bj) { *(f32x4*)(rowp + bj * HALF) = acc[ai][bj][m][0]; *(f32x4*)(rowp + bj * HALF + 4) = acc[ai][bj][m][1]; } }
    }
};
}
#define XB_TMO      128
#define XB_XCNT(j)  (256  + 64 * (j))
#define XB_XSUB(j)  (1280 + 64 * (j))
#define XB_XGEN(j)  (2304 + 64 * (j))
#define XB_TOP      3328
#define XB_TOPGEN   3392
#define XCD_BAR_WORDS 3456
#define XB_SPIN_CAP (1u << 18)

__device__ __forceinline__ unsigned xb_ld(unsigned* p)              { return __hip_atomic_load(p, __ATOMIC_RELAXED, __HIP_MEMORY_SCOPE_AGENT); }
__device__ __forceinline__ unsigned xb_add(unsigned* p, unsigned v) { return __hip_atomic_fetch_add(p, v, __ATOMIC_RELAXED, __HIP_MEMORY_SCOPE_AGENT); }
__device__ __forceinline__ unsigned xb_xcc_id() { return (unsigned)__builtin_amdgcn_s_getreg((3 << 11) | 20) & 0xFu; }
#define XB_SPIN(cond, bar) do { unsigned _sp = 0; while (cond) { __builtin_amdgcn_s_sleep(1); \
    if ((++_sp & 255u) == 0u) { if (xb_ld(&(bar)[XB_TMO])) break; if (_sp > XB_SPIN_CAP) { atomicAdd(&(bar)[XB_TMO], 1u); break; } } } } while (0)

struct XcdBarrier {
    unsigned* bar; unsigned x;
    volatile LAS unsigned* st;
};

__device__ __forceinline__ XcdBarrier xcd_barrier_post(unsigned* bar, volatile LAS unsigned* st) {
    XcdBarrier b; b.bar = bar; b.x = xb_xcc_id(); b.st = st;
    if (threadIdx.x == 0) (void)xb_add(&bar[XB_XCNT(b.x)], 1u);
    return b;
}
__device__ __forceinline__ void xcd_barrier_complete(unsigned* bar, unsigned x, unsigned& nloc, unsigned& nx) {
    const unsigned G = gridDim.x * gridDim.y * gridDim.z;
    unsigned sum, cnt, mine, sp = 0u;
    for (;;) {
        sum = 0u; cnt = 0u; mine = 0u;
#pragma unroll
        for (unsigned j = 0; j < 16; ++j) { const unsigned c = xb_ld(&bar[XB_XCNT(j)]); sum += c; cnt += (c > 0u) ? 1u : 0u; mine = (j == x) ? c : mine; }
        if (sum == G) break;
        __builtin_amdgcn_s_sleep(1);
        if ((++sp & 255u) == 0u) { if (xb_ld(&bar[XB_TMO])) break; if (sp > XB_SPIN_CAP) { atomicAdd(&bar[XB_TMO], 1u); break; } }
    }
    nloc = mine > 0u ? mine : 1u; nx = cnt > 0u ? cnt : 1u;
}

__device__ __forceinline__ void xcd_barrier(const XcdBarrier& b) {
    asm volatile("s_waitcnt vmcnt(0)" ::: "memory");
    __syncthreads();
    if (threadIdx.x == 0) {
        unsigned* bar = b.bar;
        __builtin_amdgcn_s_waitcnt(0);
        unsigned nloc = b.st[0], nx = b.st[1];
        if (nloc == 0u) { xcd_barrier_complete(bar, b.x, nloc, nx); b.st[0] = nloc; b.st[1] = nx; }
        const unsigned old = xb_add(&bar[XB_XSUB(b.x)], 1u);
        const unsigned gen = old / nloc;
        if (old + 1u == (gen + 1u) * nloc) {
            __builtin_amdgcn_fence(__ATOMIC_RELEASE, "agent");
            asm volatile("s_waitcnt vmcnt(0)" ::: "memory");
            const unsigned og = xb_add(&bar[XB_TOP], 1u);
            const unsigned tg = og / nx;
            if (og + 1u == (tg + 1u) * nx) xb_add(&bar[XB_TOPGEN], 1u);
            else XB_SPIN(xb_ld(&bar[XB_TOPGEN]) == tg, bar);
            __builtin_amdgcn_fence(__ATOMIC_ACQUIRE, "agent");
            xb_add(&bar[XB_XGEN(b.x)], 1u);
            asm volatile("s_waitcnt vmcnt(0)" ::: "memory");
        } else {
            XB_SPIN(xb_ld(&bar[XB_XGEN(b.x)]) == gen, bar);
            __builtin_amdgcn_fence(__ATOMIC_ACQUIRE, "agent");
            asm volatile("s_waitcnt vmcnt(0)" ::: "memory");
        }
    }
    __syncthreads();
}
__device__ __forceinline__ void transpose_item(const float* W, int K, int N, bf16* WT, const float* kscale, LAS float* scr, int item, int lane) {
    const int nblk = (N + 31) / 32, kb = item / nblk, nb = item % nblk, k0 = 64 * kb, n0 = 32 * nb;
    const int nn = n0 + (lane & 31);
#pragma unroll 8
    for (int i = 0; i < 32; ++i) { const int kk = 2 * i + (lane >> 5); float v = (nn < N) ? W[(size_t)(k0 + kk) * N + nn] : 0.f; if (kscale) v *= kscale[k0 + kk]; scr[kk * 33 + (lane & 31)] = v; }
    LDS_WAIT();
    const int c = lane & 7;
#pragma unroll
    for (int j = 0; j < 4; ++j) { const int n = (lane >> 3) + 8 * j; const LAS float* s = scr + (8 * c) * 33 + n;
        u32x4 o; o.x = pk2(s[0 * 33], s[1 * 33]); o.y = pk2(s[2 * 33], s[3 * 33]); o.z = pk2(s[4 * 33], s[5 * 33]); o.w = pk2(s[6 * 33], s[7 * 33]);
        if (n0 + n < N) *(u32x4*)(WT + (size_t)(n0 + n) * K + k0 + 8 * c) = o; }
    LDS_WAIT();
}
__device__ __forceinline__ void phase_prep(const Args& a, LAS unsigned char* lds, int gw, int NGW, int wave, int lane) {
    LAS float* scr = (LAS float*)(lds + wave * 16384);
    bf16* WINT = (bf16*)(a.ws + WS_WINT); bf16* WOUTT = (bf16*)(a.ws + WS_WOUTT); bf16* XB = (bf16*)(a.ws + WS_XB); float* RSTD = (float*)(a.ws + WS_RSTD);
    constexpr int I_IN = (DM / 64) * ((NPROJ + 31) / 32), I_OUT = (DINNER / 64) * (DM / 32);
    for (int it = gw; it < I_IN + I_OUT; it += NGW) {
        if (it < I_IN) transpose_item(a.w_in, DM, NPROJ, WINT, a.npw, scr, it, lane);
        else transpose_item(a.w_out, DINNER, DM, WOUTT, nullptr, scr, it - I_IN, lane);
    }
    for (int m = gw; m < M; m += NGW) {
        const f32x4* xr = (const f32x4*)(a.x + (size_t)m * DM) + lane;
        f32x4 v[4]; float s = 0.f;
#pragma unroll
        for (int j = 0; j < 4; ++j) { v[j] = xr[64 * j]; s += (v[j].x * v[j].x + v[j].y * v[j].y) + (v[j].z * v[j].z + v[j].w * v[j].w); }
        s = wave_sum(s);
        if (lane == 0) RSTD[m] = 1.f / sqrtf(s * (1.f / DM) + EPS);
        u32x2* o8 = (u32x2*)(XB + (size_t)m * DM) + lane;
#pragma unroll
        for (int j = 0; j < 4; ++j) { u32x2 o; o.x = pk2(v[j].x, v[j].y); o.y = pk2(v[j].z, v[j].w); o8[64 * j] = o; }
    }
}

__device__ __forceinline__ void naive_attn(const Args& a, int gw, int NGW, int lane) {
    const bf16* Q = (const bf16*)a.out; const bf16* K = Q + (size_t)M * 1024; const bf16* V = (const bf16*)(a.ws + WS_V); const bf16* G = (const bf16*)(a.ws + WS_G);
    bf16* MIX = (bf16*)(a.ws + WS_MIX);
    for (int it = gw; it < M * NH; it += NGW) {
        const int row = it >> 4, h = it & 15, t = row & (SEQ - 1), b = row >> 12;
        const float q = bf2f(Q[(size_t)row * 1024 + h * 64 + lane]);
        float op[3], lsep[3];
#pragma unroll
        for (int p = 0; p < 3; ++p) {
            const int d = (p == 0) ? 1 : (p == 1 ? 4 : 16);
            float m = -INFINITY, l = 0.f, o = 0.f;
            for (int j = 0; j <= 128; ++j) {
                const int tk = t - j * d; if (tk < 0) break;
                const size_t kr = ((size_t)(b * SEQ + tk)) * 1024 + h * 64 + lane;
                const float s = wave_sum(q * bf2f(K[kr]));
                const float mn = fmaxf(m, s), sc = exp2f(m - mn), pe = exp2f(s - mn);
                l = l * sc + pe; o = o * sc + pe * bf2f(V[kr]); m = mn;
            }
            op[p] = o / l; lsep[p] = m + log2f(l);
        }
        const float mm = fmaxf(lsep[0], fmaxf(lsep[1], lsep[2]));
        const float w0 = exp2f(lsep[0] - mm), w1 = exp2f(lsep[1] - mm), w2 = exp2f(lsep[2] - mm);
        float r = (w0 * op[0] + w1 * op[1] + w2 * op[2]) / (w0 + w1 + w2);
        r *= silu_f(bf2f(G[(size_t)row * 1024 + h * 64 + lane]));
        MIX[(size_t)row * DINNER + h * 64 + lane] = (bf16)f2bf(r);
    }
}
__device__ __forceinline__ void naive_conv(const Args& a, int gt, int NGT) {
    const bf16* XBC = (const bf16*)(a.ws + WS_XBC); bf16* XC = (bf16*)a.out; const float* DTRAW = (const float*)(a.ws + WS_DTRAW); float* DTS = (float*)(a.ws + WS_DTS);
    for (size_t i = gt; i < (size_t)M * DCONV; i += NGT) {
        const int row = (int)(i / DCONV), ch = (int)(i % DCONV), t = row & (SEQ - 1);
        float acc = a.conv_b[ch];
#pragma unroll
        for (int k = 0; k < 4; ++k) { const int tt = t - 3 + k; if (tt >= 0) acc += a.conv_w[k * DCONV + ch] * bf2f(XBC[(size_t)(row - 3 + k) * DCONV + ch]); }
        XC[i] = (bf16)f2bf(silu_f(acc));
    }
    for (int i = gt; i < M * NH; i += NGT) DTS[i] = softplus_f(DTRAW[i] + a.dt_bias[i & 15]);
}
__device__ __forceinline__ void naive_ssd(const Args& a, int gw, int NGW, int lane) {
    const bf16* XC = (const bf16*)a.out; const float* DTS = (const float*)(a.ws + WS_DTS); float* Y = (float*)(a.ws + WS_OUTPRE);
    for (int it = gw; it < NB * NH * HD; it += NGW) {
        const int p = it & 63, h = (it >> 6) & 15, b = it >> 10, g = h >> 3;
        const float av = -__expf(a.a_log[h]), dsk = a.d_skip[h];
        float h0 = 0.f, h1 = 0.f;
        for (int t = 0; t < SEQ; ++t) {
            const size_t row = (size_t)b * SEQ + t; const bf16* xr = XC + row * DCONV;
            const float dt = DTS[row * 16 + h], dA = __expf(dt * av), x = bf2f(xr[h * 64 + p]);
            const float B0 = bf2f(xr[1024 + g * 128 + lane]), B1 = bf2f(xr[1024 + g * 128 + 64 + lane]);
            const float C0 = bf2f(xr[1280 + g * 128 + lane]), C1 = bf2f(xr[1280 + g * 128 + 64 + lane]);
            h0 = h0 * dA + dt * x * B0; h1 = h1 * dA + dt * x * B1;
            const float y = wave_sum(C0 * h0 + C1 * h1) + dsk * x;
            if (lane == 0) Y[row * 1024 + h * 64 + p] = y;
        }
    }
}
__device__ __forceinline__ void naive_gnorm(const Args& a, int gw, int NGW, int lane) {
    const float* Y = (const float*)(a.ws + WS_OUTPRE); const bf16* Z = (const bf16*)(a.ws + WS_Z); bf16* MIX = (bf16*)(a.ws + WS_MIX);
    for (int it = gw; it < M * 2; it += NGW) {
        const int row = it >> 1, g = it & 1; const int c0 = g * 512 + lane * 8;
        float v[8]; float ss = 0.f;
#pragma unroll
        for (int j = 0; j < 8; ++j) { const float y = Y[(size_t)row * 1024 + c0 + j], z = bf2f(Z[(size_t)row * 1024 + c0 + j]); v[j] = y * silu_f(z); ss += v[j] * v[j]; }
        ss = wave_sum(ss); const float r = 1.f / sqrtf(ss * (1.f / 512.f) + EPS);
#pragma unroll
        for (int j = 0; j < 8; ++j) MIX[(size_t)row * DINNER + 1024 + c0 + j] = (bf16)f2bf(v[j] * r * a.ssm_nw[c0 + j]);
    }
}
__device__ __forceinline__ void phase_final(const Args& a, int gw, int NGW, int lane) {
    const float* OP = (const float*)(a.ws + WS_OUTPRE);
    for (int m = gw; m < M; m += NGW) {
        const f32x4* pr = (const f32x4*)(OP + (size_t)m * DM) + lane; const f32x4* xr = (const f32x4*)(a.x + (size_t)m * DM) + lane; const f32x4* wr = (const f32x4*)a.npost_w + lane;
        f32x4 v[4]; float s = 0.f;
#pragma unroll
        for (int j = 0; j < 4; ++j) { v[j] = pr[64 * j]; s += (v[j].x * v[j].x + v[j].y * v[j].y) + (v[j].z * v[j].z + v[j].w * v[j].w); }
        s = wave_sum(s); const float r = 1.f / sqrtf(s * (1.f / DM) + EPS);
        f32x4* orow = (f32x4*)(a.out + (size_t)m * DM) + lane;
#pragma unroll
        for (int j = 0; j < 4; ++j) orow[64 * j] = xr[64 * j] + v[j] * r * wr[64 * j];
    }
}
constexpr int AP2 = 144;
constexpr int ATT_Q = 0, ATT_K = 128 * AP2, ATT_V = ATT_K + 256 * AP2, ATT_END = ATT_V + 272 * AP2;
static_assert(ATT_END <= 131072, "attention LDS");
#define MFMA16(a, b, c) __builtin_amdgcn_mfma_f32_16x16x32_bf16((a), (b), (c), 0, 0, 0)
__device__ __forceinline__ s16x4 tr_read(const LAS unsigned char* p) { return __builtin_bit_cast(s16x4, __builtin_amdgcn_ds_read_tr16_b64_v4i16((LAS s16x4*)p)); }
__device__ __forceinline__ bf16x8 cat8(s16x4 lo, s16x4 hi) { return (bf16x8){lo[0], lo[1], lo[2], lo[3], hi[0], hi[1], hi[2], hi[3]}; }
__device__ __forceinline__ bf16x8 pack8(f32x4 lo, f32x4 hi) { u32x4 w; w.x = pk2(lo[0], lo[1]); w.y = pk2(lo[2], lo[3]); w.z = pk2(hi[0], hi[1]); w.w = pk2(hi[2], hi[3]); return __builtin_bit_cast(bf16x8, w); }
__device__ __forceinline__ f32x4 unpack4(u32x2 v) { return (f32x4){__builtin_bit_cast(float, v.x << 16), __builtin_bit_cast(float, v.x & 0xffff0000u), __builtin_bit_cast(float, v.y << 16), __builtin_bit_cast(float, v.y & 0xffff0000u)}; }
__device__ __forceinline__ u32x2 pack4(f32x4 v) { u32x2 o; o.x = pk2(v[0], v[1]); o.y = pk2(v[2], v[3]); return o; }

__device__ __forceinline__ void phase_attn(const Args& a, LAS unsigned char* lds, int tid, int wave, int lane) {
    const bf16* Q = (const bf16*)a.out; const bf16* K = Q + (size_t)M * 1024; const bf16* V = (const bf16*)(a.ws + WS_V); const bf16* Gt = (const bf16*)(a.ws + WS_G);
    bf16* MIX = (bf16*)(a.ws + WS_MIX); float* LSE = (float*)(a.ws + WS_LSE);
    const int li = lane & 15, quad = lane >> 4;
    for (int i = tid; i < 16 * AP2 / 4; i += NT) ((LAS unsigned*)(lds + ATT_V + 256 * AP2))[i] = 0u;
    for (int unit = blockIdx.x; unit < NB * NH * 2; unit += gridDim.x) {
        const int half = unit & 1, h = (unit >> 1) & 15, b = unit >> 5;
        const size_t rowb = (size_t)b * SEQ;
        for (int st = 0; st < 48; ++st) {
            int d, r, qi0;
            if (st < 16) { d = 16; r = st; qi0 = half * 128; }
            else if (st < 32) { d = 4; r = (st - 16) >> 2; qi0 = half * 512 + ((st - 16) & 3) * 128; }
            else { d = 1; r = 0; qi0 = half * 2048 + (st - 32) * 128; }
            const int kb0 = qi0 - 128;
            __syncthreads();
            {   const int c = tid & 7, r0 = tid >> 3;
#pragma unroll
                for (int i = 0; i < 2; ++i) { const int rr = r0 + 64 * i; const size_t grow = rowb + (size_t)(qi0 + rr) * d + r;
                    *(LAS u32x4*)(lds + ATT_Q + rr * AP2 + c * 16) = *(const u32x4*)(Q + grow * 1024 + h * 64 + c * 8); }
#pragma unroll
                for (int i = 0; i < 4; ++i) { const int rr = r0 + 64 * i; const int ks = kb0 + rr; u32x4 kv = {0u, 0u, 0u, 0u}, vv = {0u, 0u, 0u, 0u};
                    if (ks >= 0) { const size_t grow = rowb + (size_t)ks * d + r; kv = *(const u32x4*)(K + grow * 1024 + h * 64 + c * 8); vv = *(const u32x4*)(V + grow * 1024 + h * 64 + c * 8); }
                    *(LAS u32x4*)(lds + ATT_K + rr * AP2 + c * 16) = kv; *(LAS u32x4*)(lds + ATT_V + rr * AP2 + c * 16) = vv; }
            }
            __syncthreads();
            const LAS unsigned char* qp = lds + ATT_Q + (16 * wave + li) * AP2 + quad * 16;
            const bf16x8 bq0 = *(const LAS bf16x8*)qp, bq1 = *(const LAS bf16x8*)(qp + 64);
            f32x4 sc[9];
#pragma unroll
            for (int kt = 0; kt < 9; ++kt) { const LAS unsigned char* kp = lds + ATT_K + (16 * (wave + kt) + li) * AP2 + quad * 16;
                const bf16x8 a0 = *(const LAS bf16x8*)kp, a1 = *(const LAS bf16x8*)(kp + 64);
                f32x4 z = {0.f, 0.f, 0.f, 0.f}; z = MFMA16(a0, bq0, z); z = MFMA16(a1, bq1, z); sc[kt] = z; }
            float mx = -INFINITY;
#pragma unroll
            for (int kt = 0; kt < 9; ++kt)
#pragma unroll
                for (int j = 0; j < 4; ++j) { const int rel = 16 * kt + quad * 4 + j - li, kabs = kb0 + 16 * (wave + kt) + quad * 4 + j;
                    const bool valid = (rel >= 0) && (rel <= 128) && (kabs >= 0);
                    const float s = valid ? sc[kt][j] : -INFINITY; sc[kt][j] = s; mx = fmaxf(mx, s); }
            mx = fmaxf(mx, __shfl_xor(mx, 16)); mx = fmaxf(mx, __shfl_xor(mx, 32));
            float l = 0.f;
#pragma unroll
            for (int kt = 0; kt < 9; ++kt)
#pragma unroll
                for (int j = 0; j < 4; ++j) { const float p = __builtin_amdgcn_exp2f(sc[kt][j] - mx); sc[kt][j] = p; l += p; }
            l += __shfl_xor(l, 16); l += __shfl_xor(l, 32);
            bf16x8 bp[5];
#pragma unroll
            for (int kp = 0; kp < 4; ++kp) bp[kp] = pack8(sc[2 * kp], sc[2 * kp + 1]);
            bp[4] = pack8(sc[8], (f32x4){0.f, 0.f, 0.f, 0.f});
            f32x4 o[4];
            const LAS unsigned char* vb = lds + ATT_V + (16 * wave + 4 * quad + (li >> 2)) * AP2 + (li & 3) * 8;
#pragma unroll
            for (int dt = 0; dt < 4; ++dt) { f32x4 acc = {0.f, 0.f, 0.f, 0.f};
#pragma unroll
                for (int kp = 0; kp < 5; ++kp) { const LAS unsigned char* p1 = vb + (32 * kp) * AP2 + dt * 32;
                    const s16x4 lo = tr_read(p1), hi = tr_read(p1 + 16 * AP2); acc = MFMA16(cat8(lo, hi), bp[kp], acc); }
                o[dt] = acc; }
            const size_t grow = rowb + (size_t)(qi0 + 16 * wave + li) * d + r;
            bf16* mp = MIX + grow * DINNER + h * 64 + 4 * quad;
            const float lse_t = mx + __builtin_amdgcn_logf(l), inv_l = 1.f / l;
            if (st < 16) {
#pragma unroll
                for (int dt = 0; dt < 4; ++dt) *(u32x2*)(mp + 16 * dt) = pack4(o[dt] * inv_l);
                if (quad == 0) LSE[grow * 16 + h] = lse_t;
            } else {
                const float lse_p = LSE[grow * 16 + h], mm = fmaxf(lse_p, lse_t), wa = __builtin_amdgcn_exp2f(lse_p - mm), wb = __builtin_amdgcn_exp2f(lse_t - mm);
                const float inv = 1.f / (wa + wb), ca = wa * inv, cb = wb * inv * inv_l;
#pragma unroll
                for (int dt = 0; dt < 4; ++dt) { f32x4 v = unpack4(*(const u32x2*)(mp + 16 * dt)) * ca + o[dt] * cb;
                    if (st >= 32) { const f32x4 g = unpack4(*(const u32x2*)(Gt + grow * 1024 + h * 64 + 4 * quad + 16 * dt));
                        v[0] *= silu_f(g[0]); v[1] *= silu_f(g[1]); v[2] *= silu_f(g[2]); v[3] *= silu_f(g[3]); }
                    *(u32x2*)(mp + 16 * dt) = pack4(v); }
                if (st < 32 && quad == 0) LSE[grow * 16 + h] = mm + __builtin_amdgcn_logf(wa + wb);
            }
            asm volatile("s_waitcnt vmcnt(0)" ::: "memory");
        }
    }
    __syncthreads();
}
__device__ __forceinline__ void conv8(const bf16* XBC, size_t row, int t, int ch0, const float* cw, const float* cb, f32x4& o0, f32x4& o1) {
    f32x4 a0 = *(const f32x4*)(cb + ch0), a1 = *(const f32x4*)(cb + ch0 + 4);
#pragma unroll
    for (int k = 0; k < 4; ++k) {
        if (t - 3 + k >= 0) { const u32x4 v = *(const u32x4*)(XBC + (row - 3 + k) * DCONV + ch0);
            const f32x4 w0 = *(const f32x4*)(cw + k * DCONV + ch0), w1 = *(const f32x4*)(cw + k * DCONV + ch0 + 4);
            a0 += w0 * unpack4((u32x2){v.x, v.y});
            a1 += w1 * unpack4((u32x2){v.z, v.w}); }
    }
    o0 = (f32x4){silu_f(a0[0]), silu_f(a0[1]), silu_f(a0[2]), silu_f(a0[3])}; o1 = (f32x4){silu_f(a1[0]), silu_f(a1[1]), silu_f(a1[2]), silu_f(a1[3])};
}
constexpr int BP2 = 272;
constexpr int SS_B = 0, SS_C = 128 * BP2, SS_XS = 2 * 128 * BP2, SS_XD = SS_XS + 128 * AP2, SS_XW = SS_XD + 128 * AP2, SS_ACS = SS_XW + 128 * AP2, SS_DT = SS_ACS + 4096, SS_END = SS_DT + 4096;
static_assert(SS_END <= LDS_BYTES, "ssd LDS");

__device__ __forceinline__ void phase_ssd_chunk(const Args& a, LAS unsigned char* lds, int tid, int wave, int lane) {
    const bf16* XBC = (const bf16*)(a.ws + WS_XBC); const float* DTRAW = (const float*)(a.ws + WS_DTRAW); float* ACS = (float*)(a.ws + WS_ACS);
    bf16* MIX = (bf16*)(a.ws + WS_MIX); bf16* ST = (bf16*)(a.ws + WS_ST);
    const int li = lane & 15, quad = lane >> 4, w = wave;
    LAS float* ACSs = (LAS float*)(lds + SS_ACS); LAS float* DTs = (LAS float*)(lds + SS_DT);
    for (int unit = blockIdx.x; unit < NB * NCHK * 2; unit += gridDim.x) {
        const int g = unit & 1, c = (unit >> 1) & 31, b = unit >> 6;
        const size_t row0 = (size_t)b * SEQ + c * CHK; const int t0 = c * CHK;
        __syncthreads();
#pragma unroll 2
        for (int i = 0; i < 8; ++i) { const int item = i * NT + tid, cc = item & 31, l = item >> 5;
            const int ch0 = (cc < 16) ? (1024 + g * 128 + cc * 8) : (1280 + g * 128 + (cc - 16) * 8);
            f32x4 o0, o1; conv8(XBC, row0 + l, t0 + l, ch0, a.conv_w, a.conv_b, o0, o1);
            *(LAS bf16x8*)(lds + ((cc < 16) ? SS_B : SS_C) + l * BP2 + (cc & 15) * 16) = pack8(o0, o1); }
        {   const int hh = 8 * g + w; const float av = -__expf(a.a_log[hh]), db = a.dt_bias[hh];
            const float d0 = softplus_f(DTRAW[(row0 + 2 * lane) * 16 + hh] + db), d1 = softplus_f(DTRAW[(row0 + 2 * lane + 1) * 16 + hh] + db);
            const float s = (d0 + d1) * av; float inc = s;
#pragma unroll
            for (int o = 1; o < 64; o <<= 1) { const float t = __shfl_up(inc, o); if (lane >= o) inc += t; }
            const float c0 = inc - s + d0 * av, c1 = inc;
            ACSs[w * 128 + 2 * lane] = c0; ACSs[w * 128 + 2 * lane + 1] = c1; DTs[w * 128 + 2 * lane] = d0; DTs[w * 128 + 2 * lane + 1] = d1;
            ACS[(row0 + 2 * lane) * 16 + hh] = c0; ACS[(row0 + 2 * lane + 1) * 16 + hh] = c1; }
        __syncthreads();
        const int npair = (w >> 1) + 1;
        f32x4 cbt[8];
        {   bf16x8 bc[4];
#pragma unroll
            for (int ks = 0; ks < 4; ++ks) bc[ks] = *(const LAS bf16x8*)(lds + SS_C + (16 * w + li) * BP2 + ks * 64 + quad * 16);
#pragma unroll
            for (int st = 0; st < 8; ++st) { f32x4 z = {0.f, 0.f, 0.f, 0.f};
                if (st < 2 * npair) {
#pragma unroll
                    for (int ks = 0; ks < 4; ++ks) z = MFMA16(*(const LAS bf16x8*)(lds + SS_B + (16 * st + li) * BP2 + ks * 64 + quad * 16), bc[ks], z); }
                cbt[st] = z; } }
        for (int hh = 0; hh < 8; ++hh) {
            const int h = 8 * g + hh; const float dsk = a.d_skip[h];
            __syncthreads();
            const float alast = ACSs[hh * 128 + 127];
#pragma unroll
            for (int i = 0; i < 2; ++i) { const int item = i * NT + tid, cc = item & 7, l = item >> 3;
                f32x4 o0, o1; conv8(XBC, row0 + l, t0 + l, h * 64 + cc * 8, a.conv_w, a.conv_b, o0, o1);
                const float dt = DTs[hh * 128 + l], dw = dt * __expf(alast - ACSs[hh * 128 + l]);
                *(LAS bf16x8*)(lds + SS_XS + l * AP2 + cc * 16) = pack8(o0, o1);
                *(LAS bf16x8*)(lds + SS_XD + l * AP2 + cc * 16) = pack8(o0 * dt, o1 * dt);
                *(LAS bf16x8*)(lds + SS_XW + l * AP2 + cc * 16) = pack8(o0 * dw, o1 * dw); }
            __syncthreads();
            const float al = ACSs[hh * 128 + 16 * w + li];
            f32x4 o[4];
#pragma unroll
            for (int pt = 0; pt < 4; ++pt) o[pt] = (f32x4){0.f, 0.f, 0.f, 0.f};
            const LAS unsigned char* xdb = lds + SS_XD + (4 * quad + (li >> 2)) * AP2 + (li & 3) * 8;
#pragma unroll
            for (int kp = 0; kp < 4; ++kp) {
                if (kp < npair) {
                    f32x4 lt[2];
#pragma unroll
                    for (int t = 0; t < 2; ++t) { const f32x4 as = *(const LAS f32x4*)(ACSs + hh * 128 + 16 * (2 * kp + t) + 4 * quad);
#pragma unroll
                        for (int e = 0; e < 4; ++e) { const int s = 16 * (2 * kp + t) + 4 * quad + e; lt[t][e] = (s <= 16 * w + li) ? cbt[2 * kp + t][e] * __expf(al - as[e]) : 0.f; } }
                    const bf16x8 bp = pack8(lt[0], lt[1]);
#pragma unroll
                    for (int pt = 0; pt < 4; ++pt) { const LAS unsigned char* p1 = xdb + (32 * kp) * AP2 + pt * 32;
                        o[pt] = MFMA16(cat8(tr_read(p1), tr_read(p1 + 16 * AP2)), bp, o[pt]); }
                }
            }
#pragma unroll
            for (int pt = 0; pt < 4; ++pt) { const f32x4 xs = unpack4(*(const LAS u32x2*)(lds + SS_XS + (16 * w + li) * AP2 + (16 * pt + 4 * quad) * 2));
                *(u32x2*)(MIX + (row0 + 16 * w + li) * DINNER + 1024 + h * 64 + 16 * pt + 4 * quad) = pack4(o[pt] + xs * dsk); }
            f32x4 sa[4];
#pragma unroll
            for (int pt = 0; pt < 4; ++pt) sa[pt] = (f32x4){0.f, 0.f, 0.f, 0.f};
            const LAS unsigned char* bb = lds + SS_B + (8 * quad + (li >> 2)) * BP2 + (16 * w + 4 * (li & 3)) * 2;
            const LAS unsigned char* xwb = lds + SS_XW + (8 * quad + (li >> 2)) * AP2 + (li & 3) * 8;
#pragma unroll
            for (int ks = 0; ks < 4; ++ks) { const bf16x8 aB = cat8(tr_read(bb + (32 * ks) * BP2), tr_read(bb + (32 * ks + 4) * BP2));
#pragma unroll
                for (int pt = 0; pt < 4; ++pt) { const LAS unsigned char* p1 = xwb + (32 * ks) * AP2 + pt * 32;
                    sa[pt] = MFMA16(aB, cat8(tr_read(p1), tr_read(p1 + 4 * AP2)), sa[pt]); } }
            bf16* stp = ST + ((((size_t)b * NCHK + c) * NH + h) * HD) * NST;
#pragma unroll
            for (int pt = 0; pt < 4; ++pt) *(u32x2*)(stp + (size_t)(16 * pt + li) * NST + 16 * w + 4 * quad) = pack4(sa[pt]);
        }
    }
    __syncthreads();
}
__device__ __forceinline__ void phase_scan(const Args& a, int gt, int NGT) {
    bf16* ST = (bf16*)(a.ws + WS_ST); const float* ACS = (const float*)(a.ws + WS_ACS);
    for (int idx = gt; idx < NB * NH * HD * 16; idx += NGT) {
        const int n8 = idx & 15, p = (idx >> 4) & 63, h = (idx >> 10) & 15, b = idx >> 14;
        f32x4 s0 = {0.f, 0.f, 0.f, 0.f}, s1 = {0.f, 0.f, 0.f, 0.f};
        for (int c0 = 0; c0 < NCHK; c0 += 8) {
            u32x4 v[8]; float dec[8];
#pragma unroll
            for (int j = 0; j < 8; ++j) { const int c = c0 + j; v[j] = *(const u32x4*)(ST + ((((size_t)b * NCHK + c) * NH + h) * HD + p) * NST + n8 * 8);
                dec[j] = __expf(ACS[((size_t)b * SEQ + c * CHK + 127) * 16 + h]); }
#pragma unroll
            for (int j = 0; j < 8; ++j) { const int c = c0 + j;
                u32x4 o; o.x = pk2(s0[0], s0[1]); o.y = pk2(s0[2], s0[3]); o.z = pk2(s1[0], s1[1]); o.w = pk2(s1[2], s1[3]);
                *(u32x4*)(ST + ((((size_t)b * NCHK + c) * NH + h) * HD + p) * NST + n8 * 8) = o;
                s0 = s0 * dec[j] + unpack4((u32x2){v[j].x, v[j].y});
                s1 = s1 * dec[j] + unpack4((u32x2){v[j].z, v[j].w}); }
        }
    }
}
constexpr int PVP = 272, PVH = 64 * PVP, SO_PV = 128 * BP2;
static_assert(SO_PV + 4 * PVH <= LDS_BYTES, "ssd_out LDS");
__device__ __forceinline__ void phase_ssd_out(const Args& a, LAS unsigned char* lds, int tid, int wave, int lane) {
    const bf16* XBC = (const bf16*)(a.ws + WS_XBC); const float* ACS = (const float*)(a.ws + WS_ACS); const bf16* Z = (const bf16*)(a.ws + WS_Z);
    bf16* MIX = (bf16*)(a.ws + WS_MIX); const bf16* ST = (const bf16*)(a.ws + WS_ST);
    const int li = lane & 15, quad = lane >> 4, w = wave;
    for (int unit = blockIdx.x; unit < NB * NCHK * 2; unit += gridDim.x) {
        const int g = unit & 1, c = (unit >> 1) & 31, b = unit >> 6;
        const size_t row0 = (size_t)b * SEQ + c * CHK; const int t0 = c * CHK;
        const size_t row = row0 + 16 * w + li;
        u32x4 pr[4]; u32x2 ydn[2][4], zn[2][4]; float eln[2];
#define SO_PREFETCH(q) do { const int hb_ = 8 * g + 2 * (q); const u32x4* src_ = (const u32x4*)(ST + ((((size_t)b * NCHK + c) * NH + hb_) * HD) * NST); \
        _Pragma("unroll") for (int i = 0; i < 4; ++i) pr[i] = src_[i * NT + tid]; \
        _Pragma("unroll") for (int hh = 0; hh < 2; ++hh) { eln[hh] = ACS[row * 16 + hb_ + hh]; \
            _Pragma("unroll") for (int pt = 0; pt < 4; ++pt) { const int col_ = (hb_ + hh) * 64 + 16 * pt + 4 * quad; \
                ydn[hh][pt] = *(const u32x2*)(MIX + row * DINNER + 1024 + col_); zn[hh][pt] = *(const u32x2*)(Z + row * 1024 + col_); } } } while (0)
        __syncthreads();
#pragma unroll
        for (int i = 0; i < 4; ++i) { const int item = i * NT + tid, cc = item & 15, l = item >> 4;
            f32x4 o0, o1; conv8(XBC, row0 + l, t0 + l, 1280 + g * 128 + cc * 8, a.conv_w, a.conv_b, o0, o1);
            *(LAS bf16x8*)(lds + 0 + l * BP2 + cc * 16) = pack8(o0, o1); }
        asm volatile("" ::: "memory");
        SO_PREFETCH(0);
        bf16x8 bc[4];
        u32x2 yzp[8][4]; float ss = 0.f;
#pragma unroll
        for (int q = 0; q < 4; ++q) {
#pragma unroll
            for (int i = 0; i < 4; ++i) { const int idx = i * NT + tid, rr = idx >> 4; *(LAS u32x4*)(lds + SO_PV + (q & 1) * 2 * PVH + (rr >> 6) * PVH + (rr & 63) * PVP + (idx & 15) * 16) = pr[i]; }
            u32x2 ydc[2][4], zc[2][4]; float elc[2];
#pragma unroll
            for (int hh = 0; hh < 2; ++hh) { elc[hh] = eln[hh];
#pragma unroll
                for (int pt = 0; pt < 4; ++pt) { ydc[hh][pt] = ydn[hh][pt]; zc[hh][pt] = zn[hh][pt]; } }
            __syncthreads();
            if (q == 0) {
#pragma unroll
                for (int ks = 0; ks < 4; ++ks) bc[ks] = *(const LAS bf16x8*)(lds + 0 + (16 * w + li) * BP2 + ks * 64 + quad * 16); }
            if (q < 3) SO_PREFETCH(q + 1);
#pragma unroll
            for (int hh = 0; hh < 2; ++hh) { const float e = __expf(elc[hh]);
#pragma unroll
                for (int pt = 0; pt < 4; ++pt) { f32x4 acc = {0.f, 0.f, 0.f, 0.f}; if (pt & 1) asm volatile("" ::: "memory");
#pragma unroll
                    for (int ks = 0; ks < 4; ++ks) acc = MFMA16(*(const LAS bf16x8*)(lds + SO_PV + ((q & 1) * 2 + hh) * PVH + (16 * pt + li) * PVP + ks * 64 + quad * 16), bc[ks], acc);
                    const f32x4 z = unpack4(zc[hh][pt]);
                    f32x4 y = acc * e + unpack4(ydc[hh][pt]); y[0] *= silu_f(z[0]); y[1] *= silu_f(z[1]); y[2] *= silu_f(z[2]); y[3] *= silu_f(z[3]);
                    ss += (y[0] * y[0] + y[1] * y[1]) + (y[2] * y[2] + y[3] * y[3]); yzp[2 * q + hh][pt] = pack4(y); } }
        }
#undef SO_PREFETCH
        ss += __shfl_xor(ss, 16); ss += __shfl_xor(ss, 32);
        const float r = 1.f / sqrtf(ss * (1.f / 512.f) + EPS);
#pragma unroll
        for (int hh = 0; hh < 8; ++hh) { asm volatile("" ::: "memory");
#pragma unroll
            for (int pt = 0; pt < 4; ++pt) { const int col = (8 * g + hh) * 64 + 16 * pt + 4 * quad; const f32x4 wv = *(const f32x4*)(a.ssm_nw + col);
                *(u32x2*)(MIX + row * DINNER + 1024 + col) = pack4(unpack4(yzp[hh][pt]) * wv * r); } }
    }
    __syncthreads();
}
#ifndef ONE_LAUNCH
#define ONE_LAUNCH 1
#endif
constexpr int NPHASE = 8;
#ifndef REP_ATTN
#define REP_ATTN 1
#endif
#ifndef REP_P3
#define REP_P3 1
#endif
#ifndef REP_SSD
#define REP_SSD 1
#endif
__global__ void __launch_bounds__(NT, 2) hybrid_fwd(Args a) {
    extern __shared__ __attribute__((aligned(16))) unsigned char lds_raw[];
    LAS unsigned char* lds = (LAS unsigned char*)lds_raw;
    const int tid = threadIdx.x, lane = tid & 63, wave = __builtin_amdgcn_readfirstlane(tid >> 6);
    const int G = gridDim.x, gw = blockIdx.x * NWV + wave, NGW = G * NWV, gt = blockIdx.x * NT + tid, NGT = G * NT;
    const int lo = a.ph_lo, hi = a.ph_hi;
    volatile LAS unsigned* bst = (volatile LAS unsigned*)(lds + LDS_BYTES - 64);
    if (tid < 16) bst[tid] = 0u;
    __syncthreads();
    const XcdBarrier bar = xcd_barrier_post((unsigned*)a.ws, bst);
#define IN(k) (lo <= (k) && (k) < hi)
#define SEAM(k) do { if (IN(k) && IN((k) + 1)) { if ((k) == 0) cg::this_grid().sync(); else xcd_barrier(bar); } } while (0)
    if (IN(0)) { phase_prep(a, lds, gw, NGW, wave, lane); __syncthreads(); } SEAM(0);
    if (IN(1)) {
        pg8::Gemm g{(const bf16*)(a.ws + WS_XB), (const bf16*)(a.ws + WS_WINT), M, NPADN, DM}; pg8::StaticOrder S; S.init(M, NPADN, G, (int)blockIdx.x);
        pg8::EpiProj E; E.d0 = (bf16*)a.out; E.d1 = (bf16*)a.out + (size_t)M * 1024; E.d2 = (bf16*)(a.ws + WS_V); E.d3 = (bf16*)(a.ws + WS_G); E.d4 = (bf16*)(a.ws + WS_Z);
        E.xbc = (bf16*)(a.ws + WS_XBC); E.dtraw = (float*)(a.ws + WS_DTRAW); E.rstd = (const float*)(a.ws + WS_RSTD);
        pg8::gemm_phase<pg8::EpiProj, pg8::StaticOrder, true, true>(lds, g, S, E);
    } SEAM(1);
    if (IN(2)) { for (int rep = 0; rep < REP_ATTN; ++rep) phase_attn(a, lds, tid, wave, lane); }
    for (int rep = 0; rep < REP_SSD; ++rep) {
        if (rep) xcd_barrier(bar);
        if (IN(3)) { for (int r3 = 0; r3 < REP_P3; ++r3) phase_ssd_chunk(a, lds, tid, wave, lane); } SEAM(3);
        if (IN(4)) phase_scan(a, gt, NGT); SEAM(4);
        if (IN(5)) phase_ssd_out(a, lds, tid, wave, lane);
    }
    SEAM(5);
    if (IN(6)) {
        pg8::Gemm g{(const bf16*)(a.ws + WS_MIX), (const bf16*)(a.ws + WS_WOUTT), M, DM, DINNER}; pg8::StaticOrder S; S.init(M, DM, G, (int)blockIdx.x);
        pg8::EpiF32 E{(float*)(a.ws + WS_OUTPRE), DM};
        pg8::gemm_phase<pg8::EpiF32, pg8::StaticOrder, true, true>(lds, g, S, E);
    } SEAM(6);
    if (IN(7)) phase_final(a, gw, NGW, lane);
#undef IN
#undef SEAM
}

extern "C" void kernel_launch(void* const* d_in, const int* in_sizes, int n_in, void* d_out, int out_size, void* d_ws, size_t ws_size, hipStream_t stream) {
    static int grid = 0;
    if (grid == 0) {
        if (n_in != 11 || out_size != M * DM || ws_size < WS_END) { fprintf(stderr, "kernel_launch: unexpected shapes (n_in %d out %d ws %zu)\n", n_in, out_size, ws_size); grid = -1; return; }
        int dev = 0, cus = 0, per_cu = 0;
        (void)hipGetDevice(&dev); (void)hipDeviceGetAttribute(&cus, hipDeviceAttributeMultiprocessorCount, dev);
        if (hipFuncSetAttribute((const void*)hybrid_fwd, hipFuncAttributeMaxDynamicSharedMemorySize, LDS_BYTES) != hipSuccess) { fprintf(stderr, "kernel_launch: hipFuncSetAttribute failed\n"); grid = -1; return; }
        if (hipOccupancyMaxActiveBlocksPerMultiprocessor(&per_cu, (const void*)hybrid_fwd, NT, LDS_BYTES) != hipSuccess || per_cu < 1) { fprintf(stderr, "kernel_launch: occupancy query says %d\n", per_cu); per_cu = 1; }
        (void)hipGetLastError();
        grid = cus * 1;
        fprintf(stderr, "kernel_launch: cus %d per_cu %d grid %d\n", cus, per_cu, grid);
    }
    if (grid < 0) return;
    if (hipMemsetAsync(d_ws, 0, 16384, stream) != hipSuccess) { fprintf(stderr, "kernel_launch: memset failed\n"); return; }
    Args a{};
    a.x = (const float*)d_in[0]; a.npw = (const float*)d_in[1]; a.w_in = (const float*)d_in[2]; a.conv_w = (const float*)d_in[3]; a.conv_b = (const float*)d_in[4];
    a.dt_bias = (const float*)d_in[5]; a.a_log = (const float*)d_in[6]; a.d_skip = (const float*)d_in[7]; a.ssm_nw = (const float*)d_in[8]; a.w_out = (const float*)d_in[9]; a.npost_w = (const float*)d_in[10];
    a.out = (float*)d_out; a.ws = (unsigned char*)d_ws;
#if ONE_LAUNCH
    a.ph_lo = 0; a.ph_hi = NPHASE;
    void* args[] = {&a};
    hipError_t e = hipLaunchCooperativeKernel((const void*)hybrid_fwd, dim3(grid), dim3(NT), args, LDS_BYTES, stream);
    if (e != hipSuccess) fprintf(stderr, "cooperative launch failed: %s (grid %d)\n", hipGetErrorString(e), grid);
#else
    for (int p = 0; p < NPHASE; ++p) { a.ph_lo = p; a.ph_hi = p + 1; hipLaunchKernelGGL(hybrid_fwd, dim3(grid), dim3(NT), LDS_BYTES, stream, a); }
#endif
}
```

```cpp
#include <hip/hip_runtime.h>
#include <hip/hip_cooperative_groups.h>
#include <cstdio>
#include <cstdint>
namespace cg = cooperative_groups;
namespace pg8 {
#define PG8_LAS __attribute__((address_space(3)))
typedef unsigned short bf16_t;
typedef short bf16x8 __attribute__((ext_vector_type(8)));
typedef float f32x4 __attribute__((ext_vector_type(4)));
typedef unsigned u32x4 __attribute__((ext_vector_type(4)));
constexpr int BM = 256, BK = 64, HALF = 128, HTB = HALF * BK * 2  , STAGE_BYTES = 8 * HTB, NXCD = 8, WGM = 4;

__host__ __device__ __forceinline__ int lds_byte(int r, int c) { const int st = (r >> 4) * 2 + (c >> 5), rr = r & 15, cc = c & 31, ob = rr * 64 + cc * 2; return st * 1024 + (ob ^ (((ob >> 9) & 1) << 5)); }
__host__ __device__ __forceinline__ void stage_rc(int b, int& R, int& C) { const int st = b / 1024, sb = b % 1024, swz = sb ^ (((sb >> 9) & 1) << 5); R = (st >> 1) * 16 + swz / 64; C = (st & 1) * 32 + (swz % 64) / 2; }
__host__ __device__ __forceinline__ int perm32(int rho) { const int n = rho >> 4, i = rho & 15; return 8 * (i >> 2) + 4 * n + (i & 3); }

struct Unit { int pm, pn; };
struct Gemm { const bf16_t* A; const bf16_t* Bt; int M, N, K; };

struct StaticOrder {
    int nM, nN, nwg, G, c;
    __host__ __device__ void init(int M, int N, int G_, int c_) { nM = M / BM; nN = N / BM; nwg = nM * nN; G = G_; c = c_; }
    __host__ __device__ bool next(int i, Unit& u) const {
        const long L = (long)i * G + c; if (L >= nwg) return false;
        int wgid = (int)L; { const int q = nwg / NXCD, r = nwg % NXCD, xcd = wgid % NXCD, off = wgid / NXCD; wgid = (xcd < r ? xcd * (q + 1) : r * (q + 1) + (xcd - r) * q) + off; }
        const int nig = WGM * nN, gid = wgid / nig, fm = gid * WGM, gsz = (nM - fm) < WGM ? (nM - fm) : WGM;
        u.pm = fm + ((wgid % nig) % gsz); u.pn = (wgid % nig) / gsz; return true;
    }
    __device__ __forceinline__ void a_ready(const Unit&) const {}
    __device__ __forceinline__ void done(const Unit&) const {}
};

__device__ __forceinline__ unsigned cvt_pk_bf16(float lo, float hi) { unsigned r; asm volatile("v_cvt_pk_bf16_f32 %0, %1, %2" : "=v"(r) : "v"(lo), "v"(hi)); return r; }
template <class Epi, class Sched, bool ALIGN_EPI = false, bool SP2 = false>
__device__ __forceinline__ void gemm_phase(PG8_LAS unsigned char* lds, const Gemm g, const Sched& S, const Epi& E) {
    const int tid = threadIdx.x, wid = __builtin_amdgcn_readfirstlane(tid >> 6), lane = tid & 63, wr = wid >> 2, wc = wid & 3, fr = lane & 15, fq = lane >> 4;
    const int K = g.K, nt = K / BK;
    unsigned voffA[2], voffB[2];
#pragma unroll
    for (int i = 0; i < 2; ++i) { int R, C; stage_rc(tid * 16 + i * 8192, R, C); const int Rb = Epi::PERM ? ((R & ~31) + perm32(R & 31)) : R;
        voffA[i] = (unsigned)(R * K + C) * 2u; voffB[i] = (unsigned)(Rb * K + C) * 2u; }
    const size_t kstep = (size_t)(BK * 2);
    const size_t hstep = (size_t)HALF * K * 2;
    const size_t tstep = 2 * hstep;
    const unsigned ldsw = (unsigned)wid * 1024u;
    const int aoff = lds_byte(wr * 64 + fr, fq * 8), boff = lds_byte(wc * 32 + fr, fq * 8);
#define PG8_SA(b, h) (((b) * 2 + (h)) * HTB)
#define PG8_SB(b, h) ((4 + (b) * 2 + (h)) * HTB)
#define PG8_STAGE(bufoff, gbase, voff) do { _Pragma("unroll") for (int _i = 0; _i < 2; ++_i) \
        __builtin_amdgcn_global_load_lds((const unsigned*)((const char*)(gbase) + (voff)[_i]), (PG8_LAS unsigned*)(lds + (bufoff) + ldsw + _i * 8192), 16, 0, 0); } while (0)
#define PG8_LDA(dst, b, h) do { _Pragma("unroll") for (int m = 0; m < 4; ++m) _Pragma("unroll") for (int k = 0; k < 2; ++k) dst[m][k] = *(const PG8_LAS bf16x8*)(lds + PG8_SA(b, h) + aoff + m * 2048 + k * 1024); } while (0)
#define PG8_LDB(dst, b, h) do { _Pragma("unroll") for (int n = 0; n < 2; ++n) _Pragma("unroll") for (int k = 0; k < 2; ++k) dst[n][k] = *(const PG8_LAS bf16x8*)(lds + PG8_SB(b, h) + boff + n * 2048 + k * 1024); } while (0)
#define PG8_MMA(ai, bj, At, Bt) do { __builtin_amdgcn_s_setprio(1); _Pragma("unroll") for (int m = 0; m < 4; ++m) _Pragma("unroll") for (int n = 0; n < 2; ++n) _Pragma("unroll") for (int k = 0; k < 2; ++k) \
        acc[ai][bj][m][n] = __builtin_amdgcn_mfma_f32_16x16x32_bf16(Bt[n][k], At[m][k], acc[ai][bj][m][n], 0, 0, 0); __builtin_amdgcn_s_setprio(0); } while (0)
#define PG8_WAIT_V(n) asm volatile("s_waitcnt vmcnt(" #n ")" ::: "memory")
#define PG8_WAIT_L(n) asm volatile("s_waitcnt lgkmcnt(" #n ")" ::: "memory")
#define PG8_BAR __builtin_amdgcn_s_barrier()
#define PG8_SCHED __builtin_amdgcn_sched_barrier(0)
    Unit cur, nxt; int ui = 0;
    if (!S.next(0, cur)) return;
    f32x4 acc[2][2][4][2];
#pragma unroll
    for (int a = 0; a < 2; ++a)
#pragma unroll
        for (int b = 0; b < 2; ++b)
#pragma unroll
            for (int m = 0; m < 4; ++m)
#pragma unroll
                for (int n = 0; n < 2; ++n) acc[a][b][m][n] = (f32x4){0.f, 0.f, 0.f, 0.f};
    bf16x8 At[4][2], B0[2][2], B1[2][2];
    const char* cA = (const char*)g.A + (size_t)cur.pm * tstep; const char* cB = (const char*)g.Bt + (size_t)cur.pn * tstep;
    S.a_ready(cur);
    if constexpr (SP2) {
        PG8_STAGE(PG8_SB(0, 0), cB, voffB); PG8_STAGE(PG8_SB(0, 1), cB + hstep, voffB); PG8_STAGE(PG8_SA(0, 0), cA, voffA); PG8_STAGE(PG8_SA(0, 1), cA + hstep, voffA);
        if (wr == 1) PG8_BAR;
        PG8_WAIT_V(2); PG8_BAR;
        PG8_STAGE(PG8_SB(1, 0), cB + kstep, voffB); PG8_STAGE(PG8_SA(1, 0), cA + kstep, voffA); PG8_STAGE(PG8_SB(1, 1), cB + hstep + kstep, voffB);
        PG8_WAIT_V(6); PG8_BAR;
    } else {
        PG8_STAGE(PG8_SB(0, 0), cB, voffB); PG8_STAGE(PG8_SA(0, 0), cA, voffA); PG8_STAGE(PG8_SB(0, 1), cB + hstep, voffB); PG8_STAGE(PG8_SA(0, 1), cA + hstep, voffA);
        if (wr == 1) PG8_BAR;
        PG8_WAIT_V(4); PG8_BAR;
        PG8_STAGE(PG8_SB(1, 0), cB + kstep, voffB); PG8_STAGE(PG8_SA(1, 0), cA + kstep, voffA); PG8_STAGE(PG8_SB(1, 1), cB + hstep + kstep, voffB);
        PG8_WAIT_V(6); PG8_BAR;
    }
    for (;;) {
        const bool has_next = S.next(ui + 1, nxt);
        const char* nA = has_next ? (const char*)g.A + (size_t)nxt.pm * tstep : cA; const char* nB = has_next ? (const char*)g.Bt + (size_t)nxt.pn * tstep : cB;
        for (int t = 0; t < nt; t += 2) {
            const bool last = (t == nt - 2);
            const char* a1 = cA + (size_t)(t + 1) * kstep;
            const char* a2 = last ? nA : cA + (size_t)(t + 2) * kstep; const char* b2 = last ? nB : cB + (size_t)(t + 2) * kstep;
            const char* a3 = a2 + kstep; const char* b3 = b2 + kstep;
            if (last && has_next) S.a_ready(nxt);
            if constexpr (SP2) {
            PG8_LDB(B0, 0, 0); PG8_LDB(B1, 0, 1); PG8_SCHED; PG8_LDA(At, 0, 0); PG8_STAGE(PG8_SA(1, 1), a1 + hstep, voffA);
            PG8_WAIT_V(8); PG8_WAIT_L(0); PG8_BAR; PG8_MMA(0, 0, At, B0); PG8_MMA(0, 1, At, B1); PG8_BAR; PG8_SCHED;
            PG8_LDA(At, 0, 1); PG8_STAGE(PG8_SB(0, 0), b2, voffB); PG8_STAGE(PG8_SB(0, 1), b2 + hstep, voffB); PG8_STAGE(PG8_SA(0, 0), a2, voffA);
            PG8_WAIT_V(8); PG8_WAIT_L(0); PG8_BAR; PG8_MMA(1, 0, At, B0); PG8_MMA(1, 1, At, B1); PG8_BAR; PG8_SCHED;
            PG8_LDB(B0, 1, 0); PG8_LDB(B1, 1, 1); PG8_SCHED; PG8_LDA(At, 1, 0); PG8_STAGE(PG8_SA(0, 1), a2 + hstep, voffA);
            PG8_WAIT_V(8); PG8_WAIT_L(0); PG8_BAR; PG8_MMA(0, 0, At, B0); PG8_MMA(0, 1, At, B1); PG8_BAR; PG8_SCHED;
            PG8_LDA(At, 1, 1); PG8_STAGE(PG8_SB(1, 0), b3, voffB); PG8_STAGE(PG8_SB(1, 1), b3 + hstep, voffB); PG8_STAGE(PG8_SA(1, 0), a3, voffA);
            PG8_WAIT_V(8); PG8_WAIT_L(0); PG8_BAR; PG8_MMA(1, 0, At, B0); PG8_MMA(1, 1, At, B1); PG8_BAR; PG8_SCHED;
            } else {
            PG8_LDB(B0, 0, 0); PG8_SCHED; PG8_LDA(At, 0, 0); PG8_STAGE(PG8_SA(1, 1), a1 + hstep, voffA);
            PG8_WAIT_L(8); PG8_BAR; PG8_WAIT_L(0); PG8_MMA(0, 0, At, B0); PG8_BAR; PG8_SCHED;
            PG8_LDB(B1, 0, 1); PG8_STAGE(PG8_SB(0, 0), b2, voffB);
            PG8_BAR; PG8_WAIT_L(0); PG8_MMA(0, 1, At, B1); PG8_BAR;
            PG8_LDA(At, 0, 1); PG8_STAGE(PG8_SA(0, 0), a2, voffA);
            PG8_BAR; PG8_WAIT_L(0); PG8_MMA(1, 0, At, B0); PG8_BAR; PG8_SCHED;
            PG8_STAGE(PG8_SB(0, 1), b2 + hstep, voffB);
            PG8_WAIT_V(6); PG8_BAR; PG8_MMA(1, 1, At, B1); PG8_BAR;
            PG8_LDB(B0, 1, 0); PG8_SCHED; PG8_LDA(At, 1, 0); PG8_STAGE(PG8_SA(0, 1), a2 + hstep, voffA);
            PG8_WAIT_L(8); PG8_BAR; PG8_WAIT_L(0); PG8_MMA(0, 0, At, B0); PG8_BAR; PG8_SCHED;
            PG8_LDB(B1, 1, 1); PG8_STAGE(PG8_SB(1, 0), b3, voffB);
            PG8_BAR; PG8_WAIT_L(0); PG8_MMA(0, 1, At, B1); PG8_BAR;
            PG8_LDA(At, 1, 1); PG8_STAGE(PG8_SA(1, 0), a3, voffA);
            PG8_BAR; PG8_WAIT_L(0); PG8_MMA(1, 0, At, B0); PG8_BAR; PG8_SCHED;
            PG8_STAGE(PG8_SB(1, 1), b3 + hstep, voffB);
            PG8_WAIT_V(6); PG8_BAR; PG8_MMA(1, 1, At, B1); PG8_BAR;
            }
        }
        if constexpr (ALIGN_EPI) { if (wr == 0) PG8_BAR; }
        if constexpr (!Epi::AFTER_DRAIN) { E(acc, cur, wr, wc, fr, fq); S.done(cur); }
        if (!has_next) break;
#pragma unroll
        for (int a = 0; a < 2; ++a)
#pragma unroll
            for (int b = 0; b < 2; ++b)
#pragma unroll
                for (int m = 0; m < 4; ++m)
#pragma unroll
                    for (int n = 0; n < 2; ++n) acc[a][b][m][n] = (f32x4){0.f, 0.f, 0.f, 0.f};
        cur = nxt; cA = nA; cB = nB; ++ui;
        if constexpr (ALIGN_EPI) { if (wr == 1) PG8_BAR; }
    }
    PG8_WAIT_V(0);
    if constexpr (!ALIGN_EPI) { if (wr == 0) PG8_BAR; }
    PG8_BAR;
    if constexpr (Epi::AFTER_DRAIN) { E.fused(acc, cur, wr, wc, fr, fq, lds, wid, lane); S.done(cur); }
#undef PG8_SA
#undef PG8_SB
#undef PG8_STAGE
#undef PG8_LDA
#undef PG8_LDB
#undef PG8_MMA
#undef PG8_WAIT_V
#undef PG8_WAIT_L
#undef PG8_BAR
#undef PG8_SCHED
}
}
#define GAS __attribute__((address_space(1)))
#define LAS __attribute__((address_space(3)))
typedef unsigned short bf16;
typedef float f32x4 __attribute__((ext_vector_type(4)));
typedef short bf16x8 __attribute__((ext_vector_type(8)));
typedef short s16x4 __attribute__((ext_vector_type(4)));
typedef unsigned u32x4 __attribute__((ext_vector_type(4)));
typedef unsigned u32x2 __attribute__((ext_vector_type(2)));
constexpr int NB = 8, SEQ = 4096, DM = 1024, M = NB * SEQ;
constexpr int NH = 16, HD = 64, DSSM = 1024, DCONV = 1536, NST = 128, CHK = 128, NCHK = SEQ / CHK, NPROJ = 6672, NPADN = 6912, DINNER = 2048;
constexpr float EPS = 1e-6f;
constexpr float LOG2E = 1.4426950408889634f;
constexpr float QSCALE = 0.125f * LOG2E;
constexpr int NT = 512, NWV = 8;
constexpr size_t MiB = 1u << 20;
constexpr size_t WS_PCNT = 16384;
constexpr size_t WS_XCNT = 32768;
constexpr size_t WS_ROWSS = 65536;
constexpr size_t WS_ZERO_BYTES = 65536 + 131072;
constexpr size_t WS_RSTD = MiB / 2;
constexpr size_t WS_WINT = 1 * MiB;
constexpr size_t WS_WOUTT = 15 * MiB;
constexpr size_t WS_DTRAW = 19 * MiB;
constexpr size_t WS_ACS = 21 * MiB;
constexpr size_t WS_DTS = 23 * MiB;
constexpr size_t WS_LSE = 25 * MiB;
constexpr size_t WS_XB = 32 * MiB;
constexpr size_t WS_ST = 32 * MiB;
constexpr size_t WS_V = 96 * MiB, WS_G = 160 * MiB;
constexpr size_t WS_OUTPRE = 96 * MiB;
constexpr size_t WS_Z = 224 * MiB;
constexpr size_t WS_XBC = 288 * MiB;
constexpr size_t WS_MIX = 384 * MiB;
constexpr size_t WS_END = 512 * MiB;
constexpr int LDS_BYTES = 147456;

struct Args { const float *x, *npw, *w_in, *conv_w, *conv_b, *dt_bias, *a_log, *d_skip, *ssm_nw, *w_out, *npost_w; float* out; unsigned char* ws; int ph_lo, ph_hi; };

__device__ __forceinline__ float bf2f(unsigned u) { return __builtin_bit_cast(float, u << 16); }
__device__ __forceinline__ unsigned f2bf(float f) { unsigned u = __builtin_bit_cast(unsigned, f); return (u + 0x7fffu + ((u >> 16) & 1u)) >> 16; }
typedef float f32x2_t __attribute__((ext_vector_type(2))); typedef __bf16 bf16x2_t __attribute__((ext_vector_type(2)));
__device__ __forceinline__ unsigned pk2(float lo, float hi) { f32x2_t v = {lo, hi}; bf16x2_t b = __builtin_convertvector(v, bf16x2_t); return __builtin_bit_cast(unsigned, b); }
__device__ __forceinline__ float wave_sum(float v) {
#pragma unroll
    for (int o = 1; o < 64; o <<= 1) v += __shfl_xor(v, o);
    return v;
}
__device__ __forceinline__ float silu_f(float v) { return v * __builtin_amdgcn_rcpf(1.f + __builtin_amdgcn_exp2f(-LOG2E * v)); }
__device__ __forceinline__ float softplus_f(float v) { return v > 20.f ? v : log1pf(__expf(v)); }
#define LDS_WAIT() asm volatile("s_waitcnt lgkmcnt(0)" ::: "memory")

namespace pg8 {
struct EpiProj {
    static constexpr bool PERM = true, AFTER_DRAIN = false;
    bf16 *d0, *d1, *d2, *d3, *d4; bf16* xbc; float* dtraw; const float* rstd;
    __device__ __forceinline__ void operator()(const f32x4 (&acc)[2][2][4][2], const Unit& u, int wr, int wc, int fr, int fq) const {
        const int row0 = u.pm * BM + wr * 64 + fr; const int pn = u.pn;
        if (pn == 26) {
            if (wc == 0 && fq < 2) {
#pragma unroll
                for (int ai = 0; ai < 2; ++ai)
#pragma unroll
                    for (int m = 0; m < 4; ++m) { const int row = row0 + ai * HALF + m * 16; const float rs = rstd[row];
                        float* p = dtraw + (size_t)row * 16 + 8 * fq; *(f32x4*)p = acc[ai][0][m][0] * rs; *(f32x4*)(p + 4) = acc[ai][0][m][1] * rs; }
            }
            return;
        }
        bf16* base; int ldc, colt; float sc = 1.f;
        if (pn < 20) { const int sel = pn >> 2; base = sel == 0 ? d0 : sel == 1 ? d1 : sel == 2 ? d2 : sel == 3 ? d3 : d4; ldc = 1024; colt = (pn & 3) * BM; if (pn < 4) sc = QSCALE; }
        else { base = xbc; ldc = DCONV; colt = (pn - 20) * BM; }
        const int col0 = colt + wc * 32 + 8 * fq; const bool hm = pn < 12;
#pragma unroll
        for (int ai = 0; ai < 2; ++ai)
#pragma unroll
            for (int m = 0; m < 4; ++m) { const int row = row0 + ai * HALF + m * 16; const float rs = rstd[row] * sc;
#pragma unroll
                for (int bj = 0; bj < 2; ++bj) { const f32x4 v0 = acc[ai][bj][m][0] * rs, v1 = acc[ai][bj][m][1] * rs; const int col = col0 + bj * HALF;
                    bf16* p = hm ? base + ((size_t)((row >> 12) * NH + (col >> 6)) * SEQ + (row & (SEQ - 1))) * HD + (col & 63) : base + (size_t)row * ldc + col;
                    u32x4 w; w.x = cvt_pk_bf16(v0[0], v0[1]); w.y = cvt_pk_bf16(v0[2], v0[3]); w.z = cvt_pk_bf16(v1[0], v1[1]); w.w = cvt_pk_bf16(v1[2], v1[3]);
                    __builtin_nontemporal_store(w, (u32x4*)p); } }
    }
};
struct EpiF32 {
    static constexpr bool PERM = true, AFTER_DRAIN = false;
    float* O; int ldc;
    __device__ __forceinline__ void operator()(const f32x4 (&acc)[2][2][4][2], const Unit& u, int wr, int wc, int fr, int fq) const {
        const int row0 = u.pm * BM + wr * 64 + fr, col0 = u.pn * BM + wc * 32 + 8 * fq;
#pragma unroll
        for (int ai = 0; ai < 2; ++ai)
#pragma unroll
            for (int m = 0; m < 4; ++m) { float* rowp = O + (size_t)(row0 + ai * HALF + m * 16) * ldc + col0;
#pragma unroll
                for (int bj = 0; bj < 2; ++bj) { *(f32x4*)(rowp + bj * HALF) = acc[ai][bj][m][0]; *(f32x4*)(rowp + bj * HALF + 4) = acc[ai][bj][m][1]; } }
    }
};
struct EpiRmsRes {
    static constexpr bool PERM = true, AFTER_DRAIN = false;
    float* O; const float* X; const float* W; float* rowss; unsigned* pcnt;
    __device__ __forceinline__ void operator()(const f32x4 (&acc)[2][2][4][2], const Unit& u, int wr, int wc, int fr, int fq) const {
        const int row0 = u.pm * BM + wr * 64 + fr, col0 = u.pn * BM + wc * 32 + 8 * fq;
#pragma unroll
        for (int ai = 0; ai < 2; ++ai)
#pragma unroll
            for (int m = 0; m < 4; ++m) { float s = 0.f;
#pragma unroll
                for (int bj = 0; bj < 2; ++bj)
#pragma unroll
                    for (int n = 0; n < 2; ++n) { const f32x4 v = acc[ai][bj][m][n]; s += (v[0] * v[0] + v[1] * v[1]) + (v[2] * v[2] + v[3] * v[3]); }
                s += __shfl_xor(s, 16); s += __shfl_xor(s, 32);
                if (fq == 0) (void)__hip_atomic_fetch_add(rowss + row0 + ai * HALF + m * 16, s, __ATOMIC_RELAXED, __HIP_MEMORY_SCOPE_AGENT); }
        unsigned* cnt = pcnt + u.pm * 16;
        asm volatile("s_waitcnt vmcnt(0)" ::: "memory");
        if (threadIdx.x % 64 == 0) {
            (void)__hip_atomic_fetch_add(cnt, 1u, __ATOMIC_RELAXED, __HIP_MEMORY_SCOPE_AGENT);
            unsigned spin = 0;
            while (__hip_atomic_load(cnt, __ATOMIC_RELAXED, __HIP_MEMORY_SCOPE_AGENT) < 32u && ++spin < (1u << 22)) __builtin_amdgcn_s_sleep(2);
        }
        asm volatile("" ::: "memory");
        f32x4 wv[2][2];
#pragma unroll
        for (int bj = 0; bj < 2; ++bj) { wv[bj][0] = *(const f32x4*)(W + col0 + bj * HALF); wv[bj][1] = *(const f32x4*)(W + col0 + bj * HALF + 4); }
#pragma unroll
        for (int ai = 0; ai < 2; ++ai)
#pragma unroll
            for (int m = 0; m < 4; ++m) { const int row = row0 + ai * HALF + m * 16;
                const float ss = __hip_atomic_load(rowss + row, __ATOMIC_RELAXED, __HIP_MEMORY_SCOPE_AGENT); const float rs = 1.f / sqrtf(ss * (1.f / 1024.f) + 1e-6f);
                const float* xp = X + (size_t)row * 1024 + col0; float* op = O + (size_t)row * 1024 + col0;
#pragma unroll
                for (int bj = 0; bj < 2; ++bj) { const f32x4 x0 = __builtin_nontemporal_load((const f32x4*)(xp + bj * HALF)), x1 = __builtin_nontemporal_load((const f32x4*)(xp + bj * HALF + 4));
                    *(f32x4*)(op + bj * HALF) = x0 + acc[ai][bj][m][0] * wv[bj][0] * rs; *(f32x4*)(op + bj * HALF + 4) = x1 + acc[ai][bj][m][1] * wv[bj][1] * rs; } }
    }
};
}
#define XB_TMO      128
#define XB_XCNT(j)  (256  + 64 * (j))
#define XB_XSUB(j)  (1280 + 64 * (j))
#define XB_XGEN(j)  (2304 + 64 * (j))
#define XB_TOP      3328
#define XB_TOPGEN   3392
#define XCD_BAR_WORDS 3456
#define XB_SPIN_CAP (1u << 18)

__device__ __forceinline__ unsigned xb_ld(unsigned* p)              { return __hip_atomic_load(p, __ATOMIC_RELAXED, __HIP_MEMORY_SCOPE_AGENT); }
__device__ __forceinline__ unsigned xb_add(unsigned* p, unsigned v) { return __hip_atomic_fetch_add(p, v, __ATOMIC_RELAXED, __HIP_MEMORY_SCOPE_AGENT); }
__device__ __forceinline__ unsigned xb_xcc_id() { return (unsigned)__builtin_amdgcn_s_getreg((3 << 11) | 20) & 0xFu; }
#define XB_SPIN(cond, bar) do { unsigned _sp = 0; while (cond) { __builtin_amdgcn_s_sleep(1); \
    if ((++_sp & 255u) == 0u) { if (xb_ld(&(bar)[XB_TMO])) break; if (_sp > XB_SPIN_CAP) { atomicAdd(&(bar)[XB_TMO], 1u); break; } } } } while (0)

struct XcdBarrier {
    unsigned* bar; unsigned x;
    volatile LAS unsigned* st;
};

__device__ __forceinline__ XcdBarrier xcd_barrier_post(unsigned* bar, volatile LAS unsigned* st) {
    XcdBarrier b; b.bar = bar; b.x = xb_xcc_id(); b.st = st;
    if (threadIdx.x == 0) (void)xb_add(&bar[XB_XCNT(b.x)], 1u);
    return b;
}
__device__ __forceinline__ void xcd_barrier_complete(unsigned* bar, unsigned x, unsigned& nloc, unsigned& nx) {
    const unsigned G = gridDim.x * gridDim.y * gridDim.z;
    unsigned sum, cnt, mine, sp = 0u;
    for (;;) {
        sum = 0u; cnt = 0u; mine = 0u;
#pragma unroll
        for (unsigned j = 0; j < 16; ++j) { const unsigned c = xb_ld(&bar[XB_XCNT(j)]); sum += c; cnt += (c > 0u) ? 1u : 0u; mine = (j == x) ? c : mine; }
        if (sum == G) break;
        __builtin_amdgcn_s_sleep(1);
        if ((++sp & 255u) == 0u) { if (xb_ld(&bar[XB_TMO])) break; if (sp > XB_SPIN_CAP) { atomicAdd(&bar[XB_TMO], 1u); break; } }
    }
    nloc = mine > 0u ? mine : 1u; nx = cnt > 0u ? cnt : 1u;
}

__device__ __forceinline__ void xcd_barrier(const XcdBarrier& b) {
    asm volatile("s_waitcnt vmcnt(0)" ::: "memory");
    __syncthreads();
    if (threadIdx.x == 0) {
        unsigned* bar = b.bar;
        __builtin_amdgcn_s_waitcnt(0);
        unsigned nloc = b.st[0], nx = b.st[1];
        if (nloc == 0u) { xcd_barrier_complete(bar, b.x, nloc, nx); b.st[0] = nloc; b.st[1] = nx; }
        const unsigned old = xb_add(&bar[XB_XSUB(b.x)], 1u);
        const unsigned gen = old / nloc;
        if (old + 1u == (gen + 1u) * nloc) {
            __builtin_amdgcn_fence(__ATOMIC_RELEASE, "agent");
            asm volatile("s_waitcnt vmcnt(0)" ::: "memory");
            const unsigned og = xb_add(&bar[XB_TOP], 1u);
            const unsigned tg = og / nx;
            if (og + 1u == (tg + 1u) * nx) xb_add(&bar[XB_TOPGEN], 1u);
            else XB_SPIN(xb_ld(&bar[XB_TOPGEN]) == tg, bar);
            __builtin_amdgcn_fence(__ATOMIC_ACQUIRE, "agent");
            xb_add(&bar[XB_XGEN(b.x)], 1u);
            asm volatile("s_waitcnt vmcnt(0)" ::: "memory");
        } else {
            XB_SPIN(xb_ld(&bar[XB_XGEN(b.x)]) == gen, bar);
            __builtin_amdgcn_fence(__ATOMIC_ACQUIRE, "agent");
            asm volatile("s_waitcnt vmcnt(0)" ::: "memory");
        }
    }
    __syncthreads();
}
__device__ __forceinline__ void transpose_item(const float* W, int K, int N, bf16* WT, const float* kscale, LAS float* scr, int item, int lane) {
    const int nblk = (N + 31) / 32, kb = item / nblk, nb = item % nblk, k0 = 64 * kb, n0 = 32 * nb;
    const int nn = n0 + (lane & 31);
#pragma unroll 8
    for (int i = 0; i < 32; ++i) { const int kk = 2 * i + (lane >> 5); float v = (nn < N) ? W[(size_t)(k0 + kk) * N + nn] : 0.f; if (kscale) v *= kscale[k0 + kk]; scr[kk * 33 + (lane & 31)] = v; }
    LDS_WAIT();
    const int c = lane & 7;
#pragma unroll
    for (int j = 0; j < 4; ++j) { const int n = (lane >> 3) + 8 * j; const LAS float* s = scr + (8 * c) * 33 + n;
        u32x4 o; o.x = pk2(s[0 * 33], s[1 * 33]); o.y = pk2(s[2 * 33], s[3 * 33]); o.z = pk2(s[4 * 33], s[5 * 33]); o.w = pk2(s[6 * 33], s[7 * 33]);
        if (n0 + n < N) *(u32x4*)(WT + (size_t)(n0 + n) * K + k0 + 8 * c) = o; }
    LDS_WAIT();
}
__device__ __forceinline__ void phase_prep(const Args& a, LAS unsigned char* lds, int gw, int NGW, int wave, int lane) {
    LAS float* scr = (LAS float*)(lds + wave * 16384);
    bf16* WINT = (bf16*)(a.ws + WS_WINT); bf16* WOUTT = (bf16*)(a.ws + WS_WOUTT); bf16* XB = (bf16*)(a.ws + WS_XB); float* RSTD = (float*)(a.ws + WS_RSTD);
    constexpr int I_IN = (DM / 64) * ((NPROJ + 31) / 32), I_OUT = (DINNER / 64) * (DM / 32);
    const int n_items = (gridDim.x == 256) ? I_IN : I_IN + I_OUT;
    for (int it = gw; it < n_items; it += NGW) {
        if (it < I_IN) transpose_item(a.w_in, DM, NPROJ, WINT, a.npw, scr, it, lane);
        else transpose_item(a.w_out, DINNER, DM, WOUTT, nullptr, scr, it - I_IN, lane);
    }
    for (int m0 = gw * 4; m0 < M; m0 += NGW * 4) {
        f32x4 v[4][4];
#pragma unroll
        for (int r = 0; r < 4; ++r) { const f32x4* xr = (const f32x4*)(a.x + (size_t)(m0 + r) * DM) + lane;
#pragma unroll
            for (int j = 0; j < 4; ++j) v[r][j] = __builtin_nontemporal_load(xr + 64 * j); }
#pragma unroll
        for (int r = 0; r < 4; ++r) { float s = 0.f;
#pragma unroll
            for (int j = 0; j < 4; ++j) s += (v[r][j].x * v[r][j].x + v[r][j].y * v[r][j].y) + (v[r][j].z * v[r][j].z + v[r][j].w * v[r][j].w);
            s = wave_sum(s);
            if (lane == 0) RSTD[m0 + r] = 1.f / sqrtf(s * (1.f / DM) + EPS);
            u32x2* o8 = (u32x2*)(XB + (size_t)(m0 + r) * DM) + lane;
#pragma unroll
            for (int j = 0; j < 4; ++j) { u32x2 o; o.x = pk2(v[r][j].x, v[r][j].y); o.y = pk2(v[r][j].z, v[r][j].w); o8[64 * j] = o; } }
    }
}

__device__ __forceinline__ void naive_attn(const Args& a, int gw, int NGW, int lane) {
    const bf16* Q = (const bf16*)a.out; const bf16* K = Q + (size_t)M * 1024; const bf16* V = (const bf16*)(a.ws + WS_V); const bf16* G = (const bf16*)(a.ws + WS_G);
    bf16* MIX = (bf16*)(a.ws + WS_MIX);
    for (int it = gw; it < M * NH; it += NGW) {
        const int row = it >> 4, h = it & 15, t = row & (SEQ - 1), b = row >> 12;
        const float q = bf2f(Q[(size_t)row * 1024 + h * 64 + lane]);
        float op[3], lsep[3];
#pragma unroll
        for (int p = 0; p < 3; ++p) {
            const int d = (p == 0) ? 1 : (p == 1 ? 4 : 16);
            float m = -INFINITY, l = 0.f, o = 0.f;
            for (int j = 0; j <= 128; ++j) {
                const int tk = t - j * d; if (tk < 0) break;
                const size_t kr = ((size_t)(b * SEQ + tk)) * 1024 + h * 64 + lane;
                const float s = wave_sum(q * bf2f(K[kr]));
                const float mn = fmaxf(m, s), sc = exp2f(m - mn), pe = exp2f(s - mn);
                l = l * sc + pe; o = o * sc + pe * bf2f(V[kr]); m = mn;
            }
            op[p] = o / l; lsep[p] = m + log2f(l);
        }
        const float mm = fmaxf(lsep[0], fmaxf(lsep[1], lsep[2]));
        const float w0 = exp2f(lsep[0] - mm), w1 = exp2f(lsep[1] - mm), w2 = exp2f(lsep[2] - mm);
        float r = (w0 * op[0] + w1 * op[1] + w2 * op[2]) / (w0 + w1 + w2);
        r *= silu_f(bf2f(G[(size_t)row * 1024 + h * 64 + lane]));
        MIX[(size_t)row * DINNER + h * 64 + lane] = (bf16)f2bf(r);
    }
}
__device__ __forceinline__ void naive_conv(const Args& a, int gt, int NGT) {
    const bf16* XBC = (const bf16*)(a.ws + WS_XBC); bf16* XC = (bf16*)a.out; const float* DTRAW = (const float*)(a.ws + WS_DTRAW); float* DTS = (float*)(a.ws + WS_DTS);
    for (size_t i = gt; i < (size_t)M * DCONV; i += NGT) {
        const int row = (int)(i / DCONV), ch = (int)(i % DCONV), t = row & (SEQ - 1);
        float acc = a.conv_b[ch];
#pragma unroll
        for (int k = 0; k < 4; ++k) { const int tt = t - 3 + k; if (tt >= 0) acc += a.conv_w[k * DCONV + ch] * bf2f(XBC[(size_t)(row - 3 + k) * DCONV + ch]); }
        XC[i] = (bf16)f2bf(silu_f(acc));
    }
    for (int i = gt; i < M * NH; i += NGT) DTS[i] = softplus_f(DTRAW[i] + a.dt_bias[i & 15]);
}
__device__ __forceinline__ void naive_ssd(const Args& a, int gw, int NGW, int lane) {
    const bf16* XC = (const bf16*)a.out; const float* DTS = (const float*)(a.ws + WS_DTS); float* Y = (float*)(a.ws + WS_OUTPRE);
    for (int it = gw; it < NB * NH * HD; it += NGW) {
        const int p = it & 63, h = (it >> 6) & 15, b = it >> 10, g = h >> 3;
        const float av = -__expf(a.a_log[h]), dsk = a.d_skip[h];
        float h0 = 0.f, h1 = 0.f;
        for (int t = 0; t < SEQ; ++t) {
            const size_t row = (size_t)b * SEQ + t; const bf16* xr = XC + row * DCONV;
            const float dt = DTS[row * 16 + h], dA = __expf(dt * av), x = bf2f(xr[h * 64 + p]);
            const float B0 = bf2f(xr[1024 + g * 128 + lane]), B1 = bf2f(xr[1024 + g * 128 + 64 + lane]);
            const float C0 = bf2f(xr[1280 + g * 128 + lane]), C1 = bf2f(xr[1280 + g * 128 + 64 + lane]);
            h0 = h0 * dA + dt * x * B0; h1 = h1 * dA + dt * x * B1;
            const float y = wave_sum(C0 * h0 + C1 * h1) + dsk * x;
            if (lane == 0) Y[row * 1024 + h * 64 + p] = y;
        }
    }
}
__device__ __forceinline__ void naive_gnorm(const Args& a, int gw, int NGW, int lane) {
    const float* Y = (const float*)(a.ws + WS_OUTPRE); const bf16* Z = (const bf16*)(a.ws + WS_Z); bf16* MIX = (bf16*)(a.ws + WS_MIX);
    for (int it = gw; it < M * 2; it += NGW) {
        const int row = it >> 1, g = it & 1; const int c0 = g * 512 + lane * 8;
        float v[8]; float ss = 0.f;
#pragma unroll
        for (int j = 0; j < 8; ++j) { const float y = Y[(size_t)row * 1024 + c0 + j], z = bf2f(Z[(size_t)row * 1024 + c0 + j]); v[j] = y * silu_f(z); ss += v[j] * v[j]; }
        ss = wave_sum(ss); const float r = 1.f / sqrtf(ss * (1.f / 512.f) + EPS);
#pragma unroll
        for (int j = 0; j < 8; ++j) MIX[(size_t)row * DINNER + 1024 + c0 + j] = (bf16)f2bf(v[j] * r * a.ssm_nw[c0 + j]);
    }
}
__device__ __forceinline__ void phase_final(const Args& a, int gw, int NGW, int lane) {
    const float* OP = (const float*)(a.ws + WS_OUTPRE);
    for (int m = gw; m < M; m += NGW) {
        const f32x4* pr = (const f32x4*)(OP + (size_t)m * DM) + lane; const f32x4* xr = (const f32x4*)(a.x + (size_t)m * DM) + lane; const f32x4* wr = (const f32x4*)a.npost_w + lane;
        f32x4 v[4]; float s = 0.f;
#pragma unroll
        for (int j = 0; j < 4; ++j) { v[j] = pr[64 * j]; s += (v[j].x * v[j].x + v[j].y * v[j].y) + (v[j].z * v[j].z + v[j].w * v[j].w); }
        s = wave_sum(s); const float r = 1.f / sqrtf(s * (1.f / DM) + EPS);
        f32x4* orow = (f32x4*)(a.out + (size_t)m * DM) + lane;
#pragma unroll
        for (int j = 0; j < 4; ++j) orow[64 * j] = xr[64 * j] + v[j] * r * wr[64 * j];
    }
}
constexpr int AP2 = 144;
constexpr int ATT_K = 0, ATT_V = 256 * AP2, ATT_END = 512 * AP2;
static_assert(ATT_END <= 131072, "attention LDS");
#define MFMA16(a, b, c) __builtin_amdgcn_mfma_f32_16x16x32_bf16((a), (b), (c), 0, 0, 0)
__device__ __forceinline__ s16x4 tr_read(const LAS unsigned char* p) { return __builtin_bit_cast(s16x4, __builtin_amdgcn_ds_read_tr16_b64_v4i16((LAS s16x4*)p)); }
__device__ __forceinline__ bf16x8 cat8(s16x4 lo, s16x4 hi) { return (bf16x8){lo[0], lo[1], lo[2], lo[3], hi[0], hi[1], hi[2], hi[3]}; }
__device__ __forceinline__ bf16x8 pack8(f32x4 lo, f32x4 hi) { u32x4 w; w.x = pk2(lo[0], lo[1]); w.y = pk2(lo[2], lo[3]); w.z = pk2(hi[0], hi[1]); w.w = pk2(hi[2], hi[3]); return __builtin_bit_cast(bf16x8, w); }
__device__ __forceinline__ f32x4 unpack4(u32x2 v) { return (f32x4){__builtin_bit_cast(float, v.x << 16), __builtin_bit_cast(float, v.x & 0xffff0000u), __builtin_bit_cast(float, v.y << 16), __builtin_bit_cast(float, v.y & 0xffff0000u)}; }
__device__ __forceinline__ u32x2 pack4(f32x4 v) { u32x2 o; o.x = pk2(v[0], v[1]); o.y = pk2(v[2], v[3]); return o; }

__device__ __forceinline__ void attn_step(int st, int half, int& d, int& r, int& qi0, bool& fresh) {
    if (st < 16) { d = 16; r = st; qi0 = half * 128; fresh = true; }
    else if (st < 32) { d = 4; r = (st - 16) >> 2; qi0 = half * 512 + ((st - 16) & 3) * 128; fresh = ((st - 16) & 3) == 0; }
    else { d = 1; r = 0; qi0 = half * 2048 + (st - 32) * 128; fresh = (st == 32); }
}
struct AttRegs { u32x4 kc[2], vc[2], kp[2], vp[2]; bf16x8 bq[2]; };
struct AttCtx { const bf16 *Q, *K, *V, *Gt; bf16* MIX; float* LSE; LAS unsigned char* lds; size_t rowb, hb; int half, h, li, quad, w, sc, sr0; };
__device__ __forceinline__ void att_fetch(AttRegs& R, const AttCtx& c, int s) {
    int d, r, q0; bool fr; attn_step(s, c.half, d, r, q0, fr);
#pragma unroll
    for (int i = 0; i < 2; ++i) { const size_t gr = c.hb + (size_t)(q0 + c.sr0 + 64 * i) * d + r; R.kc[i] = *(const u32x4*)(c.K + gr * 64 + c.sc * 8); R.vc[i] = *(const u32x4*)(c.V + gr * 64 + c.sc * 8); }
    if (fr) {
#pragma unroll
        for (int i = 0; i < 2; ++i) { R.kp[i] = (u32x4){0u, 0u, 0u, 0u}; R.vp[i] = (u32x4){0u, 0u, 0u, 0u};
            if (q0 >= 128) { const size_t gr = c.hb + (size_t)(q0 - 128 + c.sr0 + 64 * i) * d + r; R.kp[i] = *(const u32x4*)(c.K + gr * 64 + c.sc * 8); R.vp[i] = *(const u32x4*)(c.V + gr * 64 + c.sc * 8); } } }
    const size_t gq = c.hb + (size_t)(q0 + 16 * c.w + c.li) * d + r; R.bq[0] = *(const bf16x8*)(c.Q + gq * 64 + c.quad * 8); R.bq[1] = *(const bf16x8*)(c.Q + gq * 64 + 32 + c.quad * 8);
}
__device__ __forceinline__ void att_step(AttRegs& R, const AttCtx& c, int st) {
    LAS unsigned char* lds = c.lds; const int li = c.li, quad = c.quad, w = c.w, h = c.h, sc_ = c.sc, sr0 = c.sr0;
    int d, r, qi0; bool fresh; attn_step(st, c.half, d, r, qi0, fresh);
    const int cb = st & 1;
    if (st == 16 || st == 32) asm volatile("s_waitcnt vmcnt(0)" ::: "memory");
    __syncthreads();
#pragma unroll
    for (int i = 0; i < 2; ++i) { const int rr = sr0 + 64 * i;
        *(LAS u32x4*)(lds + ATT_K + (cb * 128 + rr) * AP2 + sc_ * 16) = R.kc[i]; *(LAS u32x4*)(lds + ATT_V + (cb * 128 + rr) * AP2 + sc_ * 16) = R.vc[i];
        if (fresh) { *(LAS u32x4*)(lds + ATT_K + ((cb ^ 1) * 128 + rr) * AP2 + sc_ * 16) = R.kp[i]; *(LAS u32x4*)(lds + ATT_V + ((cb ^ 1) * 128 + rr) * AP2 + sc_ * 16) = R.vp[i]; } }
    const bf16x8 bq0 = R.bq[0], bq1 = R.bq[1];
    __syncthreads();
    if (st + 2 < 48) att_fetch(R, c, st + 2);
    const size_t grow = c.rowb + (size_t)(qi0 + 16 * w + li) * d + r;
    bf16* mp = c.MIX + grow * DINNER + h * 64 + 4 * quad;
    u32x2 prv[4], gv[4]; float lse_p = 0.f;
    if (st >= 16) { lse_p = c.LSE[grow * 16 + h];
#pragma unroll
        for (int dt = 0; dt < 4; ++dt) prv[dt] = *(const u32x2*)(mp + 16 * dt); }
    if (st >= 32) {
#pragma unroll
        for (int dt = 0; dt < 4; ++dt) gv[dt] = *(const u32x2*)(c.Gt + grow * 1024 + h * 64 + 4 * quad + 16 * dt); }
    const bool zpre = (qi0 < 128);
    f32x4 sc[9];
#pragma unroll
    for (int kt = 0; kt < 9; ++kt) { const int T = w + kt; const int ph = (T >> 3) ? cb : (cb ^ 1);
        const LAS unsigned char* kq = lds + ATT_K + (ph * 128 + (T & 7) * 16 + li) * AP2 + quad * 16;
        const bf16x8 a0 = *(const LAS bf16x8*)kq, a1 = *(const LAS bf16x8*)(kq + 64);
        f32x4 z = {0.f, 0.f, 0.f, 0.f}; z = MFMA16(a0, bq0, z); z = MFMA16(a1, bq1, z); sc[kt] = z; }
#pragma unroll
    for (int j = 0; j < 4; ++j) { if (4 * quad + j < li) sc[0][j] = -INFINITY; if (4 * quad + j > li) sc[8][j] = -INFINITY; }
    if (zpre) {
#pragma unroll
        for (int kt = 0; kt < 8; ++kt) if (w + kt < 8) sc[kt] = (f32x4){-INFINITY, -INFINITY, -INFINITY, -INFINITY}; }
    float mx = -INFINITY;
#pragma unroll
    for (int kt = 0; kt < 9; ++kt) mx = fmaxf(fmaxf(mx, fmaxf(sc[kt][0], sc[kt][1])), fmaxf(sc[kt][2], sc[kt][3]));
    mx = fmaxf(mx, __shfl_xor(mx, 16)); mx = fmaxf(mx, __shfl_xor(mx, 32));
    float l = 0.f;
#pragma unroll
    for (int kt = 0; kt < 9; ++kt)
#pragma unroll
        for (int j = 0; j < 4; ++j) { const float p = __builtin_amdgcn_exp2f(sc[kt][j] - mx); sc[kt][j] = p; l += p; }
    l += __shfl_xor(l, 16); l += __shfl_xor(l, 32);
    bf16x8 bp[5];
#pragma unroll
    for (int kp_ = 0; kp_ < 4; ++kp_) bp[kp_] = pack8(sc[2 * kp_], sc[2 * kp_ + 1]);
    bp[4] = pack8(sc[8], (f32x4){0.f, 0.f, 0.f, 0.f});
    f32x4 o[4];
#pragma unroll
    for (int dt = 0; dt < 4; ++dt) o[dt] = (f32x4){0.f, 0.f, 0.f, 0.f};
#pragma unroll
    for (int kp_ = 0; kp_ < 5; ++kp_) { const int T0 = w + 2 * kp_, T1 = T0 + 1; const int p0 = (T0 >> 3) ? cb : (cb ^ 1), p1 = (T1 >> 3) ? cb : (cb ^ 1);
        const LAS unsigned char* v0 = lds + ATT_V + (p0 * 128 + (T0 & 7) * 16 + 4 * quad + (li >> 2)) * AP2 + (li & 3) * 8;
        const LAS unsigned char* v1 = lds + ATT_V + (p1 * 128 + (T1 & 7) * 16 + 4 * quad + (li >> 2)) * AP2 + (li & 3) * 8;
#pragma unroll
        for (int dt = 0; dt < 4; ++dt) { const s16x4 lo = tr_read(v0 + dt * 32); const s16x4 hi = (kp_ < 4) ? tr_read(v1 + dt * 32) : (s16x4){0, 0, 0, 0};
            o[dt] = MFMA16(cat8(lo, hi), bp[kp_], o[dt]); } }
    const float lse_t = mx + __builtin_amdgcn_logf(l), inv_l = __builtin_amdgcn_rcpf(l);
    if (st < 16) {
#pragma unroll
        for (int dt = 0; dt < 4; ++dt) *(u32x2*)(mp + 16 * dt) = pack4(o[dt] * inv_l);
        if (quad == 0) c.LSE[grow * 16 + h] = lse_t;
    } else {
        const float mm = fmaxf(lse_p, lse_t), wa = __builtin_amdgcn_exp2f(lse_p - mm), wb = __builtin_amdgcn_exp2f(lse_t - mm);
        const float inv = __builtin_amdgcn_rcpf(wa + wb), ca = wa * inv, cbw = wb * inv * inv_l;
#pragma unroll
        for (int dt = 0; dt < 4; ++dt) { f32x4 v = unpack4(prv[dt]) * ca + o[dt] * cbw;
            if (st >= 32) { const f32x4 g = unpack4(gv[dt]); v[0] *= silu_f(g[0]); v[1] *= silu_f(g[1]); v[2] *= silu_f(g[2]); v[3] *= silu_f(g[3]); }
            *(u32x2*)(mp + 16 * dt) = pack4(v); }
        if (st < 32 && quad == 0) c.LSE[grow * 16 + h] = mm + __builtin_amdgcn_logf(wa + wb);
    }
}
__device__ __forceinline__ void phase_attn(const Args& a, LAS unsigned char* lds, int tid, int wave, int lane, int vc) {
    AttCtx c; c.Q = (const bf16*)a.out; c.K = c.Q + (size_t)M * 1024; c.V = (const bf16*)(a.ws + WS_V); c.Gt = (const bf16*)(a.ws + WS_G);
    c.MIX = (bf16*)(a.ws + WS_MIX); c.LSE = (float*)(a.ws + WS_LSE); c.lds = lds;
    c.li = lane & 15; c.quad = lane >> 4; c.w = wave; c.sc = tid & 7; c.sr0 = tid >> 3;
    for (int unit = vc; unit < NB * NH * 2; unit += gridDim.x) {
        const int bh = (unit & 7) | ((unit >> 4) << 3);
        c.half = (unit >> 3) & 1; c.h = bh & 15; const int b = bh >> 4;
        c.rowb = (size_t)b * SEQ; c.hb = (size_t)(b * NH + c.h) * SEQ;
        AttRegs R0, R1;
        att_fetch(R0, c, 0); att_fetch(R1, c, 1);
        for (int st = 0; st < 48; st += 2) { att_step(R0, c, st); att_step(R1, c, st + 1); }
    }
    __syncthreads();
}
#define LDS_BARRIER() do { asm volatile("s_waitcnt lgkmcnt(0)" ::: "memory"); __builtin_amdgcn_s_barrier(); asm volatile("" ::: "memory"); } while (0)
struct ConvRaw { u32x4 v[4]; };
__device__ __forceinline__ ConvRaw conv_load(const bf16* XBC, size_t row, int t, int ch0) {
    ConvRaw r;
#pragma unroll
    for (int k = 0; k < 4; ++k) r.v[k] = (t - 3 + k >= 0) ? *(const u32x4*)(XBC + (row - 3 + k) * DCONV + ch0) : (u32x4){0u, 0u, 0u, 0u};
    return r;
}
__device__ __forceinline__ void conv_apply(const ConvRaw& r, int ch0, const float* cw, const float* cb, f32x4& o0, f32x4& o1) {
    f32x4 a0 = *(const f32x4*)(cb + ch0), a1 = *(const f32x4*)(cb + ch0 + 4);
#pragma unroll
    for (int k = 0; k < 4; ++k) { const u32x4 v = r.v[k];
        const f32x4 w0 = *(const f32x4*)(cw + k * DCONV + ch0), w1 = *(const f32x4*)(cw + k * DCONV + ch0 + 4);
        a0 += w0 * unpack4((u32x2){v.x, v.y}); a1 += w1 * unpack4((u32x2){v.z, v.w}); }
    o0 = (f32x4){silu_f(a0[0]), silu_f(a0[1]), silu_f(a0[2]), silu_f(a0[3])}; o1 = (f32x4){silu_f(a1[0]), silu_f(a1[1]), silu_f(a1[2]), silu_f(a1[3])};
}
__device__ __forceinline__ void conv8(const bf16* XBC, size_t row, int t, int ch0, const float* cw, const float* cb, f32x4& o0, f32x4& o1) {
    const ConvRaw r = conv_load(XBC, row, t, ch0); conv_apply(r, ch0, cw, cb, o0, o1);
}
constexpr int BP2 = 272;
constexpr int SS_B = 0, SS_C = 128 * BP2, SS_XS = 2 * 128 * BP2, SS_XD = SS_XS + 128 * AP2, SS_XW = SS_XD + 128 * AP2, SS_ACS = SS_XW + 128 * AP2, SS_DT = SS_ACS + 4096, SS_END = SS_DT + 4096;
static_assert(SS_END <= LDS_BYTES, "ssd LDS");

__device__ __forceinline__ void phase_ssd_chunk(const Args& a, LAS unsigned char* lds, int tid, int wave, int lane, int vc) {
    const bf16* XBC = (const bf16*)(a.ws + WS_XBC); const float* DTRAW = (const float*)(a.ws + WS_DTRAW); float* ACS = (float*)(a.ws + WS_ACS);
    bf16* MIX = (bf16*)(a.ws + WS_MIX); bf16* ST = (bf16*)(a.ws + WS_ST);
    const int li = lane & 15, quad = lane >> 4, w = wave;
    LAS float* ACSs = (LAS float*)(lds + SS_ACS); LAS float* DTs = (LAS float*)(lds + SS_DT);
    for (int unit = vc; unit < NB * NCHK * 2; unit += gridDim.x) {
        const int g = unit & 1, c = (unit >> 1) & 31, b = unit >> 6;
        const size_t row0 = (size_t)b * SEQ + c * CHK; const int t0 = c * CHK;
        LDS_BARRIER();
        const float dtr0 = DTRAW[(row0 + 2 * lane) * 16 + 8 * g + w], dtr1 = DTRAW[(row0 + 2 * lane + 1) * 16 + 8 * g + w];
#pragma unroll 4
        for (int i = 0; i < 8; ++i) { const int item = i * NT + tid, cc = item & 31, l = item >> 5;
            const int ch0 = (cc < 16) ? (1024 + g * 128 + cc * 8) : (1280 + g * 128 + (cc - 16) * 8);
            f32x4 o0, o1; conv8(XBC, row0 + l, t0 + l, ch0, a.conv_w, a.conv_b, o0, o1);
            *(LAS bf16x8*)(lds + ((cc < 16) ? SS_B : SS_C) + l * BP2 + (cc & 15) * 16) = pack8(o0, o1); }
        {   const int hh = 8 * g + w; const float av = -__expf(a.a_log[hh]), db = a.dt_bias[hh];
            const float d0 = softplus_f(dtr0 + db), d1 = softplus_f(dtr1 + db);
            const float s = (d0 + d1) * av; float inc = s;
#pragma unroll
            for (int o = 1; o < 64; o <<= 1) { const float t = __shfl_up(inc, o); if (lane >= o) inc += t; }
            const float c0 = inc - s + d0 * av, c1 = inc;
            ACSs[w * 128 + 2 * lane] = c0; ACSs[w * 128 + 2 * lane + 1] = c1; DTs[w * 128 + 2 * lane] = d0; DTs[w * 128 + 2 * lane + 1] = d1;
            ACS[(row0 + 2 * lane) * 16 + hh] = c0; ACS[(row0 + 2 * lane + 1) * 16 + hh] = c1; }
        LDS_BARRIER();
        const int npair = (w >> 1) + 1;
        f32x4 cbt[8];
        {   bf16x8 bc[4];
#pragma unroll
            for (int ks = 0; ks < 4; ++ks) bc[ks] = *(const LAS bf16x8*)(lds + SS_C + (16 * w + li) * BP2 + ks * 64 + quad * 16);
#pragma unroll
            for (int st = 0; st < 8; ++st) { f32x4 z = {0.f, 0.f, 0.f, 0.f};
                if (st < 2 * npair) {
#pragma unroll
                    for (int ks = 0; ks < 4; ++ks) z = MFMA16(*(const LAS bf16x8*)(lds + SS_B + (16 * st + li) * BP2 + ks * 64 + quad * 16), bc[ks], z); }
                cbt[st] = z; } }
        ConvRaw xr[2];
#pragma unroll
        for (int i = 0; i < 2; ++i) { const int item = i * NT + tid, cc = item & 7, l = item >> 3; xr[i] = conv_load(XBC, row0 + l, t0 + l, 8 * g * 64 + cc * 8); }
        for (int hh = 0; hh < 8; ++hh) {
            const int h = 8 * g + hh; const float dsk = a.d_skip[h];
            LDS_BARRIER();
            const float alast = ACSs[hh * 128 + 127];
#pragma unroll
            for (int i = 0; i < 2; ++i) { const int item = i * NT + tid, cc = item & 7, l = item >> 3;
                f32x4 o0, o1; conv_apply(xr[i], h * 64 + cc * 8, a.conv_w, a.conv_b, o0, o1);
                if (hh < 7) xr[i] = conv_load(XBC, row0 + l, t0 + l, (h + 1) * 64 + cc * 8);
                const float dt = DTs[hh * 128 + l], dw = dt * __expf(alast - ACSs[hh * 128 + l]);
                *(LAS bf16x8*)(lds + SS_XS + l * AP2 + cc * 16) = pack8(o0, o1);
                *(LAS bf16x8*)(lds + SS_XD + l * AP2 + cc * 16) = pack8(o0 * dt, o1 * dt);
                *(LAS bf16x8*)(lds + SS_XW + l * AP2 + cc * 16) = pack8(o0 * dw, o1 * dw); }
            LDS_BARRIER();
            const float al = ACSs[hh * 128 + 16 * w + li];
            f32x4 o[4];
#pragma unroll
            for (int pt = 0; pt < 4; ++pt) o[pt] = (f32x4){0.f, 0.f, 0.f, 0.f};
            const LAS unsigned char* xdb = lds + SS_XD + (4 * quad + (li >> 2)) * AP2 + (li & 3) * 8;
#pragma unroll
            for (int kp = 0; kp < 4; ++kp) {
                if (kp < npair) {
                    f32x4 lt[2];
#pragma unroll
                    for (int t = 0; t < 2; ++t) { const f32x4 as = *(const LAS f32x4*)(ACSs + hh * 128 + 16 * (2 * kp + t) + 4 * quad);
#pragma unroll
                        for (int e = 0; e < 4; ++e) { const int s = 16 * (2 * kp + t) + 4 * quad + e; lt[t][e] = (s <= 16 * w + li) ? cbt[2 * kp + t][e] * __expf(al - as[e]) : 0.f; } }
                    const bf16x8 bp = pack8(lt[0], lt[1]);
#pragma unroll
                    for (int pt = 0; pt < 4; ++pt) { const LAS unsigned char* p1 = xdb + (32 * kp) * AP2 + pt * 32;
                        o[pt] = MFMA16(cat8(tr_read(p1), tr_read(p1 + 16 * AP2)), bp, o[pt]); }
                }
            }
#pragma unroll
            for (int pt = 0; pt < 4; ++pt) { const f32x4 xs = unpack4(*(const LAS u32x2*)(lds + SS_XS + (16 * w + li) * AP2 + (16 * pt + 4 * quad) * 2));
                *(u32x2*)(MIX + (row0 + 16 * w + li) * DINNER + 1024 + h * 64 + 16 * pt + 4 * quad) = pack4(o[pt] + xs * dsk); }
            f32x4 sa[4];
#pragma unroll
            for (int pt = 0; pt < 4; ++pt) sa[pt] = (f32x4){0.f, 0.f, 0.f, 0.f};
            const LAS unsigned char* bb = lds + SS_B + (8 * quad + (li >> 2)) * BP2 + (16 * w + 4 * (li & 3)) * 2;
            const LAS unsigned char* xwb = lds + SS_XW + (8 * quad + (li >> 2)) * AP2 + (li & 3) * 8;
#pragma unroll
            for (int ks = 0; ks < 4; ++ks) { const bf16x8 aB = cat8(tr_read(bb + (32 * ks) * BP2), tr_read(bb + (32 * ks + 4) * BP2));
#pragma unroll
                for (int pt = 0; pt < 4; ++pt) { const LAS unsigned char* p1 = xwb + (32 * ks) * AP2 + pt * 32;
                    sa[pt] = MFMA16(aB, cat8(tr_read(p1), tr_read(p1 + 4 * AP2)), sa[pt]); } }
            bf16* stp = ST + ((((size_t)b * NCHK + c) * NH + h) * HD) * NST;
#pragma unroll
            for (int pt = 0; pt < 4; ++pt) __builtin_nontemporal_store(pack4(sa[pt]), (u32x2*)(stp + (size_t)(16 * pt + li) * NST + 16 * w + 4 * quad));
        }
    }
    __syncthreads();
}
__device__ __forceinline__ void phase_scan(const Args& a, int gt, int NGT) {
    bf16* ST = (bf16*)(a.ws + WS_ST); const float* ACS = (const float*)(a.ws + WS_ACS);
    for (int idx = gt; idx < NB * NH * HD * 16; idx += NGT) {
        const int n8 = idx & 15, p = (idx >> 4) & 63, h = (idx >> 10) & 15, b = idx >> 14;
        f32x4 s0 = {0.f, 0.f, 0.f, 0.f}, s1 = {0.f, 0.f, 0.f, 0.f};
        for (int c0 = 0; c0 < NCHK; c0 += 8) {
            u32x4 v[8]; float dec[8];
#pragma unroll
            for (int j = 0; j < 8; ++j) { const int c = c0 + j; v[j] = __builtin_nontemporal_load((const u32x4*)(ST + ((((size_t)b * NCHK + c) * NH + h) * HD + p) * NST + n8 * 8));
                dec[j] = __expf(ACS[((size_t)b * SEQ + c * CHK + 127) * 16 + h]); }
#pragma unroll
            for (int j = 0; j < 8; ++j) { const int c = c0 + j;
                u32x4 o; o.x = pk2(s0[0], s0[1]); o.y = pk2(s0[2], s0[3]); o.z = pk2(s1[0], s1[1]); o.w = pk2(s1[2], s1[3]);
                __builtin_nontemporal_store(o, (u32x4*)(ST + ((((size_t)b * NCHK + c) * NH + h) * HD + p) * NST + n8 * 8));
                s0 = s0 * dec[j] + unpack4((u32x2){v[j].x, v[j].y});
                s1 = s1 * dec[j] + unpack4((u32x2){v[j].z, v[j].w}); }
        }
    }
}
constexpr int PVP = 272, PVH = 64 * PVP, SO_PV = 128 * BP2;
static_assert(SO_PV + 4 * PVH <= LDS_BYTES, "ssd_out LDS");
__device__ __forceinline__ void phase_ssd_out(const Args& a, LAS unsigned char* lds, int tid, int wave, int lane, int vc) {
    const bf16* XBC = (const bf16*)(a.ws + WS_XBC); const float* ACS = (const float*)(a.ws + WS_ACS); const bf16* Z = (const bf16*)(a.ws + WS_Z);
    bf16* MIX = (bf16*)(a.ws + WS_MIX); const bf16* ST = (const bf16*)(a.ws + WS_ST);
    const int li = lane & 15, quad = lane >> 4, w = wave;
    for (int unit = vc; unit < NB * NCHK * 2; unit += gridDim.x) {
        const int g = unit & 1, c = (unit >> 1) & 31, b = unit >> 6;
        const size_t row0 = (size_t)b * SEQ + c * CHK; const int t0 = c * CHK;
        const size_t row = row0 + 16 * w + li;
        u32x4 pr[4]; u32x2 ydn[2][4], zn[2][4]; float eln[2];
#define SO_PREFETCH(q) do { const int hb_ = 8 * g + 2 * (q); const u32x4* src_ = (const u32x4*)(ST + ((((size_t)b * NCHK + c) * NH + hb_) * HD) * NST); \
        _Pragma("unroll") for (int i = 0; i < 4; ++i) pr[i] = src_[i * NT + tid]; \
        _Pragma("unroll") for (int hh = 0; hh < 2; ++hh) { eln[hh] = ACS[row * 16 + hb_ + hh]; \
            _Pragma("unroll") for (int pt = 0; pt < 4; ++pt) { const int col_ = (hb_ + hh) * 64 + 16 * pt + 4 * quad; \
                ydn[hh][pt] = *(const u32x2*)(MIX + row * DINNER + 1024 + col_); zn[hh][pt] = *(const u32x2*)(Z + row * 1024 + col_); } } } while (0)
        LDS_BARRIER();
#pragma unroll
        for (int i = 0; i < 4; ++i) { const int item = i * NT + tid, cc = item & 15, l = item >> 4;
            f32x4 o0, o1; conv8(XBC, row0 + l, t0 + l, 1280 + g * 128 + cc * 8, a.conv_w, a.conv_b, o0, o1);
            *(LAS bf16x8*)(lds + 0 + l * BP2 + cc * 16) = pack8(o0, o1); }
        asm volatile("" ::: "memory");
        SO_PREFETCH(0);
        bf16x8 bc[4];
        u32x2 yzp[8][4]; float ss = 0.f;
#pragma unroll
        for (int q = 0; q < 4; ++q) {
#pragma unroll
            for (int i = 0; i < 4; ++i) { const int idx = i * NT + tid, rr = idx >> 4; *(LAS u32x4*)(lds + SO_PV + (q & 1) * 2 * PVH + (rr >> 6) * PVH + (rr & 63) * PVP + (idx & 15) * 16) = pr[i]; }
            u32x2 ydc[2][4], zc[2][4]; float elc[2];
#pragma unroll
            for (int hh = 0; hh < 2; ++hh) { elc[hh] = eln[hh];
#pragma unroll
                for (int pt = 0; pt < 4; ++pt) { ydc[hh][pt] = ydn[hh][pt]; zc[hh][pt] = zn[hh][pt]; } }
            LDS_BARRIER();
            if (q == 0) {
#pragma unroll
                for (int ks = 0; ks < 4; ++ks) bc[ks] = *(const LAS bf16x8*)(lds + 0 + (16 * w + li) * BP2 + ks * 64 + quad * 16); }
            if (q < 3) SO_PREFETCH(q + 1);
#pragma unroll
            for (int hh = 0; hh < 2; ++hh) { const float e = __expf(elc[hh]);
#pragma unroll
                for (int pt = 0; pt < 4; ++pt) { f32x4 acc = {0.f, 0.f, 0.f, 0.f}; if (pt & 1) asm volatile("" ::: "memory");
#pragma unroll
                    for (int ks = 0; ks < 4; ++ks) acc = MFMA16(*(const LAS bf16x8*)(lds + SO_PV + ((q & 1) * 2 + hh) * PVH + (16 * pt + li) * PVP + ks * 64 + quad * 16), bc[ks], acc);
                    const f32x4 z = unpack4(zc[hh][pt]);
                    f32x4 y = acc * e + unpack4(ydc[hh][pt]); y[0] *= silu_f(z[0]); y[1] *= silu_f(z[1]); y[2] *= silu_f(z[2]); y[3] *= silu_f(z[3]);
                    ss += (y[0] * y[0] + y[1] * y[1]) + (y[2] * y[2] + y[3] * y[3]); yzp[2 * q + hh][pt] = pack4(y); } }
        }
#undef SO_PREFETCH
        ss += __shfl_xor(ss, 16); ss += __shfl_xor(ss, 32);
        const float r = 1.f / sqrtf(ss * (1.f / 512.f) + EPS);
#pragma unroll
        for (int hh = 0; hh < 8; ++hh) { asm volatile("" ::: "memory");
#pragma unroll
            for (int pt = 0; pt < 4; ++pt) { const int col = (8 * g + hh) * 64 + 16 * pt + 4 * quad; const f32x4 wv = *(const f32x4*)(a.ssm_nw + col);
                *(u32x2*)(MIX + row * DINNER + 1024 + col) = pack4(unpack4(yzp[hh][pt]) * wv * r); } }
    }
    __syncthreads();
}
#ifndef ONE_LAUNCH
#define ONE_LAUNCH 1
#endif
constexpr int NPHASE = 8;
#ifndef REP_ATTN
#define REP_ATTN 1
#endif
#ifndef REP_P3
#define REP_P3 1
#endif
#ifndef REP_SSD
#define REP_SSD 1
#endif
template <bool FUSED> __global__ void __launch_bounds__(NT, 2) hybrid_fwd(Args a) {
    extern __shared__ __attribute__((aligned(16))) unsigned char lds_raw[];
    LAS unsigned char* lds = (LAS unsigned char*)lds_raw;
    const int tid = threadIdx.x, lane = tid & 63, wave = __builtin_amdgcn_readfirstlane(tid >> 6);
    const int G = gridDim.x, gw = blockIdx.x * NWV + wave, NGW = G * NWV, gt = blockIdx.x * NT + tid, NGT = G * NT;
    const int lo = a.ph_lo, hi = a.ph_hi;
    volatile LAS unsigned* bst = (volatile LAS unsigned*)(lds + LDS_BYTES - 64);
    if (tid < 16) bst[tid] = 0u;
    __syncthreads();
    const XcdBarrier bar = xcd_barrier_post((unsigned*)a.ws, bst);
    unsigned* XCNT = (unsigned*)(a.ws + WS_XCNT);
    const unsigned myx = xb_xcc_id();
    if (tid == 0) bst[4] = __hip_atomic_fetch_add(XCNT + myx * 16, 1u, __ATOMIC_RELAXED, __HIP_MEMORY_SCOPE_AGENT);
#define IN(k) (lo <= (k) && (k) < hi)
#ifdef PROBE_K
    unsigned long long* tsb = (unsigned long long*)(a.ws + 262144);
#define STAMP(i) do { if (blockIdx.x == 0 && tid == 0) tsb[i] = __builtin_amdgcn_s_memrealtime(); } while (0)
#else
#define STAMP(i) do { } while (0)
#endif
    STAMP(0);
#define SEAM(k) do { if (IN(k) && IN((k) + 1)) { xcd_barrier(bar); } } while (0)
    if (hi > NPHASE) cg::this_grid().sync();
    if (IN(0)) { phase_prep(a, lds, gw, NGW, wave, lane); __syncthreads(); } SEAM(0); STAMP(1);
    if (tid == 0) { unsigned base = 0, all32 = 1;
        for (unsigned j = 0; j < 16; ++j) { const unsigned cj = __hip_atomic_load(XCNT + j * 16, __ATOMIC_RELAXED, __HIP_MEMORY_SCOPE_AGENT); if (j < myx) base += cj; if (j < 8 ? cj != 32u : cj != 0u) all32 = 0; }
        const unsigned vcu = base + bst[4];
        bst[5] = (all32 && G == 256) ? (vcu & 31u) * 8u + (vcu >> 5) : vcu; }
    __syncthreads();
    const int vc = (int)bst[5];
    if (IN(1)) {
        pg8::Gemm g{(const bf16*)(a.ws + WS_XB), (const bf16*)(a.ws + WS_WINT), M, NPADN, DM}; pg8::StaticOrder S; S.init(M, NPADN, G, vc);
        pg8::EpiProj E; E.d0 = (bf16*)a.out; E.d1 = (bf16*)a.out + (size_t)M * 1024; E.d2 = (bf16*)(a.ws + WS_V); E.d3 = (bf16*)(a.ws + WS_G); E.d4 = (bf16*)(a.ws + WS_Z);
        E.xbc = (bf16*)(a.ws + WS_XBC); E.dtraw = (float*)(a.ws + WS_DTRAW); E.rstd = (const float*)(a.ws + WS_RSTD);
        pg8::gemm_phase<pg8::EpiProj, pg8::StaticOrder, true, true>(lds, g, S, E);
        if (G == 256 && vc >= 128) {
            constexpr int I_OUT = (DINNER / 64) * (DM / 32);
            LAS float* scr = (LAS float*)(lds + wave * 16384);
            for (int it = (vc - 128) * NWV + wave; it < I_OUT; it += 128 * NWV) transpose_item(a.w_out, DINNER, DM, (bf16*)(a.ws + WS_WOUTT), nullptr, scr, it, lane);
        }
    } SEAM(1); STAMP(2);
    if (IN(2)) { for (int rep = 0; rep < REP_ATTN; ++rep) phase_attn(a, lds, tid, wave, lane, vc); }   STAMP(3);
    for (int rep = 0; rep < REP_SSD; ++rep) {
        if (rep) xcd_barrier(bar);
        if (IN(3)) { for (int r3 = 0; r3 < REP_P3; ++r3) phase_ssd_chunk(a, lds, tid, wave, lane, vc); } SEAM(3); STAMP(4);
        if (IN(4)) phase_scan(a, gt, NGT); SEAM(4); STAMP(5);
        if (IN(5)) phase_ssd_out(a, lds, tid, wave, lane, vc);
    }
    SEAM(5); STAMP(6);
    if (IN(6)) {
        pg8::Gemm g{(const bf16*)(a.ws + WS_MIX), (const bf16*)(a.ws + WS_WOUTT), M, DM, DINNER}; pg8::StaticOrder S; S.init(M, DM, G, vc);
        if constexpr (FUSED) {
            pg8::EpiRmsRes E{a.out, a.x, a.npost_w, (float*)(a.ws + WS_ROWSS), (unsigned*)(a.ws + WS_PCNT)};
            pg8::gemm_phase<pg8::EpiRmsRes, pg8::StaticOrder, true, true>(lds, g, S, E);
        } else {
            pg8::EpiF32 E{(float*)(a.ws + WS_OUTPRE), DM};
            pg8::gemm_phase<pg8::EpiF32, pg8::StaticOrder, true, true>(lds, g, S, E);
            xcd_barrier(bar);
            phase_final(a, gw, NGW, lane);
        }
    }
#ifdef PROBE_K
    __syncthreads(); STAMP(7);
    if (blockIdx.x == 0 && tid == 0) { asm volatile("s_waitcnt vmcnt(0)" ::: "memory"); const float us_ = (float)(tsb[PROBE_K + 1] - tsb[PROBE_K]) * 0.01f; a.out[0] = 1000.f * floorf(us_ * (1.f / PROBE_BIN) + 0.5f); }
#endif
#undef IN
#undef SEAM
}

extern "C" void kernel_launch(void* const* d_in, const int* in_sizes, int n_in, void* d_out, int out_size, void* d_ws, size_t ws_size, hipStream_t stream) {
    static int grid = 0;
    if (grid == 0) {
        if (n_in != 11 || out_size != M * DM || ws_size < WS_END) { fprintf(stderr, "kernel_launch: unexpected shapes (n_in %d out %d ws %zu)\n", n_in, out_size, ws_size); grid = -1; return; }
        int dev = 0, cus = 0, per_cu = 0;
        (void)hipGetDevice(&dev); (void)hipDeviceGetAttribute(&cus, hipDeviceAttributeMultiprocessorCount, dev);
        const void* fn = (cus == 256) ? (const void*)hybrid_fwd<true> : (const void*)hybrid_fwd<false>;
        if (hipFuncSetAttribute(fn, hipFuncAttributeMaxDynamicSharedMemorySize, LDS_BYTES) != hipSuccess) { fprintf(stderr, "kernel_launch: hipFuncSetAttribute failed\n"); grid = -1; return; }
        if (hipOccupancyMaxActiveBlocksPerMultiprocessor(&per_cu, fn, NT, LDS_BYTES) != hipSuccess || per_cu < 1) { fprintf(stderr, "kernel_launch: occupancy query says %d\n", per_cu); per_cu = 1; }
        (void)hipGetLastError();
        grid = cus * 1;
        fprintf(stderr, "kernel_launch: cus %d per_cu %d grid %d\n", cus, per_cu, grid);
    }
    if (grid < 0) return;
    if (hipMemsetAsync(d_ws, 0, WS_ZERO_BYTES, stream) != hipSuccess) { fprintf(stderr, "kernel_launch: memset failed\n"); return; }
    Args a{};
    a.x = (const float*)d_in[0]; a.npw = (const float*)d_in[1]; a.w_in = (const float*)d_in[2]; a.conv_w = (const float*)d_in[3]; a.conv_b = (const float*)d_in[4];
    a.dt_bias = (const float*)d_in[5]; a.a_log = (const float*)d_in[6]; a.d_skip = (const float*)d_in[7]; a.ssm_nw = (const float*)d_in[8]; a.w_out = (const float*)d_in[9]; a.npost_w = (const float*)d_in[10];
    a.out = (float*)d_out; a.ws = (unsigned char*)d_ws;
#if ONE_LAUNCH
    a.ph_lo = 0; a.ph_hi = NPHASE;
    void* args[] = {&a};
    hipError_t e = hipLaunchCooperativeKernel((grid == 256) ? (const void*)hybrid_fwd<true> : (const void*)hybrid_fwd<false>, dim3(grid), dim3(NT), args, LDS_BYTES, stream);
    if (e != hipSuccess) fprintf(stderr, "cooperative launch failed: %s (grid %d)\n", hipGetErrorString(e), grid);
#else
    for (int p = 0; p < NPHASE; ++p) { a.ph_lo = p; a.ph_hi = p + 1; hipLaunchKernelGGL(hybrid_fwd<true>, dim3(grid), dim3(NT), LDS_BYTES, stream, a); }
#endif
}
```

```cpp
#include <hip/hip_runtime.h>
#include <hip/hip_cooperative_groups.h>
#include <cstdio>
#include <cstdint>
namespace cg = cooperative_groups;
namespace pg8 {
#define PG8_LAS __attribute__((address_space(3)))
typedef unsigned short bf16_t;
typedef short bf16x8 __attribute__((ext_vector_type(8)));
typedef float f32x4 __attribute__((ext_vector_type(4)));
typedef unsigned u32x4 __attribute__((ext_vector_type(4)));
constexpr int BM = 256, BK = 64, HALF = 128, HTB = HALF * BK * 2  , STAGE_BYTES = 8 * HTB, NXCD = 8, WGM = 2;

__host__ __device__ __forceinline__ int lds_byte(int r, int c) { const int st = (r >> 4) * 2 + (c >> 5), rr = r & 15, cc = c & 31, ob = rr * 64 + cc * 2; return st * 1024 + (ob ^ (((ob >> 9) & 1) << 5)); }
__host__ __device__ __forceinline__ void stage_rc(int b, int& R, int& C) { const int st = b / 1024, sb = b % 1024, swz = sb ^ (((sb >> 9) & 1) << 5); R = (st >> 1) * 16 + swz / 64; C = (st & 1) * 32 + (swz % 64) / 2; }
__host__ __device__ __forceinline__ int perm32(int rho) { const int n = rho >> 4, i = rho & 15; return 8 * (i >> 2) + 4 * n + (i & 3); }

struct Unit { int pm, pn; };
struct Gemm { const bf16_t* A; const bf16_t* Bt; int M, N, K; };

struct StaticOrder {
    int nM, nN, nwg, G, c;
    __host__ __device__ void init(int M, int N, int G_, int c_) { nM = M / BM; nN = N / BM; nwg = nM * nN; G = G_; c = c_; }
    __host__ __device__ bool next(int i, Unit& u) const {
        const long L = (long)i * G + c; if (L >= nwg) return false;
        int wgid = (int)L; { const int q = nwg / NXCD, r = nwg % NXCD, xcd = wgid % NXCD, off = wgid / NXCD; wgid = (xcd < r ? xcd * (q + 1) : r * (q + 1) + (xcd - r) * q) + off; }
        const int nig = WGM * nN, gid = wgid / nig, fm = gid * WGM, gsz = (nM - fm) < WGM ? (nM - fm) : WGM;
        u.pm = fm + ((wgid % nig) % gsz); u.pn = (wgid % nig) / gsz; return true;
    }
    __device__ __forceinline__ void a_ready(const Unit&) const {}
    __device__ __forceinline__ void done(const Unit&) const {}
};

__device__ __forceinline__ unsigned cvt_pk_bf16(float lo, float hi) { unsigned r; asm volatile("v_cvt_pk_bf16_f32 %0, %1, %2" : "=v"(r) : "v"(lo), "v"(hi)); return r; }
template <class Epi, class Sched, bool ALIGN_EPI = false, bool SP2 = false>
__device__ __forceinline__ void gemm_phase(PG8_LAS unsigned char* lds, const Gemm g, const Sched& S, const Epi& E) {
    const int tid = threadIdx.x, wid = __builtin_amdgcn_readfirstlane(tid >> 6), lane = tid & 63, wr = wid >> 2, wc = wid & 3, fr = lane & 15, fq = lane >> 4;
    const int K = g.K, nt = K / BK;
    unsigned voffA[2], voffB[2];
#pragma unroll
    for (int i = 0; i < 2; ++i) { int R, C; stage_rc(tid * 16 + i * 8192, R, C); const int Rb = Epi::PERM ? ((R & ~31) + perm32(R & 31)) : R;
        voffA[i] = (unsigned)(R * K + C) * 2u; voffB[i] = (unsigned)(Rb * K + C) * 2u; }
    const size_t kstep = (size_t)(BK * 2);
    const size_t hstep = (size_t)HALF * K * 2;
    const size_t tstep = 2 * hstep;
    const unsigned ldsw = (unsigned)wid * 1024u;
    const int aoff = lds_byte(wr * 64 + fr, fq * 8), boff = lds_byte(wc * 32 + fr, fq * 8);
#define PG8_SA(b, h) (((b) * 2 + (h)) * HTB)
#define PG8_SB(b, h) ((4 + (b) * 2 + (h)) * HTB)
#define PG8_STAGE(bufoff, gbase, voff) do { _Pragma("unroll") for (int _i = 0; _i < 2; ++_i) \
        __builtin_amdgcn_global_load_lds((const unsigned*)((const char*)(gbase) + (voff)[_i]), (PG8_LAS unsigned*)(lds + (bufoff) + ldsw + _i * 8192), 16, 0, 0); } while (0)
#define PG8_LDA(dst, b, h) do { _Pragma("unroll") for (int m = 0; m < 4; ++m) _Pragma("unroll") for (int k = 0; k < 2; ++k) dst[m][k] = *(const PG8_LAS bf16x8*)(lds + PG8_SA(b, h) + aoff + m * 2048 + k * 1024); } while (0)
#define PG8_LDB(dst, b, h) do { _Pragma("unroll") for (int n = 0; n < 2; ++n) _Pragma("unroll") for (int k = 0; k < 2; ++k) dst[n][k] = *(const PG8_LAS bf16x8*)(lds + PG8_SB(b, h) + boff + n * 2048 + k * 1024); } while (0)
#define PG8_MMA(ai, bj, At, Bt) do { __builtin_amdgcn_s_setprio(1); _Pragma("unroll") for (int m = 0; m < 4; ++m) _Pragma("unroll") for (int n = 0; n < 2; ++n) _Pragma("unroll") for (int k = 0; k < 2; ++k) \
        acc[ai][bj][m][n] = __builtin_amdgcn_mfma_f32_16x16x32_bf16(Bt[n][k], At[m][k], acc[ai][bj][m][n], 0, 0, 0); __builtin_amdgcn_s_setprio(0); } while (0)
#define PG8_WAIT_V(n) asm volatile("s_waitcnt vmcnt(" #n ")" ::: "memory")
#define PG8_WAIT_L(n) asm volatile("s_waitcnt lgkmcnt(" #n ")" ::: "memory")
#define PG8_BAR __builtin_amdgcn_s_barrier()
#define PG8_SCHED __builtin_amdgcn_sched_barrier(0)
    Unit cur, nxt; int ui = 0;
    if (!S.next(0, cur)) return;
    f32x4 acc[2][2][4][2];
#pragma unroll
    for (int a = 0; a < 2; ++a)
#pragma unroll
        for (int b = 0; b < 2; ++b)
#pragma unroll
            for (int m = 0; m < 4; ++m)
#pragma unroll
                for (int n = 0; n < 2; ++n) acc[a][b][m][n] = (f32x4){0.f, 0.f, 0.f, 0.f};
    bf16x8 At[4][2], B0[2][2], B1[2][2];
    const char* cA = (const char*)g.A + (size_t)cur.pm * tstep; const char* cB = (const char*)g.Bt + (size_t)cur.pn * tstep;
    S.a_ready(cur);
    if constexpr (SP2) {
        PG8_STAGE(PG8_SB(0, 0), cB, voffB); PG8_STAGE(PG8_SB(0, 1), cB + hstep, voffB); PG8_STAGE(PG8_SA(0, 0), cA, voffA); PG8_STAGE(PG8_SA(0, 1), cA + hstep, voffA);
        if (wr == 1) PG8_BAR;
        PG8_WAIT_V(2); PG8_BAR;
        PG8_STAGE(PG8_SB(1, 0), cB + kstep, voffB); PG8_STAGE(PG8_SA(1, 0), cA + kstep, voffA); PG8_STAGE(PG8_SB(1, 1), cB + hstep + kstep, voffB);
        PG8_WAIT_V(6); PG8_BAR;
    } else {
        PG8_STAGE(PG8_SB(0, 0), cB, voffB); PG8_STAGE(PG8_SA(0, 0), cA, voffA); PG8_STAGE(PG8_SB(0, 1), cB + hstep, voffB); PG8_STAGE(PG8_SA(0, 1), cA + hstep, voffA);
        if (wr == 1) PG8_BAR;
        PG8_WAIT_V(4); PG8_BAR;
        PG8_STAGE(PG8_SB(1, 0), cB + kstep, voffB); PG8_STAGE(PG8_SA(1, 0), cA + kstep, voffA); PG8_STAGE(PG8_SB(1, 1), cB + hstep + kstep, voffB);
        PG8_WAIT_V(6); PG8_BAR;
    }
    for (;;) {
        const bool has_next = S.next(ui + 1, nxt);
        const char* nA = has_next ? (const char*)g.A + (size_t)nxt.pm * tstep : cA; const char* nB = has_next ? (const char*)g.Bt + (size_t)nxt.pn * tstep : cB;
        for (int t = 0; t < nt; t += 2) {
            const bool last = (t == nt - 2);
            const char* a1 = cA + (size_t)(t + 1) * kstep;
            const char* a2 = last ? nA : cA + (size_t)(t + 2) * kstep; const char* b2 = last ? nB : cB + (size_t)(t + 2) * kstep;
            const char* a3 = a2 + kstep; const char* b3 = b2 + kstep;
            if (last && has_next) S.a_ready(nxt);
            if constexpr (SP2) {
            PG8_LDB(B0, 0, 0); PG8_LDB(B1, 0, 1); PG8_SCHED; PG8_LDA(At, 0, 0); PG8_STAGE(PG8_SA(1, 1), a1 + hstep, voffA);
            PG8_WAIT_V(8); PG8_WAIT_L(0); PG8_BAR; PG8_MMA(0, 0, At, B0); PG8_MMA(0, 1, At, B1); PG8_BAR; PG8_SCHED;
            PG8_LDA(At, 0, 1); PG8_STAGE(PG8_SB(0, 0), b2, voffB); PG8_STAGE(PG8_SB(0, 1), b2 + hstep, voffB); PG8_STAGE(PG8_SA(0, 0), a2, voffA);
            PG8_WAIT_V(8); PG8_WAIT_L(0); PG8_BAR; PG8_MMA(1, 0, At, B0); PG8_MMA(1, 1, At, B1); PG8_BAR; PG8_SCHED;
            PG8_LDB(B0, 1, 0); PG8_LDB(B1, 1, 1); PG8_SCHED; PG8_LDA(At, 1, 0); PG8_STAGE(PG8_SA(0, 1), a2 + hstep, voffA);
            PG8_WAIT_V(8); PG8_WAIT_L(0); PG8_BAR; PG8_MMA(0, 0, At, B0); PG8_MMA(0, 1, At, B1); PG8_BAR; PG8_SCHED;
            PG8_LDA(At, 1, 1); PG8_STAGE(PG8_SB(1, 0), b3, voffB); PG8_STAGE(PG8_SB(1, 1), b3 + hstep, voffB); PG8_STAGE(PG8_SA(1, 0), a3, voffA);
            PG8_WAIT_V(8); PG8_WAIT_L(0); PG8_BAR; PG8_MMA(1, 0, At, B0); PG8_MMA(1, 1, At, B1); PG8_BAR; PG8_SCHED;
            } else {
            PG8_LDB(B0, 0, 0); PG8_SCHED; PG8_LDA(At, 0, 0); PG8_STAGE(PG8_SA(1, 1), a1 + hstep, voffA);
            PG8_WAIT_L(8); PG8_BAR; PG8_WAIT_L(0); PG8_MMA(0, 0, At, B0); PG8_BAR; PG8_SCHED;
            PG8_LDB(B1, 0, 1); PG8_STAGE(PG8_SB(0, 0), b2, voffB);
            PG8_BAR; PG8_WAIT_L(0); PG8_MMA(0, 1, At, B1); PG8_BAR;
            PG8_LDA(At, 0, 1); PG8_STAGE(PG8_SA(0, 0), a2, voffA);
            PG8_BAR; PG8_WAIT_L(0); PG8_MMA(1, 0, At, B0); PG8_BAR; PG8_SCHED;
            PG8_STAGE(PG8_SB(0, 1), b2 + hstep, voffB);
            PG8_WAIT_V(6); PG8_BAR; PG8_MMA(1, 1, At, B1); PG8_BAR;
            PG8_LDB(B0, 1, 0); PG8_SCHED; PG8_LDA(At, 1, 0); PG8_STAGE(PG8_SA(0, 1), a2 + hstep, voffA);
            PG8_WAIT_L(8); PG8_BAR; PG8_WAIT_L(0); PG8_MMA(0, 0, At, B0); PG8_BAR; PG8_SCHED;
            PG8_LDB(B1, 1, 1); PG8_STAGE(PG8_SB(1, 0), b3, voffB);
            PG8_BAR; PG8_WAIT_L(0); PG8_MMA(0, 1, At, B1); PG8_BAR;
            PG8_LDA(At, 1, 1); PG8_STAGE(PG8_SA(1, 0), a3, voffA);
            PG8_BAR; PG8_WAIT_L(0); PG8_MMA(1, 0, At, B0); PG8_BAR; PG8_SCHED;
            PG8_STAGE(PG8_SB(1, 1), b3 + hstep, voffB);
            PG8_WAIT_V(6); PG8_BAR; PG8_MMA(1, 1, At, B1); PG8_BAR;
            }
        }
        if constexpr (ALIGN_EPI) { if (wr == 0) PG8_BAR; }
        if constexpr (!Epi::AFTER_DRAIN) { E(acc, cur, wr, wc, fr, fq); S.done(cur); }
        if (!has_next) break;
#pragma unroll
        for (int a = 0; a < 2; ++a)
#pragma unroll
            for (int b = 0; b < 2; ++b)
#pragma unroll
                for (int m = 0; m < 4; ++m)
#pragma unroll
                    for (int n = 0; n < 2; ++n) acc[a][b][m][n] = (f32x4){0.f, 0.f, 0.f, 0.f};
        cur = nxt; cA = nA; cB = nB; ++ui;
        if constexpr (ALIGN_EPI) { if (wr == 1) PG8_BAR; }
    }
    PG8_WAIT_V(0);
    if constexpr (!ALIGN_EPI) { if (wr == 0) PG8_BAR; }
    PG8_BAR;
    if constexpr (Epi::AFTER_DRAIN) { E.fused(acc, cur, wr, wc, fr, fq, lds, wid, lane); S.done(cur); }
#undef PG8_SA
#undef PG8_SB
#undef PG8_STAGE
#undef PG8_LDA
#undef PG8_LDB
#undef PG8_MMA
#undef PG8_WAIT_V
#undef PG8_WAIT_L
#undef PG8_BAR
#undef PG8_SCHED
}
}
#define GAS __attribute__((address_space(1)))
#define LAS __attribute__((address_space(3)))
typedef unsigned short bf16;
typedef float f32x4 __attribute__((ext_vector_type(4)));
typedef short bf16x8 __attribute__((ext_vector_type(8)));
typedef short s16x4 __attribute__((ext_vector_type(4)));
typedef unsigned u32x4 __attribute__((ext_vector_type(4)));
typedef unsigned u32x2 __attribute__((ext_vector_type(2)));
constexpr int NB = 8, SEQ = 4096, DM = 1024, M = NB * SEQ;
constexpr int NH = 16, HD = 64, DSSM = 1024, DCONV = 1536, NST = 128, CHK = 128, NCHK = SEQ / CHK, NPROJ = 6672, NPADN = 6912, DINNER = 2048;
constexpr float EPS = 1e-6f;
constexpr float LOG2E = 1.4426950408889634f;
constexpr float QSCALE = 0.125f * LOG2E;
constexpr int NT = 512, NWV = 8;
constexpr size_t MiB = 1u << 20;
constexpr size_t WS_PCNT = 16384;
constexpr size_t WS_XCNT = 32768;
constexpr size_t WS_ROWSS = 65536;
constexpr size_t WS_ZERO_BYTES = 65536 + 131072;
constexpr size_t WS_RSTD = MiB / 2;
constexpr size_t WS_WINT = 1 * MiB;
constexpr size_t WS_WOUTT = 15 * MiB;
constexpr size_t WS_DTRAW = 19 * MiB;
constexpr size_t WS_ACS = 21 * MiB;
constexpr size_t WS_DTS = 23 * MiB;
constexpr size_t WS_LSE = 25 * MiB;
constexpr size_t WS_XB = 32 * MiB;
constexpr size_t WS_ST = 32 * MiB;
constexpr size_t WS_V = 96 * MiB, WS_G = 160 * MiB;
constexpr size_t WS_OUTPRE = 96 * MiB;
constexpr size_t WS_Z = 224 * MiB;
constexpr size_t WS_XBC = 288 * MiB;
constexpr size_t WS_MIX = 384 * MiB;
constexpr size_t WS_END = 512 * MiB;
constexpr int LDS_BYTES = 147456;

struct Args { const float *x, *npw, *w_in, *conv_w, *conv_b, *dt_bias, *a_log, *d_skip, *ssm_nw, *w_out, *npost_w; float* out; unsigned char* ws; int ph_lo, ph_hi; };

__device__ __forceinline__ float bf2f(unsigned u) { return __builtin_bit_cast(float, u << 16); }
__device__ __forceinline__ unsigned f2bf(float f) { unsigned u = __builtin_bit_cast(unsigned, f); return (u + 0x7fffu + ((u >> 16) & 1u)) >> 16; }
typedef float f32x2_t __attribute__((ext_vector_type(2))); typedef __bf16 bf16x2_t __attribute__((ext_vector_type(2)));
__device__ __forceinline__ unsigned pk2(float lo, float hi) { f32x2_t v = {lo, hi}; bf16x2_t b = __builtin_convertvector(v, bf16x2_t); return __builtin_bit_cast(unsigned, b); }
__device__ __forceinline__ float wave_sum(float v) {
#pragma unroll
    for (int o = 1; o < 64; o <<= 1) v += __shfl_xor(v, o);
    return v;
}
__device__ __forceinline__ float silu_f(float v) { return v * __builtin_amdgcn_rcpf(1.f + __builtin_amdgcn_exp2f(-LOG2E * v)); }
__device__ __forceinline__ float softplus_f(float v) { return v > 20.f ? v : log1pf(__expf(v)); }
#define LDS_WAIT() asm volatile("s_waitcnt lgkmcnt(0)" ::: "memory")

namespace pg8 {
struct EpiProj {
    static constexpr bool PERM = true, AFTER_DRAIN = false;
    bf16 *d0, *d1, *d2, *d3, *d4; bf16* xbc; float* dtraw; const float* rstd;
    __device__ __forceinline__ void operator()(const f32x4 (&acc)[2][2][4][2], const Unit& u, int wr, int wc, int fr, int fq) const {
        const int row0 = u.pm * BM + wr * 64 + fr; const int pn = u.pn;
        if (pn == 26) {
            if (wc == 0 && fq < 2) {
#pragma unroll
                for (int ai = 0; ai < 2; ++ai)
#pragma unroll
                    for (int m = 0; m < 4; ++m) { const int row = row0 + ai * HALF + m * 16; const float rs = rstd[row];
                        float* p = dtraw + (size_t)row * 16 + 8 * fq; *(f32x4*)p = acc[ai][0][m][0] * rs; *(f32x4*)(p + 4) = acc[ai][0][m][1] * rs; }
            }
            return;
        }
        bf16* base; int ldc, colt; float sc = 1.f;
        if (pn < 20) { const int sel = pn >> 2; base = sel == 0 ? d0 : sel == 1 ? d1 : sel == 2 ? d2 : sel == 3 ? d3 : d4; ldc = 1024; colt = (pn & 3) * BM; if (pn < 4) sc = QSCALE; }
        else { base = xbc; ldc = DCONV; colt = (pn - 20) * BM; }
        const int col0 = colt + wc * 32 + 8 * fq; const bool hm = pn < 12;
#pragma unroll
        for (int ai = 0; ai < 2; ++ai)
#pragma unroll
            for (int m = 0; m < 4; ++m) { const int row = row0 + ai * HALF + m * 16; const float rs = rstd[row] * sc;
#pragma unroll
                for (int bj = 0; bj < 2; ++bj) { const f32x4 v0 = acc[ai][bj][m][0] * rs, v1 = acc[ai][bj][m][1] * rs; const int col = col0 + bj * HALF;
                    bf16* p = hm ? base + ((size_t)((row >> 12) * NH + (col >> 6)) * SEQ + (row & (SEQ - 1))) * HD + (col & 63) : base + (size_t)row * ldc + col;
                    u32x4 w; w.x = cvt_pk_bf16(v0[0], v0[1]); w.y = cvt_pk_bf16(v0[2], v0[3]); w.z = cvt_pk_bf16(v1[0], v1[1]); w.w = cvt_pk_bf16(v1[2], v1[3]);
                    __builtin_nontemporal_store(w, (u32x4*)p); } }
    }
};
struct EpiF32 {
    static constexpr bool PERM = true, AFTER_DRAIN = false;
    float* O; int ldc;
    __device__ __forceinline__ void operator()(const f32x4 (&acc)[2][2][4][2], const Unit& u, int wr, int wc, int fr, int fq) const {
        const int row0 = u.pm * BM + wr * 64 + fr, col0 = u.pn * BM + wc * 32 + 8 * fq;
#pragma unroll
        for (int ai = 0; ai < 2; ++ai)
#pragma unroll
            for (int m = 0; m < 4; ++m) { float* rowp = O + (size_t)(row0 + ai * HALF + m * 16) * ldc + col0;
#pragma unroll
                for (int bj = 0; bj < 2; ++bj) { *(f32x4*)(rowp + bj * HALF) = acc[ai][bj][m][0]; *(f32x4*)(rowp + bj * HALF + 4) = acc[ai][bj][m][1]; } }
    }
};
struct EpiRmsRes {
    static constexpr bool PERM = true, AFTER_DRAIN = false;
    float* O; const float* X; const float* W; float* rowss; unsigned* pcnt;
    __device__ __forceinline__ void operator()(const f32x4 (&acc)[2][2][4][2], const Unit& u, int wr, int wc, int fr, int fq) const {
        const int row0 = u.pm * BM + wr * 64 + fr, col0 = u.pn * BM + wc * 32 + 8 * fq;
#pragma unroll
        for (int ai = 0; ai < 2; ++ai)
#pragma unroll
            for (int m = 0; m < 4; ++m) { float s = 0.f;
#pragma unroll
                for (int bj = 0; bj < 2; ++bj)
#pragma unroll
                    for (int n = 0; n < 2; ++n) { const f32x4 v = acc[ai][bj][m][n]; s += (v[0] * v[0] + v[1] * v[1]) + (v[2] * v[2] + v[3] * v[3]); }
                s += __shfl_xor(s, 16); s += __shfl_xor(s, 32);
                if (fq == 0) (void)__hip_atomic_fetch_add(rowss + row0 + ai * HALF + m * 16, s, __ATOMIC_RELAXED, __HIP_MEMORY_SCOPE_AGENT); }
        unsigned* cnt = pcnt + u.pm * 16;
        asm volatile("s_waitcnt vmcnt(0)" ::: "memory");
        if (threadIdx.x % 64 == 0) {
            (void)__hip_atomic_fetch_add(cnt, 1u, __ATOMIC_RELAXED, __HIP_MEMORY_SCOPE_AGENT);
            unsigned spin = 0;
            while (__hip_atomic_load(cnt, __ATOMIC_RELAXED, __HIP_MEMORY_SCOPE_AGENT) < 32u && ++spin < (1u << 22)) __builtin_amdgcn_s_sleep(2);
        }
        asm volatile("" ::: "memory");
        f32x4 wv[2][2];
#pragma unroll
        for (int bj = 0; bj < 2; ++bj) { wv[bj][0] = *(const f32x4*)(W + col0 + bj * HALF); wv[bj][1] = *(const f32x4*)(W + col0 + bj * HALF + 4); }
#pragma unroll
        for (int ai = 0; ai < 2; ++ai)
#pragma unroll
            for (int m = 0; m < 4; ++m) { const int row = row0 + ai * HALF + m * 16;
                const float ss = __hip_atomic_load(rowss + row, __ATOMIC_RELAXED, __HIP_MEMORY_SCOPE_AGENT); const float rs = 1.f / sqrtf(ss * (1.f / 1024.f) + 1e-6f);
                const float* xp = X + (size_t)row * 1024 + col0; float* op = O + (size_t)row * 1024 + col0;
#pragma unroll
                for (int bj = 0; bj < 2; ++bj) { const f32x4 x0 = __builtin_nontemporal_load((const f32x4*)(xp + bj * HALF)), x1 = __builtin_nontemporal_load((const f32x4*)(xp + bj * HALF + 4));
                    *(f32x4*)(op + bj * HALF) = x0 + acc[ai][bj][m][0] * wv[bj][0] * rs; *(f32x4*)(op + bj * HALF + 4) = x1 + acc[ai][bj][m][1] * wv[bj][1] * rs; } }
    }
};
}
#define XB_TMO      128
#define XB_XCNT(j)  (256  + 64 * (j))
#define XB_XSUB(j)  (1280 + 64 * (j))
#define XB_XGEN(j)  (2304 + 64 * (j))
#define XB_TOP      3328
#define XB_TOPGEN   3392
#define XCD_BAR_WORDS 3456
#define XB_SPIN_CAP (1u << 18)

__device__ __forceinline__ unsigned xb_ld(unsigned* p)              { return __hip_atomic_load(p, __ATOMIC_RELAXED, __HIP_MEMORY_SCOPE_AGENT); }
__device__ __forceinline__ unsigned xb_add(unsigned* p, unsigned v) { return __hip_atomic_fetch_add(p, v, __ATOMIC_RELAXED, __HIP_MEMORY_SCOPE_AGENT); }
__device__ __forceinline__ unsigned xb_xcc_id() { return (unsigned)__builtin_amdgcn_s_getreg((3 << 11) | 20) & 0xFu; }
#define XB_SPIN(cond, bar) do { unsigned _sp = 0; while (cond) { __builtin_amdgcn_s_sleep(1); \
    if ((++_sp & 255u) == 0u) { if (xb_ld(&(bar)[XB_TMO])) break; if (_sp > XB_SPIN_CAP) { atomicAdd(&(bar)[XB_TMO], 1u); break; } } } } while (0)

struct XcdBarrier {
    unsigned* bar; unsigned x;
    volatile LAS unsigned* st;
};

__device__ __forceinline__ XcdBarrier xcd_barrier_post(unsigned* bar, volatile LAS unsigned* st) {
    XcdBarrier b; b.bar = bar; b.x = xb_xcc_id(); b.st = st;
    if (threadIdx.x == 0) (void)xb_add(&bar[XB_XCNT(b.x)], 1u);
    return b;
}
__device__ __forceinline__ void xcd_barrier_complete(unsigned* bar, unsigned x, unsigned& nloc, unsigned& nx) {
    const unsigned G = gridDim.x * gridDim.y * gridDim.z;
    unsigned sum, cnt, mine, sp = 0u;
    for (;;) {
        sum = 0u; cnt = 0u; mine = 0u;
#pragma unroll
        for (unsigned j = 0; j < 16; ++j) { const unsigned c = xb_ld(&bar[XB_XCNT(j)]); sum += c; cnt += (c > 0u) ? 1u : 0u; mine = (j == x) ? c : mine; }
        if (sum == G) break;
        __builtin_amdgcn_s_sleep(1);
        if ((++sp & 255u) == 0u) { if (xb_ld(&bar[XB_TMO])) break; if (sp > XB_SPIN_CAP) { atomicAdd(&bar[XB_TMO], 1u); break; } }
    }
    nloc = mine > 0u ? mine : 1u; nx = cnt > 0u ? cnt : 1u;
}

__device__ __forceinline__ void xcd_barrier(const XcdBarrier& b) {
    asm volatile("s_waitcnt vmcnt(0)" ::: "memory");
    __syncthreads();
    if (threadIdx.x == 0) {
        unsigned* bar = b.bar;
        __builtin_amdgcn_s_waitcnt(0);
        unsigned nloc = b.st[0], nx = b.st[1];
        if (nloc == 0u) { xcd_barrier_complete(bar, b.x, nloc, nx); b.st[0] = nloc; b.st[1] = nx; }
        const unsigned old = xb_add(&bar[XB_XSUB(b.x)], 1u);
        const unsigned gen = old / nloc;
        if (old + 1u == (gen + 1u) * nloc) {
            __builtin_amdgcn_fence(__ATOMIC_RELEASE, "agent");
            asm volatile("s_waitcnt vmcnt(0)" ::: "memory");
            const unsigned og = xb_add(&bar[XB_TOP], 1u);
            const unsigned tg = og / nx;
            if (og + 1u == (tg + 1u) * nx) xb_add(&bar[XB_TOPGEN], 1u);
            else XB_SPIN(xb_ld(&bar[XB_TOPGEN]) == tg, bar);
            __builtin_amdgcn_fence(__ATOMIC_ACQUIRE, "agent");
            xb_add(&bar[XB_XGEN(b.x)], 1u);
            asm volatile("s_waitcnt vmcnt(0)" ::: "memory");
        } else {
            XB_SPIN(xb_ld(&bar[XB_XGEN(b.x)]) == gen, bar);
            __builtin_amdgcn_fence(__ATOMIC_ACQUIRE, "agent");
            asm volatile("s_waitcnt vmcnt(0)" ::: "memory");
        }
    }
    __syncthreads();
}
__device__ __forceinline__ void transpose_item(const float* W, int K, int N, bf16* WT, const float* kscale, LAS float* scr, int item, int lane) {
    const int nblk = (N + 31) / 32, kb = item / nblk, nb = item % nblk, k0 = 64 * kb, n0 = 32 * nb;
    const int nn = n0 + (lane & 31);
#pragma unroll 8
    for (int i = 0; i < 32; ++i) { const int kk = 2 * i + (lane >> 5); float v = (nn < N) ? W[(size_t)(k0 + kk) * N + nn] : 0.f; if (kscale) v *= kscale[k0 + kk]; scr[kk * 33 + (lane & 31)] = v; }
    LDS_WAIT();
    const int c = lane & 7;
#pragma unroll
    for (int j = 0; j < 4; ++j) { const int n = (lane >> 3) + 8 * j; const LAS float* s = scr + (8 * c) * 33 + n;
        u32x4 o; o.x = pk2(s[0 * 33], s[1 * 33]); o.y = pk2(s[2 * 33], s[3 * 33]); o.z = pk2(s[4 * 33], s[5 * 33]); o.w = pk2(s[6 * 33], s[7 * 33]);
        if (n0 + n < N) *(u32x4*)(WT + (size_t)(n0 + n) * K + k0 + 8 * c) = o; }
    LDS_WAIT();
}
__device__ __forceinline__ void phase_prep(const Args& a, LAS unsigned char* lds, int gw, int NGW, int wave, int lane) {
    LAS float* scr = (LAS float*)(lds + wave * 16384);
    bf16* WINT = (bf16*)(a.ws + WS_WINT); bf16* WOUTT = (bf16*)(a.ws + WS_WOUTT); bf16* XB = (bf16*)(a.ws + WS_XB); float* RSTD = (float*)(a.ws + WS_RSTD);
    constexpr int I_IN = (DM / 64) * ((NPROJ + 31) / 32), I_OUT = (DINNER / 64) * (DM / 32);
    const int n_items = (gridDim.x == 256) ? I_IN : I_IN + I_OUT;
    for (int it = gw; it < n_items; it += NGW) {
        if (it < I_IN) transpose_item(a.w_in, DM, NPROJ, WINT, a.npw, scr, it, lane);
        else transpose_item(a.w_out, DINNER, DM, WOUTT, nullptr, scr, it - I_IN, lane);
    }
    for (int m0 = gw * 4; m0 < M; m0 += NGW * 4) {
        f32x4 v[4][4];
#pragma unroll
        for (int r = 0; r < 4; ++r) { const f32x4* xr = (const f32x4*)(a.x + (size_t)(m0 + r) * DM) + lane;
#pragma unroll
            for (int j = 0; j < 4; ++j) v[r][j] = __builtin_nontemporal_load(xr + 64 * j); }
#pragma unroll
        for (int r = 0; r < 4; ++r) { float s = 0.f;
#pragma unroll
            for (int j = 0; j < 4; ++j) s += (v[r][j].x * v[r][j].x + v[r][j].y * v[r][j].y) + (v[r][j].z * v[r][j].z + v[r][j].w * v[r][j].w);
            s = wave_sum(s);
            if (lane == 0) RSTD[m0 + r] = 1.f / sqrtf(s * (1.f / DM) + EPS);
            u32x2* o8 = (u32x2*)(XB + (size_t)(m0 + r) * DM) + lane;
#pragma unroll
            for (int j = 0; j < 4; ++j) { u32x2 o; o.x = pk2(v[r][j].x, v[r][j].y); o.y = pk2(v[r][j].z, v[r][j].w); o8[64 * j] = o; } }
    }
}

__device__ __forceinline__ void naive_attn(const Args& a, int gw, int NGW, int lane) {
    const bf16* Q = (const bf16*)a.out; const bf16* K = Q + (size_t)M * 1024; const bf16* V = (const bf16*)(a.ws + WS_V); const bf16* G = (const bf16*)(a.ws + WS_G);
    bf16* MIX = (bf16*)(a.ws + WS_MIX);
    for (int it = gw; it < M * NH; it += NGW) {
        const int row = it >> 4, h = it & 15, t = row & (SEQ - 1), b = row >> 12;
        const float q = bf2f(Q[(size_t)row * 1024 + h * 64 + lane]);
        float op[3], lsep[3];
#pragma unroll
        for (int p = 0; p < 3; ++p) {
            const int d = (p == 0) ? 1 : (p == 1 ? 4 : 16);
            float m = -INFINITY, l = 0.f, o = 0.f;
            for (int j = 0; j <= 128; ++j) {
                const int tk = t - j * d; if (tk < 0) break;
                const size_t kr = ((size_t)(b * SEQ + tk)) * 1024 + h * 64 + lane;
                const float s = wave_sum(q * bf2f(K[kr]));
                const float mn = fmaxf(m, s), sc = exp2f(m - mn), pe = exp2f(s - mn);
                l = l * sc + pe; o = o * sc + pe * bf2f(V[kr]); m = mn;
            }
            op[p] = o / l; lsep[p] = m + log2f(l);
        }
        const float mm = fmaxf(lsep[0], fmaxf(lsep[1], lsep[2]));
        const float w0 = exp2f(lsep[0] - mm), w1 = exp2f(lsep[1] - mm), w2 = exp2f(lsep[2] - mm);
        float r = (w0 * op[0] + w1 * op[1] + w2 * op[2]) / (w0 + w1 + w2);
        r *= silu_f(bf2f(G[(size_t)row * 1024 + h * 64 + lane]));
        MIX[(size_t)row * DINNER + h * 64 + lane] = (bf16)f2bf(r);
    }
}
__device__ __forceinline__ void naive_conv(const Args& a, int gt, int NGT) {
    const bf16* XBC = (const bf16*)(a.ws + WS_XBC); bf16* XC = (bf16*)a.out; const float* DTRAW = (const float*)(a.ws + WS_DTRAW); float* DTS = (float*)(a.ws + WS_DTS);
    for (size_t i = gt; i < (size_t)M * DCONV; i += NGT) {
        const int row = (int)(i / DCONV), ch = (int)(i % DCONV), t = row & (SEQ - 1);
        float acc = a.conv_b[ch];
#pragma unroll
        for (int k = 0; k < 4; ++k) { const int tt = t - 3 + k; if (tt >= 0) acc += a.conv_w[k * DCONV + ch] * bf2f(XBC[(size_t)(row - 3 + k) * DCONV + ch]); }
        XC[i] = (bf16)f2bf(silu_f(acc));
    }
    for (int i = gt; i < M * NH; i += NGT) DTS[i] = softplus_f(DTRAW[i] + a.dt_bias[i & 15]);
}
__device__ __forceinline__ void naive_ssd(const Args& a, int gw, int NGW, int lane) {
    const bf16* XC = (const bf16*)a.out; const float* DTS = (const float*)(a.ws + WS_DTS); float* Y = (float*)(a.ws + WS_OUTPRE);
    for (int it = gw; it < NB * NH * HD; it += NGW) {
        const int p = it & 63, h = (it >> 6) & 15, b = it >> 10, g = h >> 3;
        const float av = -__expf(a.a_log[h]), dsk = a.d_skip[h];
        float h0 = 0.f, h1 = 0.f;
        for (int t = 0; t < SEQ; ++t) {
            const size_t row = (size_t)b * SEQ + t; const bf16* xr = XC + row * DCONV;
            const float dt = DTS[row * 16 + h], dA = __expf(dt * av), x = bf2f(xr[h * 64 + p]);
            const float B0 = bf2f(xr[1024 + g * 128 + lane]), B1 = bf2f(xr[1024 + g * 128 + 64 + lane]);
            const float C0 = bf2f(xr[1280 + g * 128 + lane]), C1 = bf2f(xr[1280 + g * 128 + 64 + lane]);
            h0 = h0 * dA + dt * x * B0; h1 = h1 * dA + dt * x * B1;
            const float y = wave_sum(C0 * h0 + C1 * h1) + dsk * x;
            if (lane == 0) Y[row * 1024 + h * 64 + p] = y;
        }
    }
}
__device__ __forceinline__ void naive_gnorm(const Args& a, int gw, int NGW, int lane) {
    const float* Y = (const float*)(a.ws + WS_OUTPRE); const bf16* Z = (const bf16*)(a.ws + WS_Z); bf16* MIX = (bf16*)(a.ws + WS_MIX);
    for (int it = gw; it < M * 2; it += NGW) {
        const int row = it >> 1, g = it & 1; const int c0 = g * 512 + lane * 8;
        float v[8]; float ss = 0.f;
#pragma unroll
        for (int j = 0; j < 8; ++j) { const float y = Y[(size_t)row * 1024 + c0 + j], z = bf2f(Z[(size_t)row * 1024 + c0 + j]); v[j] = y * silu_f(z); ss += v[j] * v[j]; }
        ss = wave_sum(ss); const float r = 1.f / sqrtf(ss * (1.f / 512.f) + EPS);
#pragma unroll
        for (int j = 0; j < 8; ++j) MIX[(size_t)row * DINNER + 1024 + c0 + j] = (bf16)f2bf(v[j] * r * a.ssm_nw[c0 + j]);
    }
}
__device__ __forceinline__ void phase_final(const Args& a, int gw, int NGW, int lane) {
    const float* OP = (const float*)(a.ws + WS_OUTPRE);
    for (int m = gw; m < M; m += NGW) {
        const f32x4* pr = (const f32x4*)(OP + (size_t)m * DM) + lane; const f32x4* xr = (const f32x4*)(a.x + (size_t)m * DM) + lane; const f32x4* wr = (const f32x4*)a.npost_w + lane;
        f32x4 v[4]; float s = 0.f;
#pragma unroll
        for (int j = 0; j < 4; ++j) { v[j] = pr[64 * j]; s += (v[j].x * v[j].x + v[j].y * v[j].y) + (v[j].z * v[j].z + v[j].w * v[j].w); }
        s = wave_sum(s); const float r = 1.f / sqrtf(s * (1.f / DM) + EPS);
        f32x4* orow = (f32x4*)(a.out + (size_t)m * DM) + lane;
#pragma unroll
        for (int j = 0; j < 4; ++j) orow[64 * j] = xr[64 * j] + v[j] * r * wr[64 * j];
    }
}
constexpr int AP2 = 144;
constexpr int ATT_K = 0, ATT_V = 256 * AP2, ATT_END = 512 * AP2;
static_assert(ATT_END <= 131072, "attention LDS");
#define MFMA16(a, b, c) __builtin_amdgcn_mfma_f32_16x16x32_bf16((a), (b), (c), 0, 0, 0)
__device__ __forceinline__ s16x4 tr_read(const LAS unsigned char* p) { return __builtin_bit_cast(s16x4, __builtin_amdgcn_ds_read_tr16_b64_v4i16((LAS s16x4*)p)); }
__device__ __forceinline__ bf16x8 cat8(s16x4 lo, s16x4 hi) { return (bf16x8){lo[0], lo[1], lo[2], lo[3], hi[0], hi[1], hi[2], hi[3]}; }
__device__ __forceinline__ bf16x8 pack8(f32x4 lo, f32x4 hi) { u32x4 w; w.x = pk2(lo[0], lo[1]); w.y = pk2(lo[2], lo[3]); w.z = pk2(hi[0], hi[1]); w.w = pk2(hi[2], hi[3]); return __builtin_bit_cast(bf16x8, w); }
__device__ __forceinline__ f32x4 unpack4(u32x2 v) { return (f32x4){__builtin_bit_cast(float, v.x << 16), __builtin_bit_cast(float, v.x & 0xffff0000u), __builtin_bit_cast(float, v.y << 16), __builtin_bit_cast(float, v.y & 0xffff0000u)}; }
__device__ __forceinline__ u32x2 pack4(f32x4 v) { u32x2 o; o.x = pk2(v[0], v[1]); o.y = pk2(v[2], v[3]); return o; }

__device__ __forceinline__ void attn_step(int st, int half, int& d, int& r, int& qi0, bool& fresh) {
    if (st < 16) { d = 16; r = st; qi0 = half * 128; fresh = true; }
    else if (st < 32) { d = 4; r = (st - 16) >> 2; qi0 = half * 512 + ((st - 16) & 3) * 128; fresh = ((st - 16) & 3) == 0; }
    else { d = 1; r = 0; qi0 = half * 2048 + (st - 32) * 128; fresh = (st == 32); }
}
struct AttRegs { u32x4 kc[2], vc[2], kp[2], vp[2]; bf16x8 bq[2]; };
struct AttCtx { const bf16 *Q, *K, *V, *Gt; bf16* MIX; float* LSE; LAS unsigned char* lds; size_t rowb, hb; int half, h, li, quad, w, sc, sr0; };
__device__ __forceinline__ void att_fetch(AttRegs& R, const AttCtx& c, int s) {
    int d, r, q0; bool fr; attn_step(s, c.half, d, r, q0, fr);
#pragma unroll
    for (int i = 0; i < 2; ++i) { const size_t gr = c.hb + (size_t)(q0 + c.sr0 + 64 * i) * d + r; R.kc[i] = *(const u32x4*)(c.K + gr * 64 + c.sc * 8); R.vc[i] = *(const u32x4*)(c.V + gr * 64 + c.sc * 8); }
    if (fr) {
#pragma unroll
        for (int i = 0; i < 2; ++i) { R.kp[i] = (u32x4){0u, 0u, 0u, 0u}; R.vp[i] = (u32x4){0u, 0u, 0u, 0u};
            if (q0 >= 128) { const size_t gr = c.hb + (size_t)(q0 - 128 + c.sr0 + 64 * i) * d + r; R.kp[i] = *(const u32x4*)(c.K + gr * 64 + c.sc * 8); R.vp[i] = *(const u32x4*)(c.V + gr * 64 + c.sc * 8); } } }
    const size_t gq = c.hb + (size_t)(q0 + 16 * c.w + c.li) * d + r; R.bq[0] = *(const bf16x8*)(c.Q + gq * 64 + c.quad * 8); R.bq[1] = *(const bf16x8*)(c.Q + gq * 64 + 32 + c.quad * 8);
}
__device__ __forceinline__ void att_step(AttRegs& R, const AttCtx& c, int st) {
    LAS unsigned char* lds = c.lds; const int li = c.li, quad = c.quad, w = c.w, h = c.h, sc_ = c.sc, sr0 = c.sr0;
    int d, r, qi0; bool fresh; attn_step(st, c.half, d, r, qi0, fresh);
    const int cb = st & 1;
    if (st == 16 || st == 32) asm volatile("s_waitcnt vmcnt(0)" ::: "memory");
    __syncthreads();
#pragma unroll
    for (int i = 0; i < 2; ++i) { const int rr = sr0 + 64 * i;
        *(LAS u32x4*)(lds + ATT_K + (cb * 128 + rr) * AP2 + sc_ * 16) = R.kc[i]; *(LAS u32x4*)(lds + ATT_V + (cb * 128 + rr) * AP2 + sc_ * 16) = R.vc[i];
        if (fresh) { *(LAS u32x4*)(lds + ATT_K + ((cb ^ 1) * 128 + rr) * AP2 + sc_ * 16) = R.kp[i]; *(LAS u32x4*)(lds + ATT_V + ((cb ^ 1) * 128 + rr) * AP2 + sc_ * 16) = R.vp[i]; } }
    const bf16x8 bq0 = R.bq[0], bq1 = R.bq[1];
    __syncthreads();
    if (st + 2 < 48) att_fetch(R, c, st + 2);
    const size_t grow = c.rowb + (size_t)(qi0 + 16 * w + li) * d + r;
    bf16* mp = c.MIX + grow * DINNER + h * 64 + 4 * quad;
    u32x2 prv[4], gv[4]; float lse_p = 0.f;
    if (st >= 16) { lse_p = c.LSE[grow * 16 + h];
#pragma unroll
        for (int dt = 0; dt < 4; ++dt) prv[dt] = *(const u32x2*)(mp + 16 * dt); }
    if (st >= 32) {
#pragma unroll
        for (int dt = 0; dt < 4; ++dt) gv[dt] = *(const u32x2*)(c.Gt + grow * 1024 + h * 64 + 4 * quad + 16 * dt); }
    const bool zpre = (qi0 < 128);
    f32x4 sc[9];
#pragma unroll
    for (int kt = 0; kt < 9; ++kt) { const int T = w + kt; const int ph = (T >> 3) ? cb : (cb ^ 1);
        const LAS unsigned char* kq = lds + ATT_K + (ph * 128 + (T & 7) * 16 + li) * AP2 + quad * 16;
        const bf16x8 a0 = *(const LAS bf16x8*)kq, a1 = *(const LAS bf16x8*)(kq + 64);
        f32x4 z = {0.f, 0.f, 0.f, 0.f}; z = MFMA16(a0, bq0, z); z = MFMA16(a1, bq1, z); sc[kt] = z; }
#pragma unroll
    for (int j = 0; j < 4; ++j) { if (4 * quad + j < li) sc[0][j] = -INFINITY; if (4 * quad + j > li) sc[8][j] = -INFINITY; }
    if (zpre) {
#pragma unroll
        for (int kt = 0; kt < 8; ++kt) if (w + kt < 8) sc[kt] = (f32x4){-INFINITY, -INFINITY, -INFINITY, -INFINITY}; }
    float mx = -INFINITY;
#pragma unroll
    for (int kt = 0; kt < 9; ++kt) mx = fmaxf(fmaxf(mx, fmaxf(sc[kt][0], sc[kt][1])), fmaxf(sc[kt][2], sc[kt][3]));
    mx = fmaxf(mx, __shfl_xor(mx, 16)); mx = fmaxf(mx, __shfl_xor(mx, 32));
    float l = 0.f;
#pragma unroll
    for (int kt = 0; kt < 9; ++kt)
#pragma unroll
        for (int j = 0; j < 4; ++j) { const float p = __builtin_amdgcn_exp2f(sc[kt][j] - mx); sc[kt][j] = p; l += p; }
    l += __shfl_xor(l, 16); l += __shfl_xor(l, 32);
    bf16x8 bp[5];
#pragma unroll
    for (int kp_ = 0; kp_ < 4; ++kp_) bp[kp_] = pack8(sc[2 * kp_], sc[2 * kp_ + 1]);
    bp[4] = pack8(sc[8], (f32x4){0.f, 0.f, 0.f, 0.f});
    f32x4 o[4];
#pragma unroll
    for (int dt = 0; dt < 4; ++dt) o[dt] = (f32x4){0.f, 0.f, 0.f, 0.f};
#pragma unroll
    for (int kp_ = 0; kp_ < 5; ++kp_) { const int T0 = w + 2 * kp_, T1 = T0 + 1; const int p0 = (T0 >> 3) ? cb : (cb ^ 1), p1 = (T1 >> 3) ? cb : (cb ^ 1);
        const LAS unsigned char* v0 = lds + ATT_V + (p0 * 128 + (T0 & 7) * 16 + 4 * quad + (li >> 2)) * AP2 + (li & 3) * 8;
        const LAS unsigned char* v1 = lds + ATT_V + (p1 * 128 + (T1 & 7) * 16 + 4 * quad + (li >> 2)) * AP2 + (li & 3) * 8;
#pragma unroll
        for (int dt = 0; dt < 4; ++dt) { const s16x4 lo = tr_read(v0 + dt * 32); const s16x4 hi = (kp_ < 4) ? tr_read(v1 + dt * 32) : (s16x4){0, 0, 0, 0};
            o[dt] = MFMA16(cat8(lo, hi), bp[kp_], o[dt]); } }
    const float lse_t = mx + __builtin_amdgcn_logf(l), inv_l = __builtin_amdgcn_rcpf(l);
    if (st < 16) {
#pragma unroll
        for (int dt = 0; dt < 4; ++dt) *(u32x2*)(mp + 16 * dt) = pack4(o[dt] * inv_l);
        if (quad == 0) c.LSE[grow * 16 + h] = lse_t;
    } else {
        const float mm = fmaxf(lse_p, lse_t), wa = __builtin_amdgcn_exp2f(lse_p - mm), wb = __builtin_amdgcn_exp2f(lse_t - mm);
        const float inv = __builtin_amdgcn_rcpf(wa + wb), ca = wa * inv, cbw = wb * inv * inv_l;
#pragma unroll
        for (int dt = 0; dt < 4; ++dt) { f32x4 v = unpack4(prv[dt]) * ca + o[dt] * cbw;
            if (st >= 32) { const f32x4 g = unpack4(gv[dt]); v[0] *= silu_f(g[0]); v[1] *= silu_f(g[1]); v[2] *= silu_f(g[2]); v[3] *= silu_f(g[3]); }
            *(u32x2*)(mp + 16 * dt) = pack4(v); }
        if (st < 32 && quad == 0) c.LSE[grow * 16 + h] = mm + __builtin_amdgcn_logf(wa + wb);
    }
}
__device__ __forceinline__ void phase_attn(const Args& a, LAS unsigned char* lds, int tid, int wave, int lane, int vc) {
    AttCtx c; c.Q = (const bf16*)a.out; c.K = c.Q + (size_t)M * 1024; c.V = (const bf16*)(a.ws + WS_V); c.Gt = (const bf16*)(a.ws + WS_G);
    c.MIX = (bf16*)(a.ws + WS_MIX); c.LSE = (float*)(a.ws + WS_LSE); c.lds = lds;
    c.li = lane & 15; c.quad = lane >> 4; c.w = wave; c.sc = tid & 7; c.sr0 = tid >> 3;
    for (int unit = vc; unit < NB * NH * 2; unit += gridDim.x) {
        const int bh = (unit & 7) | ((unit >> 4) << 3);
        c.half = (unit >> 3) & 1; c.h = bh & 15; const int b = bh >> 4;
        c.rowb = (size_t)b * SEQ; c.hb = (size_t)(b * NH + c.h) * SEQ;
        AttRegs R0, R1;
        att_fetch(R0, c, 0); att_fetch(R1, c, 1);
        for (int st = 0; st < 48; st += 2) { att_step(R0, c, st); att_step(R1, c, st + 1); }
    }
    __syncthreads();
}
#define LDS_BARRIER() do { asm volatile("s_waitcnt lgkmcnt(0)" ::: "memory"); __builtin_amdgcn_s_barrier(); asm volatile("" ::: "memory"); } while (0)
struct ConvRaw { u32x4 v[4]; };
__device__ __forceinline__ ConvRaw conv_load(const bf16* XBC, size_t row, int t, int ch0) {
    ConvRaw r;
#pragma unroll
    for (int k = 0; k < 4; ++k) r.v[k] = (t - 3 + k >= 0) ? *(const u32x4*)(XBC + (row - 3 + k) * DCONV + ch0) : (u32x4){0u, 0u, 0u, 0u};
    return r;
}
__device__ __forceinline__ void conv_apply(const ConvRaw& r, int ch0, const float* cw, const float* cb, f32x4& o0, f32x4& o1) {
    f32x4 a0 = *(const f32x4*)(cb + ch0), a1 = *(const f32x4*)(cb + ch0 + 4);
#pragma unroll
    for (int k = 0; k < 4; ++k) { const u32x4 v = r.v[k];
        const f32x4 w0 = *(const f32x4*)(cw + k * DCONV + ch0), w1 = *(const f32x4*)(cw + k * DCONV + ch0 + 4);
        a0 += w0 * unpack4((u32x2){v.x, v.y}); a1 += w1 * unpack4((u32x2){v.z, v.w}); }
    o0 = (f32x4){silu_f(a0[0]), silu_f(a0[1]), silu_f(a0[2]), silu_f(a0[3])}; o1 = (f32x4){silu_f(a1[0]), silu_f(a1[1]), silu_f(a1[2]), silu_f(a1[3])};
}
__device__ __forceinline__ void conv8(const bf16* XBC, size_t row, int t, int ch0, const float* cw, const float* cb, f32x4& o0, f32x4& o1) {
    const ConvRaw r = conv_load(XBC, row, t, ch0); conv_apply(r, ch0, cw, cb, o0, o1);
}
constexpr int BP2 = 272;
constexpr int SS_B = 0, SS_C = 128 * BP2, SS_XS = 2 * 128 * BP2, SS_XD = SS_XS + 128 * AP2, SS_XW = SS_XD + 128 * AP2, SS_ACS = SS_XW + 128 * AP2, SS_DT = SS_ACS + 4096, SS_END = SS_DT + 4096;
static_assert(SS_END <= LDS_BYTES, "ssd LDS");

__device__ __forceinline__ void phase_ssd_chunk(const Args& a, LAS unsigned char* lds, int tid, int wave, int lane, int vc) {
    const bf16* XBC = (const bf16*)(a.ws + WS_XBC); const float* DTRAW = (const float*)(a.ws + WS_DTRAW); float* ACS = (float*)(a.ws + WS_ACS);
    bf16* MIX = (bf16*)(a.ws + WS_MIX); bf16* ST = (bf16*)(a.ws + WS_ST);
    const int li = lane & 15, quad = lane >> 4, w = wave;
    LAS float* ACSs = (LAS float*)(lds + SS_ACS); LAS float* DTs = (LAS float*)(lds + SS_DT);
    for (int unit = vc; unit < NB * NCHK * 2; unit += gridDim.x) {
        const int g = unit & 1, c = (unit >> 1) & 31, b = unit >> 6;
        const size_t row0 = (size_t)b * SEQ + c * CHK; const int t0 = c * CHK;
        LDS_BARRIER();
        const float dtr0 = DTRAW[(row0 + 2 * lane) * 16 + 8 * g + w], dtr1 = DTRAW[(row0 + 2 * lane + 1) * 16 + 8 * g + w];
#pragma unroll 4
        for (int i = 0; i < 8; ++i) { const int item = i * NT + tid, cc = item & 31, l = item >> 5;
            const int ch0 = (cc < 16) ? (1024 + g * 128 + cc * 8) : (1280 + g * 128 + (cc - 16) * 8);
            f32x4 o0, o1; conv8(XBC, row0 + l, t0 + l, ch0, a.conv_w, a.conv_b, o0, o1);
            *(LAS bf16x8*)(lds + ((cc < 16) ? SS_B : SS_C) + l * BP2 + (cc & 15) * 16) = pack8(o0, o1); }
        {   const int hh = 8 * g + w; const float av = -__expf(a.a_log[hh]), db = a.dt_bias[hh];
            const float d0 = softplus_f(dtr0 + db), d1 = softplus_f(dtr1 + db);
            const float s = (d0 + d1) * av; float inc = s;
#pragma unroll
            for (int o = 1; o < 64; o <<= 1) { const float t = __shfl_up(inc, o); if (lane >= o) inc += t; }
            const float c0 = inc - s + d0 * av, c1 = inc;
            ACSs[w * 128 + 2 * lane] = c0; ACSs[w * 128 + 2 * lane + 1] = c1; DTs[w * 128 + 2 * lane] = d0; DTs[w * 128 + 2 * lane + 1] = d1;
            ACS[(row0 + 2 * lane) * 16 + hh] = c0; ACS[(row0 + 2 * lane + 1) * 16 + hh] = c1; }
        LDS_BARRIER();
        const int npair = (w >> 1) + 1;
        f32x4 cbt[8];
        {   bf16x8 bc[4];
#pragma unroll
            for (int ks = 0; ks < 4; ++ks) bc[ks] = *(const LAS bf16x8*)(lds + SS_C + (16 * w + li) * BP2 + ks * 64 + quad * 16);
#pragma unroll
            for (int st = 0; st < 8; ++st) { f32x4 z = {0.f, 0.f, 0.f, 0.f};
                if (st < 2 * npair) {
#pragma unroll
                    for (int ks = 0; ks < 4; ++ks) z = MFMA16(*(const LAS bf16x8*)(lds + SS_B + (16 * st + li) * BP2 + ks * 64 + quad * 16), bc[ks], z); }
                cbt[st] = z; } }
        ConvRaw xr[2];
#pragma unroll
        for (int i = 0; i < 2; ++i) { const int item = i * NT + tid, cc = item & 7, l = item >> 3; xr[i] = conv_load(XBC, row0 + l, t0 + l, 8 * g * 64 + cc * 8); }
        for (int hh = 0; hh < 8; ++hh) {
            const int h = 8 * g + hh; const float dsk = a.d_skip[h];
            LDS_BARRIER();
            const float alast = ACSs[hh * 128 + 127];
#pragma unroll
            for (int i = 0; i < 2; ++i) { const int item = i * NT + tid, cc = item & 7, l = item >> 3;
                f32x4 o0, o1; conv_apply(xr[i], h * 64 + cc * 8, a.conv_w, a.conv_b, o0, o1);
                if (hh < 7) xr[i] = conv_load(XBC, row0 + l, t0 + l, (h + 1) * 64 + cc * 8);
                const float dt = DTs[hh * 128 + l], dw = dt * __expf(alast - ACSs[hh * 128 + l]);
                *(LAS bf16x8*)(lds + SS_XS + l * AP2 + cc * 16) = pack8(o0, o1);
                *(LAS bf16x8*)(lds + SS_XD + l * AP2 + cc * 16) = pack8(o0 * dt, o1 * dt);
                *(LAS bf16x8*)(lds + SS_XW + l * AP2 + cc * 16) = pack8(o0 * dw, o1 * dw); }
            LDS_BARRIER();
            const float al = ACSs[hh * 128 + 16 * w + li];
            f32x4 o[4];
#pragma unroll
            for (int pt = 0; pt < 4; ++pt) o[pt] = (f32x4){0.f, 0.f, 0.f, 0.f};
            const LAS unsigned char* xdb = lds + SS_XD + (4 * quad + (li >> 2)) * AP2 + (li & 3) * 8;
#pragma unroll
            for (int kp = 0; kp < 4; ++kp) {
                if (kp < npair) {
                    f32x4 lt[2];
#pragma unroll
                    for (int t = 0; t < 2; ++t) { const f32x4 as = *(const LAS f32x4*)(ACSs + hh * 128 + 16 * (2 * kp + t) + 4 * quad);
#pragma unroll
                        for (int e = 0; e < 4; ++e) { const int s = 16 * (2 * kp + t) + 4 * quad + e; lt[t][e] = (s <= 16 * w + li) ? cbt[2 * kp + t][e] * __expf(al - as[e]) : 0.f; } }
                    const bf16x8 bp = pack8(lt[0], lt[1]);
#pragma unroll
                    for (int pt = 0; pt < 4; ++pt) { const LAS unsigned char* p1 = xdb + (32 * kp) * AP2 + pt * 32;
                        o[pt] = MFMA16(cat8(tr_read(p1), tr_read(p1 + 16 * AP2)), bp, o[pt]); }
                }
            }
#pragma unroll
            for (int pt = 0; pt < 4; ++pt) { const f32x4 xs = unpack4(*(const LAS u32x2*)(lds + SS_XS + (16 * w + li) * AP2 + (16 * pt + 4 * quad) * 2));
                *(u32x2*)(MIX + (row0 + 16 * w + li) * DINNER + 1024 + h * 64 + 16 * pt + 4 * quad) = pack4(o[pt] + xs * dsk); }
            f32x4 sa[4];
#pragma unroll
            for (int pt = 0; pt < 4; ++pt) sa[pt] = (f32x4){0.f, 0.f, 0.f, 0.f};
            const LAS unsigned char* bb = lds + SS_B + (8 * quad + (li >> 2)) * BP2 + (16 * w + 4 * (li & 3)) * 2;
            const LAS unsigned char* xwb = lds + SS_XW + (8 * quad + (li >> 2)) * AP2 + (li & 3) * 8;
#pragma unroll
            for (int ks = 0; ks < 4; ++ks) { const bf16x8 aB = cat8(tr_read(bb + (32 * ks) * BP2), tr_read(bb + (32 * ks + 4) * BP2));
#pragma unroll
                for (int pt = 0; pt < 4; ++pt) { const LAS unsigned char* p1 = xwb + (32 * ks) * AP2 + pt * 32;
                    sa[pt] = MFMA16(aB, cat8(tr_read(p1), tr_read(p1 + 4 * AP2)), sa[pt]); } }
            bf16* stp = ST + ((((size_t)b * NCHK + c) * NH + h) * HD) * NST;
#pragma unroll
            for (int pt = 0; pt < 4; ++pt) *(u32x2*)(stp + (size_t)(16 * pt + li) * NST + 16 * w + 4 * quad) = pack4(sa[pt]);
        }
    }
    __syncthreads();
}
__device__ __forceinline__ void phase_scan(const Args& a, int gt, int NGT) {
    bf16* ST = (bf16*)(a.ws + WS_ST); const float* ACS = (const float*)(a.ws + WS_ACS);
    for (int idx = gt; idx < NB * NH * HD * 16; idx += NGT) {
        const int n8 = idx & 15, p = (idx >> 4) & 63, h = (idx >> 10) & 15, b = idx >> 14;
        f32x4 s0 = {0.f, 0.f, 0.f, 0.f}, s1 = {0.f, 0.f, 0.f, 0.f};
        for (int c0 = 0; c0 < NCHK; c0 += 8) {
            u32x4 v[8]; float dec[8];
#pragma unroll
            for (int j = 0; j < 8; ++j) { const int c = c0 + j; v[j] = *(const u32x4*)(ST + ((((size_t)b * NCHK + c) * NH + h) * HD + p) * NST + n8 * 8);
                dec[j] = __expf(ACS[((size_t)b * SEQ + c * CHK + 127) * 16 + h]); }
#pragma unroll
            for (int j = 0; j < 8; ++j) { const int c = c0 + j;
                u32x4 o; o.x = pk2(s0[0], s0[1]); o.y = pk2(s0[2], s0[3]); o.z = pk2(s1[0], s1[1]); o.w = pk2(s1[2], s1[3]);
                *(u32x4*)(ST + ((((size_t)b * NCHK + c) * NH + h) * HD + p) * NST + n8 * 8) = o;
                s0 = s0 * dec[j] + unpack4((u32x2){v[j].x, v[j].y});
                s1 = s1 * dec[j] + unpack4((u32x2){v[j].z, v[j].w}); }
        }
    }
}
constexpr int PVP = 272, PVH = 64 * PVP, SO_PV = 128 * BP2;
static_assert(SO_PV + 4 * PVH <= LDS_BYTES, "ssd_out LDS");
__device__ __forceinline__ void phase_ssd_out(const Args& a, LAS unsigned char* lds, int tid, int wave, int lane, int vc) {
    const bf16* XBC = (const bf16*)(a.ws + WS_XBC); const float* ACS = (const float*)(a.ws + WS_ACS); const bf16* Z = (const bf16*)(a.ws + WS_Z);
    bf16* MIX = (bf16*)(a.ws + WS_MIX); const bf16* ST = (const bf16*)(a.ws + WS_ST);
    const int li = lane & 15, quad = lane >> 4, w = wave;
    for (int unit = vc; unit < NB * NCHK * 2; unit += gridDim.x) {
        const int g = unit & 1, c = (unit >> 1) & 31, b = unit >> 6;
        const size_t row0 = (size_t)b * SEQ + c * CHK; const int t0 = c * CHK;
        const size_t row = row0 + 16 * w + li;
        u32x4 pr[4]; u32x2 ydn[2][4], zn[2][4]; float eln[2];
#define SO_PREFETCH(q) do { const int hb_ = 8 * g + 2 * (q); const u32x4* src_ = (const u32x4*)(ST + ((((size_t)b * NCHK + c) * NH + hb_) * HD) * NST); \
        _Pragma("unroll") for (int i = 0; i < 4; ++i) pr[i] = src_[i * NT + tid]; \
        _Pragma("unroll") for (int hh = 0; hh < 2; ++hh) { eln[hh] = ACS[row * 16 + hb_ + hh]; \
            _Pragma("unroll") for (int pt = 0; pt < 4; ++pt) { const int col_ = (hb_ + hh) * 64 + 16 * pt + 4 * quad; \
                ydn[hh][pt] = *(const u32x2*)(MIX + row * DINNER + 1024 + col_); zn[hh][pt] = *(const u32x2*)(Z + row * 1024 + col_); } } } while (0)
        LDS_BARRIER();
#pragma unroll
        for (int i = 0; i < 4; ++i) { const int item = i * NT + tid, cc = item & 15, l = item >> 4;
            f32x4 o0, o1; conv8(XBC, row0 + l, t0 + l, 1280 + g * 128 + cc * 8, a.conv_w, a.conv_b, o0, o1);
            *(LAS bf16x8*)(lds + 0 + l * BP2 + cc * 16) = pack8(o0, o1); }
        asm volatile("" ::: "memory");
        SO_PREFETCH(0);
        bf16x8 bc[4];
        u32x2 yzp[8][4]; float ss = 0.f;
#pragma unroll
        for (int q = 0; q < 4; ++q) {
#pragma unroll
            for (int i = 0; i < 4; ++i) { const int idx = i * NT + tid, rr = idx >> 4; *(LAS u32x4*)(lds + SO_PV + (q & 1) * 2 * PVH + (rr >> 6) * PVH + (rr & 63) * PVP + (idx & 15) * 16) = pr[i]; }
            u32x2 ydc[2][4], zc[2][4]; float elc[2];
#pragma unroll
            for (int hh = 0; hh < 2; ++hh) { elc[hh] = eln[hh];
#pragma unroll
                for (int pt = 0; pt < 4; ++pt) { ydc[hh][pt] = ydn[hh][pt]; zc[hh][pt] = zn[hh][pt]; } }
            LDS_BARRIER();
            if (q == 0) {
#pragma unroll
                for (int ks = 0; ks < 4; ++ks) bc[ks] = *(const LAS bf16x8*)(lds + 0 + (16 * w + li) * BP2 + ks * 64 + quad * 16); }
            if (q < 3) SO_PREFETCH(q + 1);
#pragma unroll
            for (int hh = 0; hh < 2; ++hh) { const float e = __expf(elc[hh]);
#pragma unroll
                for (int pt = 0; pt < 4; ++pt) { f32x4 acc = {0.f, 0.f, 0.f, 0.f}; if (pt & 1) asm volatile("" ::: "memory");
#pragma unroll
                    for (int ks = 0; ks < 4; ++ks) acc = MFMA16(*(const LAS bf16x8*)(lds + SO_PV + ((q & 1) * 2 + hh) * PVH + (16 * pt + li) * PVP + ks * 64 + quad * 16), bc[ks], acc);
                    const f32x4 z = unpack4(zc[hh][pt]);
                    f32x4 y = acc * e + unpack4(ydc[hh][pt]); y[0] *= silu_f(z[0]); y[1] *= silu_f(z[1]); y[2] *= silu_f(z[2]); y[3] *= silu_f(z[3]);
                    ss += (y[0] * y[0] + y[1] * y[1]) + (y[2] * y[2] + y[3] * y[3]); yzp[2 * q + hh][pt] = pack4(y); } }
        }
#undef SO_PREFETCH
        ss += __shfl_xor(ss, 16); ss += __shfl_xor(ss, 32);
        const float r = 1.f / sqrtf(ss * (1.f / 512.f) + EPS);
#pragma unroll
        for (int hh = 0; hh < 8; ++hh) { asm volatile("" ::: "memory");
#pragma unroll
            for (int pt = 0; pt < 4; ++pt) { const int col = (8 * g + hh) * 64 + 16 * pt + 4 * quad; const f32x4 wv = *(const f32x4*)(a.ssm_nw + col);
                *(u32x2*)(MIX + row * DINNER + 1024 + col) = pack4(unpack4(yzp[hh][pt]) * wv * r); } }
    }
    __syncthreads();
}
#ifndef ONE_LAUNCH
#define ONE_LAUNCH 1
#endif
constexpr int NPHASE = 8;
#ifndef REP_ATTN
#define REP_ATTN 1
#endif
#ifndef REP_P3
#define REP_P3 1
#endif
#ifndef REP_SSD
#define REP_SSD 1
#endif
template <bool FUSED> __global__ void __launch_bounds__(NT, 2) hybrid_fwd(Args a) {
    extern __shared__ __attribute__((aligned(16))) unsigned char lds_raw[];
    LAS unsigned char* lds = (LAS unsigned char*)lds_raw;
    const int tid = threadIdx.x, lane = tid & 63, wave = __builtin_amdgcn_readfirstlane(tid >> 6);
    const int G = gridDim.x, gw = blockIdx.x * NWV + wave, NGW = G * NWV, gt = blockIdx.x * NT + tid, NGT = G * NT;
    const int lo = a.ph_lo, hi = a.ph_hi;
    volatile LAS unsigned* bst = (volatile LAS unsigned*)(lds + LDS_BYTES - 64);
    if (tid < 16) bst[tid] = 0u;
    __syncthreads();
    const XcdBarrier bar = xcd_barrier_post((unsigned*)a.ws, bst);
    unsigned* XCNT = (unsigned*)(a.ws + WS_XCNT);
    const unsigned myx = xb_xcc_id();
    if (tid == 0) bst[4] = __hip_atomic_fetch_add(XCNT + myx * 16, 1u, __ATOMIC_RELAXED, __HIP_MEMORY_SCOPE_AGENT);
#define IN(k) (lo <= (k) && (k) < hi)
#ifdef PROBE_K
    unsigned long long* tsb = (unsigned long long*)(a.ws + 262144);
#define STAMP(i) do { if (blockIdx.x == 0 && tid == 0) tsb[i] = __builtin_amdgcn_s_memrealtime(); } while (0)
#else
#define STAMP(i) do { } while (0)
#endif
    STAMP(0);
#define SEAM(k) do { if (IN(k) && IN((k) + 1)) { xcd_barrier(bar); } } while (0)
    if (hi > NPHASE) cg::this_grid().sync();
    if (IN(0)) { phase_prep(a, lds, gw, NGW, wave, lane); __syncthreads(); } SEAM(0); STAMP(1);
    if (tid == 0) { unsigned base = 0, all32 = 1;
        for (unsigned j = 0; j < 16; ++j) { const unsigned cj = __hip_atomic_load(XCNT + j * 16, __ATOMIC_RELAXED, __HIP_MEMORY_SCOPE_AGENT); if (j < myx) base += cj; if (j < 8 ? cj != 32u : cj != 0u) all32 = 0; }
        const unsigned vcu = base + bst[4];
        bst[5] = (all32 && G == 256) ? (vcu & 31u) * 8u + (vcu >> 5) : vcu; }
    __syncthreads();
    const int vc = (int)bst[5];
    if (IN(1)) {
        pg8::Gemm g{(const bf16*)(a.ws + WS_XB), (const bf16*)(a.ws + WS_WINT), M, NPADN, DM}; pg8::StaticOrder S; S.init(M, NPADN, G, vc);
        pg8::EpiProj E; E.d0 = (bf16*)a.out; E.d1 = (bf16*)a.out + (size_t)M * 1024; E.d2 = (bf16*)(a.ws + WS_V); E.d3 = (bf16*)(a.ws + WS_G); E.d4 = (bf16*)(a.ws + WS_Z);
        E.xbc = (bf16*)(a.ws + WS_XBC); E.dtraw = (float*)(a.ws + WS_DTRAW); E.rstd = (const float*)(a.ws + WS_RSTD);
        pg8::gemm_phase<pg8::EpiProj, pg8::StaticOrder, true, true>(lds, g, S, E);
        if (G == 256 && vc >= 128) {
            constexpr int I_OUT = (DINNER / 64) * (DM / 32);
            LAS float* scr = (LAS float*)(lds + wave * 16384);
            for (int it = (vc - 128) * NWV + wave; it < I_OUT; it += 128 * NWV) transpose_item(a.w_out, DINNER, DM, (bf16*)(a.ws + WS_WOUTT), nullptr, scr, it, lane);
        }
    } SEAM(1); STAMP(2);
    if (IN(2)) { for (int rep = 0; rep < REP_ATTN; ++rep) phase_attn(a, lds, tid, wave, lane, vc); }   STAMP(3);
    for (int rep = 0; rep < REP_SSD; ++rep) {
        if (rep) xcd_barrier(bar);
        if (IN(3)) { for (int r3 = 0; r3 < REP_P3; ++r3) phase_ssd_chunk(a, lds, tid, wave, lane, vc); } SEAM(3); STAMP(4);
        if (IN(4)) phase_scan(a, gt, NGT); SEAM(4); STAMP(5);
        if (IN(5)) phase_ssd_out(a, lds, tid, wave, lane, vc);
    }
    SEAM(5); STAMP(6);
    if (IN(6)) {
        pg8::Gemm g{(const bf16*)(a.ws + WS_MIX), (const bf16*)(a.ws + WS_WOUTT), M, DM, DINNER}; pg8::StaticOrder S; S.init(M, DM, G, vc);
        if constexpr (FUSED) {
            pg8::EpiRmsRes E{a.out, a.x, a.npost_w, (float*)(a.ws + WS_ROWSS), (unsigned*)(a.ws + WS_PCNT)};
            pg8::gemm_phase<pg8::EpiRmsRes, pg8::StaticOrder, true, true>(lds, g, S, E);
        } else {
            pg8::EpiF32 E{(float*)(a.ws + WS_OUTPRE), DM};
            pg8::gemm_phase<pg8::EpiF32, pg8::StaticOrder, true, true>(lds, g, S, E);
            xcd_barrier(bar);
            phase_final(a, gw, NGW, lane);
        }
    }
#ifdef PROBE_K
    __syncthreads(); STAMP(7);
    if (blockIdx.x == 0 && tid == 0) { asm volatile("s_waitcnt vmcnt(0)" ::: "memory"); const float us_ = (float)(tsb[PROBE_K + 1] - tsb[PROBE_K]) * 0.01f; a.out[0] = 1000.f * floorf(us_ * (1.f / PROBE_BIN) + 0.5f); }
#endif
#undef IN
#undef SEAM
}

extern "C" void kernel_launch(void* const* d_in, const int* in_sizes, int n_in, void* d_out, int out_size, void* d_ws, size_t ws_size, hipStream_t stream) {
    static int grid = 0;
    if (grid == 0) {
        if (n_in != 11 || out_size != M * DM || ws_size < WS_END) { fprintf(stderr, "kernel_launch: unexpected shapes (n_in %d out %d ws %zu)\n", n_in, out_size, ws_size); grid = -1; return; }
        int dev = 0, cus = 0, per_cu = 0;
        (void)hipGetDevice(&dev); (void)hipDeviceGetAttribute(&cus, hipDeviceAttributeMultiprocessorCount, dev);
        const void* fn = (cus == 256) ? (const void*)hybrid_fwd<true> : (const void*)hybrid_fwd<false>;
        if (hipFuncSetAttribute(fn, hipFuncAttributeMaxDynamicSharedMemorySize, LDS_BYTES) != hipSuccess) { fprintf(stderr, "kernel_launch: hipFuncSetAttribute failed\n"); grid = -1; return; }
        if (hipOccupancyMaxActiveBlocksPerMultiprocessor(&per_cu, fn, NT, LDS_BYTES) != hipSuccess || per_cu < 1) { fprintf(stderr, "kernel_launch: occupancy query says %d\n", per_cu); per_cu = 1; }
        (void)hipGetLastError();
        grid = cus * 1;
        fprintf(stderr, "kernel_launch: cus %d per_cu %d grid %d\n", cus, per_cu, grid);
    }
    if (grid < 0) return;
    if (hipMemsetAsync(d_ws, 0, WS_ZERO_BYTES, stream) != hipSuccess) { fprintf(stderr, "kernel_launch: memset failed\n"); return; }
    Args a{};
    a.x = (const float*)d_in[0]; a.npw = (const float*)d_in[1]; a.w_in = (const float*)d_in[2]; a.conv_w = (const float*)d_in[3]; a.conv_b = (const float*)d_in[4];
    a.dt_bias = (const float*)d_in[5]; a.a_log = (const float*)d_in[6]; a.d_skip = (const float*)d_in[7]; a.ssm_nw = (const float*)d_in[8]; a.w_out = (const float*)d_in[9]; a.npost_w = (const float*)d_in[10];
    a.out = (float*)d_out; a.ws = (unsigned char*)d_ws;
#if ONE_LAUNCH
    a.ph_lo = 0; a.ph_hi = NPHASE;
    void* args[] = {&a};
    hipError_t e = hipLaunchCooperativeKernel((grid == 256) ? (const void*)hybrid_fwd<true> : (const void*)hybrid_fwd<false>, dim3(grid), dim3(NT), args, LDS_BYTES, stream);
    if (e != hipSuccess) fprintf(stderr, "cooperative launch failed: %s (grid %d)\n", hipGetErrorString(e), grid);
#else
    for (int p = 0; p < NPHASE; ++p) { a.ph_lo = p; a.ph_hi = p + 1; hipLaunchKernelGGL(hybrid_fwd<true>, dim3(grid), dim3(NT), LDS_BYTES, stream, a); }
#endif
}
```

```cpp
#include <hip/hip_runtime.h>
#include <hip/hip_cooperative_groups.h>
#include <cstdio>
#include <cstdint>
namespace cg = cooperative_groups;
namespace pg8 {
#define PG8_LAS __attribute__((address_space(3)))
typedef unsigned short bf16_t;
typedef short bf16x8 __attribute__((ext_vector_type(8)));
typedef float f32x4 __attribute__((ext_vector_type(4)));
typedef unsigned u32x4 __attribute__((ext_vector_type(4)));
constexpr int BM = 256, BK = 64, HALF = 128, HTB = HALF * BK * 2  , STAGE_BYTES = 8 * HTB, NXCD = 8, WGM = 4;

__host__ __device__ __forceinline__ int lds_byte(int r, int c) { const int st = (r >> 4) * 2 + (c >> 5), rr = r & 15, cc = c & 31, ob = rr * 64 + cc * 2; return st * 1024 + (ob ^ (((ob >> 9) & 1) << 5)); }
__host__ __device__ __forceinline__ void stage_rc(int b, int& R, int& C) { const int st = b / 1024, sb = b % 1024, swz = sb ^ (((sb >> 9) & 1) << 5); R = (st >> 1) * 16 + swz / 64; C = (st & 1) * 32 + (swz % 64) / 2; }
__host__ __device__ __forceinline__ int perm32(int rho) { const int n = rho >> 4, i = rho & 15; return 8 * (i >> 2) + 4 * n + (i & 3); }

struct Unit { int pm, pn; };
struct Gemm { const bf16_t* A; const bf16_t* Bt; int M, N, K; };

struct StaticOrder {
    int nM, nN, nwg, G, c;
    __host__ __device__ void init(int M, int N, int G_, int c_) { nM = M / BM; nN = N / BM; nwg = nM * nN; G = G_; c = c_; }
    __host__ __device__ bool next(int i, Unit& u) const {
        const long L = (long)i * G + c; if (L >= nwg) return false;
        int wgid = (int)L; { const int q = nwg / NXCD, r = nwg % NXCD, xcd = wgid % NXCD, off = wgid / NXCD; wgid = (xcd < r ? xcd * (q + 1) : r * (q + 1) + (xcd - r) * q) + off; }
        const int nig = WGM * nN, gid = wgid / nig, fm = gid * WGM, gsz = (nM - fm) < WGM ? (nM - fm) : WGM;
        u.pm = fm + ((wgid % nig) % gsz); u.pn = (wgid % nig) / gsz; return true;
    }
    __device__ __forceinline__ void a_ready(const Unit&) const {}
    __device__ __forceinline__ void done(const Unit&) const {}
};

__device__ __forceinline__ unsigned cvt_pk_bf16(float lo, float hi) { unsigned r; asm volatile("v_cvt_pk_bf16_f32 %0, %1, %2" : "=v"(r) : "v"(lo), "v"(hi)); return r; }
template <class Epi, class Sched, bool ALIGN_EPI = false, bool SP2 = false>
__device__ __forceinline__ void gemm_phase(PG8_LAS unsigned char* lds, const Gemm g, const Sched& S, const Epi& E) {
    const int tid = threadIdx.x, wid = __builtin_amdgcn_readfirstlane(tid >> 6), lane = tid & 63, wr = wid >> 2, wc = wid & 3, fr = lane & 15, fq = lane >> 4;
    const int K = g.K, nt = K / BK;
    unsigned voffA[2], voffB[2];
#pragma unroll
    for (int i = 0; i < 2; ++i) { int R, C; stage_rc(tid * 16 + i * 8192, R, C); const int Rb = Epi::PERM ? ((R & ~31) + perm32(R & 31)) : R;
        voffA[i] = (unsigned)(R * K + C) * 2u; voffB[i] = (unsigned)(Rb * K + C) * 2u; }
    const size_t kstep = (size_t)(BK * 2);
    const size_t hstep = (size_t)HALF * K * 2;
    const size_t tstep = 2 * hstep;
    const unsigned ldsw = (unsigned)wid * 1024u;
    const int aoff = lds_byte(wr * 64 + fr, fq * 8), boff = lds_byte(wc * 32 + fr, fq * 8);
#define PG8_SA(b, h) (((b) * 2 + (h)) * HTB)
#define PG8_SB(b, h) ((4 + (b) * 2 + (h)) * HTB)
#define PG8_STAGE(bufoff, gbase, voff) do { _Pragma("unroll") for (int _i = 0; _i < 2; ++_i) \
        __builtin_amdgcn_global_load_lds((const unsigned*)((const char*)(gbase) + (voff)[_i]), (PG8_LAS unsigned*)(lds + (bufoff) + ldsw + _i * 8192), 16, 0, 0); } while (0)
#define PG8_LDA(dst, b, h) do { _Pragma("unroll") for (int m = 0; m < 4; ++m) _Pragma("unroll") for (int k = 0; k < 2; ++k) dst[m][k] = *(const PG8_LAS bf16x8*)(lds + PG8_SA(b, h) + aoff + m * 2048 + k * 1024); } while (0)
#define PG8_LDB(dst, b, h) do { _Pragma("unroll") for (int n = 0; n < 2; ++n) _Pragma("unroll") for (int k = 0; k < 2; ++k) dst[n][k] = *(const PG8_LAS bf16x8*)(lds + PG8_SB(b, h) + boff + n * 2048 + k * 1024); } while (0)
#define PG8_MMA(ai, bj, At, Bt) do { __builtin_amdgcn_s_setprio(1); _Pragma("unroll") for (int m = 0; m < 4; ++m) _Pragma("unroll") for (int n = 0; n < 2; ++n) _Pragma("unroll") for (int k = 0; k < 2; ++k) \
        acc[ai][bj][m][n] = __builtin_amdgcn_mfma_f32_16x16x32_bf16(Bt[n][k], At[m][k], acc[ai][bj][m][n], 0, 0, 0); __builtin_amdgcn_s_setprio(0); } while (0)
#define PG8_WAIT_V(n) asm volatile("s_waitcnt vmcnt(" #n ")" ::: "memory")
#define PG8_WAIT_L(n) asm volatile("s_waitcnt lgkmcnt(" #n ")" ::: "memory")
#define PG8_BAR __builtin_amdgcn_s_barrier()
#define PG8_SCHED __builtin_amdgcn_sched_barrier(0)
    Unit cur, nxt; int ui = 0;
    if (!S.next(0, cur)) return;
    f32x4 acc[2][2][4][2];
#pragma unroll
    for (int a = 0; a < 2; ++a)
#pragma unroll
        for (int b = 0; b < 2; ++b)
#pragma unroll
            for (int m = 0; m < 4; ++m)
#pragma unroll
                for (int n = 0; n < 2; ++n) acc[a][b][m][n] = (f32x4){0.f, 0.f, 0.f, 0.f};
    bf16x8 At[4][2], B0[2][2], B1[2][2];
    const char* cA = (const char*)g.A + (size_t)cur.pm * tstep; const char* cB = (const char*)g.Bt + (size_t)cur.pn * tstep;
    S.a_ready(cur);
    if constexpr (SP2) {
        PG8_STAGE(PG8_SB(0, 0), cB, voffB); PG8_STAGE(PG8_SB(0, 1), cB + hstep, voffB); PG8_STAGE(PG8_SA(0, 0), cA, voffA); PG8_STAGE(PG8_SA(0, 1), cA + hstep, voffA);
        if (wr == 1) PG8_BAR;
        PG8_WAIT_V(2); PG8_BAR;
        PG8_STAGE(PG8_SB(1, 0), cB + kstep, voffB); PG8_STAGE(PG8_SA(1, 0), cA + kstep, voffA); PG8_STAGE(PG8_SB(1, 1), cB + hstep + kstep, voffB);
        PG8_WAIT_V(6); PG8_BAR;
    } else {
        PG8_STAGE(PG8_SB(0, 0), cB, voffB); PG8_STAGE(PG8_SA(0, 0), cA, voffA); PG8_STAGE(PG8_SB(0, 1), cB + hstep, voffB); PG8_STAGE(PG8_SA(0, 1), cA + hstep, voffA);
        if (wr == 1) PG8_BAR;
        PG8_WAIT_V(4); PG8_BAR;
        PG8_STAGE(PG8_SB(1, 0), cB + kstep, voffB); PG8_STAGE(PG8_SA(1, 0), cA + kstep, voffA); PG8_STAGE(PG8_SB(1, 1), cB + hstep + kstep, voffB);
        PG8_WAIT_V(6); PG8_BAR;
    }
    for (;;) {
        const bool has_next = S.next(ui + 1, nxt);
        const char* nA = has_next ? (const char*)g.A + (size_t)nxt.pm * tstep : cA; const char* nB = has_next ? (const char*)g.Bt + (size_t)nxt.pn * tstep : cB;
        for (int t = 0; t < nt; t += 2) {
            const bool last = (t == nt - 2);
            const char* a1 = cA + (size_t)(t + 1) * kstep;
            const char* a2 = last ? nA : cA + (size_t)(t + 2) * kstep; const char* b2 = last ? nB : cB + (size_t)(t + 2) * kstep;
            const char* a3 = a2 + kstep; const char* b3 = b2 + kstep;
            if (last && has_next) S.a_ready(nxt);
            if constexpr (SP2) {
            PG8_LDB(B0, 0, 0); PG8_LDB(B1, 0, 1); PG8_SCHED; PG8_LDA(At, 0, 0); PG8_STAGE(PG8_SA(1, 1), a1 + hstep, voffA);
            PG8_WAIT_V(8); PG8_WAIT_L(0); PG8_BAR; PG8_MMA(0, 0, At, B0); PG8_MMA(0, 1, At, B1); PG8_BAR; PG8_SCHED;
            PG8_LDA(At, 0, 1); PG8_STAGE(PG8_SB(0, 0), b2, voffB); PG8_STAGE(PG8_SB(0, 1), b2 + hstep, voffB); PG8_STAGE(PG8_SA(0, 0), a2, voffA);
            PG8_WAIT_V(8); PG8_WAIT_L(0); PG8_BAR; PG8_MMA(1, 0, At, B0); PG8_MMA(1, 1, At, B1); PG8_BAR; PG8_SCHED;
            PG8_LDB(B0, 1, 0); PG8_LDB(B1, 1, 1); PG8_SCHED; PG8_LDA(At, 1, 0); PG8_STAGE(PG8_SA(0, 1), a2 + hstep, voffA);
            PG8_WAIT_V(8); PG8_WAIT_L(0); PG8_BAR; PG8_MMA(0, 0, At, B0); PG8_MMA(0, 1, At, B1); PG8_BAR; PG8_SCHED;
            PG8_LDA(At, 1, 1); PG8_STAGE(PG8_SB(1, 0), b3, voffB); PG8_STAGE(PG8_SB(1, 1), b3 + hstep, voffB); PG8_STAGE(PG8_SA(1, 0), a3, voffA);
            PG8_WAIT_V(8); PG8_WAIT_L(0); PG8_BAR; PG8_MMA(1, 0, At, B0); PG8_MMA(1, 1, At, B1); PG8_BAR; PG8_SCHED;
            } else {
            PG8_LDB(B0, 0, 0); PG8_SCHED; PG8_LDA(At, 0, 0); PG8_STAGE(PG8_SA(1, 1), a1 + hstep, voffA);
            PG8_WAIT_L(8); PG8_BAR; PG8_WAIT_L(0); PG8_MMA(0, 0, At, B0); PG8_BAR; PG8_SCHED;
            PG8_LDB(B1, 0, 1); PG8_STAGE(PG8_SB(0, 0), b2, voffB);
            PG8_BAR; PG8_WAIT_L(0); PG8_MMA(0, 1, At, B1); PG8_BAR;
            PG8_LDA(At, 0, 1); PG8_STAGE(PG8_SA(0, 0), a2, voffA);
            PG8_BAR; PG8_WAIT_L(0); PG8_MMA(1, 0, At, B0); PG8_BAR; PG8_SCHED;
            PG8_STAGE(PG8_SB(0, 1), b2 + hstep, voffB);
            PG8_WAIT_V(6); PG8_BAR; PG8_MMA(1, 1, At, B1); PG8_BAR;
            PG8_LDB(B0, 1, 0); PG8_SCHED; PG8_LDA(At, 1, 0); PG8_STAGE(PG8_SA(0, 1), a2 + hstep, voffA);
            PG8_WAIT_L(8); PG8_BAR; PG8_WAIT_L(0); PG8_MMA(0, 0, At, B0); PG8_BAR; PG8_SCHED;
            PG8_LDB(B1, 1, 1); PG8_STAGE(PG8_SB(1, 0), b3, voffB);
            PG8_BAR; PG8_WAIT_L(0); PG8_MMA(0, 1, At, B1); PG8_BAR;
            PG8_LDA(At, 1, 1); PG8_STAGE(PG8_SA(1, 0), a3, voffA);
            PG8_BAR; PG8_WAIT_L(0); PG8_MMA(1, 0, At, B0); PG8_BAR; PG8_SCHED;
            PG8_STAGE(PG8_SB(1, 1), b3 + hstep, voffB);
            PG8_WAIT_V(6); PG8_BAR; PG8_MMA(1, 1, At, B1); PG8_BAR;
            }
        }
        if constexpr (ALIGN_EPI) { if (wr == 0) PG8_BAR; }
        if constexpr (!Epi::AFTER_DRAIN) { E(acc, cur, wr, wc, fr, fq); S.done(cur); }
        if (!has_next) break;
#pragma unroll
        for (int a = 0; a < 2; ++a)
#pragma unroll
            for (int b = 0; b < 2; ++b)
#pragma unroll
                for (int m = 0; m < 4; ++m)
#pragma unroll
                    for (int n = 0; n < 2; ++n) acc[a][b][m][n] = (f32x4){0.f, 0.f, 0.f, 0.f};
        cur = nxt; cA = nA; cB = nB; ++ui;
        if constexpr (ALIGN_EPI) { if (wr == 1) PG8_BAR; }
    }
    PG8_WAIT_V(0);
    if constexpr (!ALIGN_EPI) { if (wr == 0) PG8_BAR; }
    PG8_BAR;
    if constexpr (Epi::AFTER_DRAIN) { E.fused(acc, cur, wr, wc, fr, fq, lds, wid, lane); S.done(cur); }
#undef PG8_SA
#undef PG8_SB
#undef PG8_STAGE
#undef PG8_LDA
#undef PG8_LDB
#undef PG8_MMA
#undef PG8_WAIT_V
#undef PG8_WAIT_L
#undef PG8_BAR
#undef PG8_SCHED
}
}
#define GAS __attribute__((address_space(1)))
#define LAS __attribute__((address_space(3)))
typedef unsigned short bf16;
typedef float f32x4 __attribute__((ext_vector_type(4)));
typedef short bf16x8 __attribute__((ext_vector_type(8)));
typedef short s16x4 __attribute__((ext_vector_type(4)));
typedef unsigned u32x4 __attribute__((ext_vector_type(4)));
typedef unsigned u32x2 __attribute__((ext_vector_type(2)));
constexpr int NB = 8, SEQ = 4096, DM = 1024, M = NB * SEQ;
constexpr int NH = 16, HD = 64, DSSM = 1024, DCONV = 1536, NST = 128, CHK = 128, NCHK = SEQ / CHK, NPROJ = 6672, NPADN = 6912, DINNER = 2048;
constexpr float EPS = 1e-6f;
constexpr float LOG2E = 1.4426950408889634f;
constexpr float QSCALE = 0.125f * LOG2E;
constexpr int NT = 512, NWV = 8;
constexpr size_t MiB = 1u << 20;
constexpr size_t WS_PCNT = 16384;
constexpr size_t WS_XCNT = 32768;
constexpr size_t WS_ROWSS = 65536;
constexpr size_t WS_ZERO_BYTES = 65536 + 131072;
constexpr size_t WS_RSTD = MiB / 2;
constexpr size_t WS_WINT = 1 * MiB;
constexpr size_t WS_WOUTT = 15 * MiB;
constexpr size_t WS_DTRAW = 19 * MiB;
constexpr size_t WS_ACS = 21 * MiB;
constexpr size_t WS_DTS = 23 * MiB;
constexpr size_t WS_LSE = 25 * MiB;
constexpr size_t WS_XB = 32 * MiB;
constexpr size_t WS_ST = 32 * MiB;
constexpr size_t WS_V = 96 * MiB, WS_G = 160 * MiB;
constexpr size_t WS_OUTPRE = 96 * MiB;
constexpr size_t WS_Z = 224 * MiB;
constexpr size_t WS_XBC = 288 * MiB;
constexpr size_t WS_MIX = 384 * MiB;
constexpr size_t WS_END = 512 * MiB;
constexpr int LDS_BYTES = 147456;

struct Args { const float *x, *npw, *w_in, *conv_w, *conv_b, *dt_bias, *a_log, *d_skip, *ssm_nw, *w_out, *npost_w; float* out; unsigned char* ws; int ph_lo, ph_hi; };

__device__ __forceinline__ float bf2f(unsigned u) { return __builtin_bit_cast(float, u << 16); }
__device__ __forceinline__ unsigned f2bf(float f) { unsigned u = __builtin_bit_cast(unsigned, f); return (u + 0x7fffu + ((u >> 16) & 1u)) >> 16; }
typedef float f32x2_t __attribute__((ext_vector_type(2))); typedef __bf16 bf16x2_t __attribute__((ext_vector_type(2)));
__device__ __forceinline__ unsigned pk2(float lo, float hi) { f32x2_t v = {lo, hi}; bf16x2_t b = __builtin_convertvector(v, bf16x2_t); return __builtin_bit_cast(unsigned, b); }
__device__ __forceinline__ float wave_sum(float v) {
#pragma unroll
    for (int o = 1; o < 64; o <<= 1) v += __shfl_xor(v, o);
    return v;
}
__device__ __forceinline__ float silu_f(float v) { return v * __builtin_amdgcn_rcpf(1.f + __builtin_amdgcn_exp2f(-LOG2E * v)); }
__device__ __forceinline__ float softplus_f(float v) { return v > 20.f ? v : log1pf(__expf(v)); }
#define LDS_WAIT() asm volatile("s_waitcnt lgkmcnt(0)" ::: "memory")

namespace pg8 {
struct EpiProj {
    static constexpr bool PERM = true, AFTER_DRAIN = false;
    bf16 *d0, *d1, *d2, *d3, *d4; bf16* xbc; float* dtraw; const float* rstd;
    __device__ __forceinline__ void operator()(const f32x4 (&acc)[2][2][4][2], const Unit& u, int wr, int wc, int fr, int fq) const {
        const int row0 = u.pm * BM + wr * 64 + fr; const int pn = u.pn;
        if (pn == 26) {
            if (wc == 0 && fq < 2) {
#pragma unroll
                for (int ai = 0; ai < 2; ++ai)
#pragma unroll
                    for (int m = 0; m < 4; ++m) { const int row = row0 + ai * HALF + m * 16; const float rs = rstd[row];
                        float* p = dtraw + (size_t)row * 16 + 8 * fq; *(f32x4*)p = acc[ai][0][m][0] * rs; *(f32x4*)(p + 4) = acc[ai][0][m][1] * rs; }
            }
            return;
        }
        bf16* base; int ldc, colt; float sc = 1.f;
        if (pn < 20) { const int sel = pn >> 2; base = sel == 0 ? d0 : sel == 1 ? d1 : sel == 2 ? d2 : sel == 3 ? d3 : d4; ldc = 1024; colt = (pn & 3) * BM; if (pn < 4) sc = QSCALE; }
        else { base = xbc; ldc = DCONV; colt = (pn - 20) * BM; }
        const int col0 = colt + wc * 32 + 8 * fq; const bool hm = pn < 12;
#pragma unroll
        for (int ai = 0; ai < 2; ++ai)
#pragma unroll
            for (int m = 0; m < 4; ++m) { const int row = row0 + ai * HALF + m * 16; const float rs = rstd[row] * sc;
#pragma unroll
                for (int bj = 0; bj < 2; ++bj) { const f32x4 v0 = acc[ai][bj][m][0] * rs, v1 = acc[ai][bj][m][1] * rs; const int col = col0 + bj * HALF;
                    bf16* p = hm ? base + ((size_t)((row >> 12) * NH + (col >> 6)) * SEQ + (row & (SEQ - 1))) * HD + (col & 63) : base + (size_t)row * ldc + col;
                    u32x4 w; w.x = cvt_pk_bf16(v0[0], v0[1]); w.y = cvt_pk_bf16(v0[2], v0[3]); w.z = cvt_pk_bf16(v1[0], v1[1]); w.w = cvt_pk_bf16(v1[2], v1[3]);
                    __builtin_nontemporal_store(w, (u32x4*)p); } }
    }
};
struct EpiF32 {
    static constexpr bool PERM = true, AFTER_DRAIN = false;
    float* O; int ldc;
    __device__ __forceinline__ void operator()(const f32x4 (&acc)[2][2][4][2], const Unit& u, int wr, int wc, int fr, int fq) const {
        const int row0 = u.pm * BM + wr * 64 + fr, col0 = u.pn * BM + wc * 32 + 8 * fq;
#pragma unroll
        for (int ai = 0; ai < 2; ++ai)
#pragma unroll
            for (int m = 0; m < 4; ++m) { float* rowp = O + (size_t)(row0 + ai * HALF + m * 16) * ldc + col0;
#pragma unroll
                for (int bj = 0; bj < 2; ++bj) { *(f32x4*)(rowp + bj * HALF) = acc[ai][bj][m][0]; *(f32x4*)(rowp + bj * HALF + 4) = acc[ai][bj][m][1]; } }
    }
};
struct EpiRmsRes {
    static constexpr bool PERM = true, AFTER_DRAIN = false;
    float* O; const float* X; const float* W; float* rowss; unsigned* pcnt;
    __device__ __forceinline__ void operator()(const f32x4 (&acc)[2][2][4][2], const Unit& u, int wr, int wc, int fr, int fq) const {
        const int row0 = u.pm * BM + wr * 64 + fr, col0 = u.pn * BM + wc * 32 + 8 * fq;
#pragma unroll
        for (int ai = 0; ai < 2; ++ai)
#pragma unroll
            for (int m = 0; m < 4; ++m) { float s = 0.f;
#pragma unroll
                for (int bj = 0; bj < 2; ++bj)
#pragma unroll
                    for (int n = 0; n < 2; ++n) { const f32x4 v = acc[ai][bj][m][n]; s += (v[0] * v[0] + v[1] * v[1]) + (v[2] * v[2] + v[3] * v[3]); }
                s += __shfl_xor(s, 16); s += __shfl_xor(s, 32);
                if (fq == 0) (void)__hip_atomic_fetch_add(rowss + row0 + ai * HALF + m * 16, s, __ATOMIC_RELAXED, __HIP_MEMORY_SCOPE_AGENT); }
        unsigned* cnt = pcnt + u.pm * 16;
        asm volatile("s_waitcnt vmcnt(0)" ::: "memory");
        if (threadIdx.x % 64 == 0) {
            (void)__hip_atomic_fetch_add(cnt, 1u, __ATOMIC_RELAXED, __HIP_MEMORY_SCOPE_AGENT);
            unsigned spin = 0;
            while (__hip_atomic_load(cnt, __ATOMIC_RELAXED, __HIP_MEMORY_SCOPE_AGENT) < 32u && ++spin < (1u << 22)) __builtin_amdgcn_s_sleep(2);
        }
        asm volatile("" ::: "memory");
        f32x4 wv[2][2];
#pragma unroll
        for (int bj = 0; bj < 2; ++bj) { wv[bj][0] = *(const f32x4*)(W + col0 + bj * HALF); wv[bj][1] = *(const f32x4*)(W + col0 + bj * HALF + 4); }
#pragma unroll
        for (int ai = 0; ai < 2; ++ai)
#pragma unroll
            for (int m = 0; m < 4; ++m) { const int row = row0 + ai * HALF + m * 16;
                const float ss = __hip_atomic_load(rowss + row, __ATOMIC_RELAXED, __HIP_MEMORY_SCOPE_AGENT); const float rs = 1.f / sqrtf(ss * (1.f / 1024.f) + 1e-6f);
                const float* xp = X + (size_t)row * 1024 + col0; float* op = O + (size_t)row * 1024 + col0;
#pragma unroll
                for (int bj = 0; bj < 2; ++bj) { const f32x4 x0 = __builtin_nontemporal_load((const f32x4*)(xp + bj * HALF)), x1 = __builtin_nontemporal_load((const f32x4*)(xp + bj * HALF + 4));
                    *(f32x4*)(op + bj * HALF) = x0 + acc[ai][bj][m][0] * wv[bj][0] * rs; *(f32x4*)(op + bj * HALF + 4) = x1 + acc[ai][bj][m][1] * wv[bj][1] * rs; } }
    }
};
}
#define XB_TMO      128
#define XB_XCNT(j)  (256  + 64 * (j))
#define XB_XSUB(j)  (1280 + 64 * (j))
#define XB_XGEN(j)  (2304 + 64 * (j))
#define XB_TOP      3328
#define XB_TOPGEN   3392
#define XCD_BAR_WORDS 3456
#define XB_SPIN_CAP (1u << 18)

__device__ __forceinline__ unsigned xb_ld(unsigned* p)              { return __hip_atomic_load(p, __ATOMIC_RELAXED, __HIP_MEMORY_SCOPE_AGENT); }
__device__ __forceinline__ unsigned xb_add(unsigned* p, unsigned v) { return __hip_atomic_fetch_add(p, v, __ATOMIC_RELAXED, __HIP_MEMORY_SCOPE_AGENT); }
__device__ __forceinline__ unsigned xb_xcc_id() { return (unsigned)__builtin_amdgcn_s_getreg((3 << 11) | 20) & 0xFu; }
#define XB_SPIN(cond, bar) do { unsigned _sp = 0; while (cond) { __builtin_amdgcn_s_sleep(1); \
    if ((++_sp & 255u) == 0u) { if (xb_ld(&(bar)[XB_TMO])) break; if (_sp > XB_SPIN_CAP) { atomicAdd(&(bar)[XB_TMO], 1u); break; } } } } while (0)

struct XcdBarrier {
    unsigned* bar; unsigned x;
    volatile LAS unsigned* st;
};

__device__ __forceinline__ XcdBarrier xcd_barrier_post(unsigned* bar, volatile LAS unsigned* st) {
    XcdBarrier b; b.bar = bar; b.x = xb_xcc_id(); b.st = st;
    if (threadIdx.x == 0) (void)xb_add(&bar[XB_XCNT(b.x)], 1u);
    return b;
}
__device__ __forceinline__ void xcd_barrier_complete(unsigned* bar, unsigned x, unsigned& nloc, unsigned& nx) {
    const unsigned G = gridDim.x * gridDim.y * gridDim.z;
    unsigned sum, cnt, mine, sp = 0u;
    for (;;) {
        sum = 0u; cnt = 0u; mine = 0u;
#pragma unroll
        for (unsigned j = 0; j < 16; ++j) { const unsigned c = xb_ld(&bar[XB_XCNT(j)]); sum += c; cnt += (c > 0u) ? 1u : 0u; mine = (j == x) ? c : mine; }
        if (sum == G) break;
        __builtin_amdgcn_s_sleep(1);
        if ((++sp & 255u) == 0u) { if (xb_ld(&bar[XB_TMO])) break; if (sp > XB_SPIN_CAP) { atomicAdd(&bar[XB_TMO], 1u); break; } }
    }
    nloc = mine > 0u ? mine : 1u; nx = cnt > 0u ? cnt : 1u;
}

__device__ __forceinline__ void xcd_barrier(const XcdBarrier& b) {
    asm volatile("s_waitcnt vmcnt(0)" ::: "memory");
    __syncthreads();
    if (threadIdx.x == 0) {
        unsigned* bar = b.bar;
        __builtin_amdgcn_s_waitcnt(0);
        unsigned nloc = b.st[0], nx = b.st[1];
        if (nloc == 0u) { xcd_barrier_complete(bar, b.x, nloc, nx); b.st[0] = nloc; b.st[1] = nx; }
        const unsigned old = xb_add(&bar[XB_XSUB(b.x)], 1u);
        const unsigned gen = old / nloc;
        if (old + 1u == (gen + 1u) * nloc) {
            __builtin_amdgcn_fence(__ATOMIC_RELEASE, "agent");
            asm volatile("s_waitcnt vmcnt(0)" ::: "memory");
            const unsigned og = xb_add(&bar[XB_TOP], 1u);
            const unsigned tg = og / nx;
            if (og + 1u == (tg + 1u) * nx) xb_add(&bar[XB_TOPGEN], 1u);
            else XB_SPIN(xb_ld(&bar[XB_TOPGEN]) == tg, bar);
            __builtin_amdgcn_fence(__ATOMIC_ACQUIRE, "agent");
            xb_add(&bar[XB_XGEN(b.x)], 1u);
            asm volatile("s_waitcnt vmcnt(0)" ::: "memory");
        } else {
            XB_SPIN(xb_ld(&bar[XB_XGEN(b.x)]) == gen, bar);
            __builtin_amdgcn_fence(__ATOMIC_ACQUIRE, "agent");
            asm volatile("s_waitcnt vmcnt(0)" ::: "memory");
        }
    }
    __syncthreads();
}
__device__ __forceinline__ void transpose_item(const float* W, int K, int N, bf16* WT, const float* kscale, LAS float* scr, int item, int lane) {
    const int nblk = (N + 31) / 32, kb = item / nblk, nb = item % nblk, k0 = 64 * kb, n0 = 32 * nb;
    const int nn = n0 + (lane & 31);
#pragma unroll
    for (int i = 0; i < 32; ++i) { const int kk = 2 * i + (lane >> 5); float v = (nn < N) ? W[(size_t)(k0 + kk) * N + nn] : 0.f; if (kscale) v *= kscale[k0 + kk]; scr[kk * 33 + (lane & 31)] = v; }
    LDS_WAIT();
    const int c = lane & 7;
#pragma unroll
    for (int j = 0; j < 4; ++j) { const int n = (lane >> 3) + 8 * j; const LAS float* s = scr + (8 * c) * 33 + n;
        u32x4 o; o.x = pk2(s[0 * 33], s[1 * 33]); o.y = pk2(s[2 * 33], s[3 * 33]); o.z = pk2(s[4 * 33], s[5 * 33]); o.w = pk2(s[6 * 33], s[7 * 33]);
        if (n0 + n < N) *(u32x4*)(WT + (size_t)(n0 + n) * K + k0 + 8 * c) = o; }
    LDS_WAIT();
}
__device__ __forceinline__ void phase_prep(const Args& a, LAS unsigned char* lds, int gw, int NGW, int wave, int lane) {
    LAS float* scr = (LAS float*)(lds + wave * 16384);
    bf16* WINT = (bf16*)(a.ws + WS_WINT); bf16* WOUTT = (bf16*)(a.ws + WS_WOUTT); bf16* XB = (bf16*)(a.ws + WS_XB); float* RSTD = (float*)(a.ws + WS_RSTD);
    constexpr int I_IN = (DM / 64) * ((NPROJ + 31) / 32), I_OUT = (DINNER / 64) * (DM / 32);
    const int n_items = (gridDim.x == 256) ? I_IN : I_IN + I_OUT;
    for (int it = gw; it < n_items; it += NGW) {
        if (it < I_IN) transpose_item(a.w_in, DM, NPROJ, WINT, a.npw, scr, it, lane);
        else transpose_item(a.w_out, DINNER, DM, WOUTT, nullptr, scr, it - I_IN, lane);
    }
    for (int m0 = gw * 4; m0 < M; m0 += NGW * 4) {
        f32x4 v[4][4];
#pragma unroll
        for (int r = 0; r < 4; ++r) { const f32x4* xr = (const f32x4*)(a.x + (size_t)(m0 + r) * DM) + lane;
#pragma unroll
            for (int j = 0; j < 4; ++j) v[r][j] = __builtin_nontemporal_load(xr + 64 * j); }
#pragma unroll
        for (int r = 0; r < 4; ++r) { float s = 0.f;
#pragma unroll
            for (int j = 0; j < 4; ++j) s += (v[r][j].x * v[r][j].x + v[r][j].y * v[r][j].y) + (v[r][j].z * v[r][j].z + v[r][j].w * v[r][j].w);
            s = wave_sum(s);
            if (lane == 0) RSTD[m0 + r] = 1.f / sqrtf(s * (1.f / DM) + EPS);
            u32x2* o8 = (u32x2*)(XB + (size_t)(m0 + r) * DM) + lane;
#pragma unroll
            for (int j = 0; j < 4; ++j) { u32x2 o; o.x = pk2(v[r][j].x, v[r][j].y); o.y = pk2(v[r][j].z, v[r][j].w); o8[64 * j] = o; } }
    }
}

__device__ __forceinline__ void naive_attn(const Args& a, int gw, int NGW, int lane) {
    const bf16* Q = (const bf16*)a.out; const bf16* K = Q + (size_t)M * 1024; const bf16* V = (const bf16*)(a.ws + WS_V); const bf16* G = (const bf16*)(a.ws + WS_G);
    bf16* MIX = (bf16*)(a.ws + WS_MIX);
    for (int it = gw; it < M * NH; it += NGW) {
        const int row = it >> 4, h = it & 15, t = row & (SEQ - 1), b = row >> 12;
        const float q = bf2f(Q[(size_t)row * 1024 + h * 64 + lane]);
        float op[3], lsep[3];
#pragma unroll
        for (int p = 0; p < 3; ++p) {
            const int d = (p == 0) ? 1 : (p == 1 ? 4 : 16);
            float m = -INFINITY, l = 0.f, o = 0.f;
            for (int j = 0; j <= 128; ++j) {
                const int tk = t - j * d; if (tk < 0) break;
                const size_t kr = ((size_t)(b * SEQ + tk)) * 1024 + h * 64 + lane;
                const float s = wave_sum(q * bf2f(K[kr]));
                const float mn = fmaxf(m, s), sc = exp2f(m - mn), pe = exp2f(s - mn);
                l = l * sc + pe; o = o * sc + pe * bf2f(V[kr]); m = mn;
            }
            op[p] = o / l; lsep[p] = m + log2f(l);
        }
        const float mm = fmaxf(lsep[0], fmaxf(lsep[1], lsep[2]));
        const float w0 = exp2f(lsep[0] - mm), w1 = exp2f(lsep[1] - mm), w2 = exp2f(lsep[2] - mm);
        float r = (w0 * op[0] + w1 * op[1] + w2 * op[2]) / (w0 + w1 + w2);
        r *= silu_f(bf2f(G[(size_t)row * 1024 + h * 64 + lane]));
        MIX[(size_t)row * DINNER + h * 64 + lane] = (bf16)f2bf(r);
    }
}
__device__ __forceinline__ void naive_conv(const Args& a, int gt, int NGT) {
    const bf16* XBC = (const bf16*)(a.ws + WS_XBC); bf16* XC = (bf16*)a.out; const float* DTRAW = (const float*)(a.ws + WS_DTRAW); float* DTS = (float*)(a.ws + WS_DTS);
    for (size_t i = gt; i < (size_t)M * DCONV; i += NGT) {
        const int row = (int)(i / DCONV), ch = (int)(i % DCONV), t = row & (SEQ - 1);
        float acc = a.conv_b[ch];
#pragma unroll
        for (int k = 0; k < 4; ++k) { const int tt = t - 3 + k; if (tt >= 0) acc += a.conv_w[k * DCONV + ch] * bf2f(XBC[(size_t)(row - 3 + k) * DCONV + ch]); }
        XC[i] = (bf16)f2bf(silu_f(acc));
    }
    for (int i = gt; i < M * NH; i += NGT) DTS[i] = softplus_f(DTRAW[i] + a.dt_bias[i & 15]);
}
__device__ __forceinline__ void naive_ssd(const Args& a, int gw, int NGW, int lane) {
    const bf16* XC = (const bf16*)a.out; const float* DTS = (const float*)(a.ws + WS_DTS); float* Y = (float*)(a.ws + WS_OUTPRE);
    for (int it = gw; it < NB * NH * HD; it += NGW) {
        const int p = it & 63, h = (it >> 6) & 15, b = it >> 10, g = h >> 3;
        const float av = -__expf(a.a_log[h]), dsk = a.d_skip[h];
        float h0 = 0.f, h1 = 0.f;
        for (int t = 0; t < SEQ; ++t) {
            const size_t row = (size_t)b * SEQ + t; const bf16* xr = XC + row * DCONV;
            const float dt = DTS[row * 16 + h], dA = __expf(dt * av), x = bf2f(xr[h * 64 + p]);
            const float B0 = bf2f(xr[1024 + g * 128 + lane]), B1 = bf2f(xr[1024 + g * 128 + 64 + lane]);
            const float C0 = bf2f(xr[1280 + g * 128 + lane]), C1 = bf2f(xr[1280 + g * 128 + 64 + lane]);
            h0 = h0 * dA + dt * x * B0; h1 = h1 * dA + dt * x * B1;
            const float y = wave_sum(C0 * h0 + C1 * h1) + dsk * x;
            if (lane == 0) Y[row * 1024 + h * 64 + p] = y;
        }
    }
}
__device__ __forceinline__ void naive_gnorm(const Args& a, int gw, int NGW, int lane) {
    const float* Y = (const float*)(a.ws + WS_OUTPRE); const bf16* Z = (const bf16*)(a.ws + WS_Z); bf16* MIX = (bf16*)(a.ws + WS_MIX);
    for (int it = gw; it < M * 2; it += NGW) {
        const int row = it >> 1, g = it & 1; const int c0 = g * 512 + lane * 8;
        float v[8]; float ss = 0.f;
#pragma unroll
        for (int j = 0; j < 8; ++j) { const float y = Y[(size_t)row * 1024 + c0 + j], z = bf2f(Z[(size_t)row * 1024 + c0 + j]); v[j] = y * silu_f(z); ss += v[j] * v[j]; }
        ss = wave_sum(ss); const float r = 1.f / sqrtf(ss * (1.f / 512.f) + EPS);
#pragma unroll
        for (int j = 0; j < 8; ++j) MIX[(size_t)row * DINNER + 1024 + c0 + j] = (bf16)f2bf(v[j] * r * a.ssm_nw[c0 + j]);
    }
}
__device__ __forceinline__ void phase_final(const Args& a, int gw, int NGW, int lane) {
    const float* OP = (const float*)(a.ws + WS_OUTPRE);
    for (int m = gw; m < M; m += NGW) {
        const f32x4* pr = (const f32x4*)(OP + (size_t)m * DM) + lane; const f32x4* xr = (const f32x4*)(a.x + (size_t)m * DM) + lane; const f32x4* wr = (const f32x4*)a.npost_w + lane;
        f32x4 v[4]; float s = 0.f;
#pragma unroll
        for (int j = 0; j < 4; ++j) { v[j] = pr[64 * j]; s += (v[j].x * v[j].x + v[j].y * v[j].y) + (v[j].z * v[j].z + v[j].w * v[j].w); }
        s = wave_sum(s); const float r = 1.f / sqrtf(s * (1.f / DM) + EPS);
        f32x4* orow = (f32x4*)(a.out + (size_t)m * DM) + lane;
#pragma unroll
        for (int j = 0; j < 4; ++j) orow[64 * j] = xr[64 * j] + v[j] * r * wr[64 * j];
    }
}
constexpr int AP2 = 144;
constexpr int ATT_K = 0, ATT_V = 256 * AP2, ATT_END = 512 * AP2;
static_assert(ATT_END <= 131072, "attention LDS");
#define MFMA16(a, b, c) __builtin_amdgcn_mfma_f32_16x16x32_bf16((a), (b), (c), 0, 0, 0)
__device__ __forceinline__ s16x4 tr_read(const LAS unsigned char* p) { return __builtin_bit_cast(s16x4, __builtin_amdgcn_ds_read_tr16_b64_v4i16((LAS s16x4*)p)); }
__device__ __forceinline__ bf16x8 cat8(s16x4 lo, s16x4 hi) { return (bf16x8){lo[0], lo[1], lo[2], lo[3], hi[0], hi[1], hi[2], hi[3]}; }
__device__ __forceinline__ bf16x8 pack8(f32x4 lo, f32x4 hi) { u32x4 w; w.x = pk2(lo[0], lo[1]); w.y = pk2(lo[2], lo[3]); w.z = pk2(hi[0], hi[1]); w.w = pk2(hi[2], hi[3]); return __builtin_bit_cast(bf16x8, w); }
__device__ __forceinline__ f32x4 unpack4(u32x2 v) { return (f32x4){__builtin_bit_cast(float, v.x << 16), __builtin_bit_cast(float, v.x & 0xffff0000u), __builtin_bit_cast(float, v.y << 16), __builtin_bit_cast(float, v.y & 0xffff0000u)}; }
__device__ __forceinline__ u32x2 pack4(f32x4 v) { u32x2 o; o.x = pk2(v[0], v[1]); o.y = pk2(v[2], v[3]); return o; }

__device__ __forceinline__ void attn_step(int st, int half, int& d, int& r, int& qi0, bool& fresh) {
    if (st < 16) { d = 16; r = st; qi0 = half * 128; fresh = true; }
    else if (st < 32) { d = 4; r = (st - 16) >> 2; qi0 = half * 512 + ((st - 16) & 3) * 128; fresh = ((st - 16) & 3) == 0; }
    else { d = 1; r = 0; qi0 = half * 2048 + (st - 32) * 128; fresh = (st == 32); }
}
struct AttRegs { u32x4 kc[2], vc[2], kp[2], vp[2]; bf16x8 bq[2]; };
struct AttCtx { const bf16 *Q, *K, *V, *Gt; bf16* MIX; float* LSE; LAS unsigned char* lds; size_t rowb, hb; int half, h, li, quad, w, sc, sr0; };
__device__ __forceinline__ void att_fetch(AttRegs& R, const AttCtx& c, int s) {
    int d, r, q0; bool fr; attn_step(s, c.half, d, r, q0, fr);
#pragma unroll
    for (int i = 0; i < 2; ++i) { const size_t gr = c.hb + (size_t)(q0 + c.sr0 + 64 * i) * d + r; R.kc[i] = *(const u32x4*)(c.K + gr * 64 + c.sc * 8); R.vc[i] = *(const u32x4*)(c.V + gr * 64 + c.sc * 8); }
    if (fr) {
#pragma unroll
        for (int i = 0; i < 2; ++i) { R.kp[i] = (u32x4){0u, 0u, 0u, 0u}; R.vp[i] = (u32x4){0u, 0u, 0u, 0u};
            if (q0 >= 128) { const size_t gr = c.hb + (size_t)(q0 - 128 + c.sr0 + 64 * i) * d + r; R.kp[i] = *(const u32x4*)(c.K + gr * 64 + c.sc * 8); R.vp[i] = *(const u32x4*)(c.V + gr * 64 + c.sc * 8); } } }
    const size_t gq = c.hb + (size_t)(q0 + 16 * c.w + c.li) * d + r; R.bq[0] = *(const bf16x8*)(c.Q + gq * 64 + c.quad * 8); R.bq[1] = *(const bf16x8*)(c.Q + gq * 64 + 32 + c.quad * 8);
}
__device__ __forceinline__ void att_step(AttRegs& R, const AttCtx& c, int st) {
    LAS unsigned char* lds = c.lds; const int li = c.li, quad = c.quad, w = c.w, h = c.h, sc_ = c.sc, sr0 = c.sr0;
    int d, r, qi0; bool fresh; attn_step(st, c.half, d, r, qi0, fresh);
    const int cb = st & 1;
    if (st == 16 || st == 32) asm volatile("s_waitcnt vmcnt(0)" ::: "memory");
    __syncthreads();
#pragma unroll
    for (int i = 0; i < 2; ++i) { const int rr = sr0 + 64 * i;
        *(LAS u32x4*)(lds + ATT_K + (cb * 128 + rr) * AP2 + sc_ * 16) = R.kc[i]; *(LAS u32x4*)(lds + ATT_V + (cb * 128 + rr) * AP2 + sc_ * 16) = R.vc[i];
        if (fresh) { *(LAS u32x4*)(lds + ATT_K + ((cb ^ 1) * 128 + rr) * AP2 + sc_ * 16) = R.kp[i]; *(LAS u32x4*)(lds + ATT_V + ((cb ^ 1) * 128 + rr) * AP2 + sc_ * 16) = R.vp[i]; } }
    const bf16x8 bq0 = R.bq[0], bq1 = R.bq[1];
    __syncthreads();
    if (st + 2 < 48) att_fetch(R, c, st + 2);
    const size_t grow = c.rowb + (size_t)(qi0 + 16 * w + li) * d + r;
    bf16* mp = c.MIX + grow * DINNER + h * 64 + 4 * quad;
    u32x2 prv[4], gv[4]; float lse_p = 0.f;
    if (st >= 16) { lse_p = c.LSE[grow * 16 + h];
#pragma unroll
        for (int dt = 0; dt < 4; ++dt) prv[dt] = *(const u32x2*)(mp + 16 * dt); }
    if (st >= 32) {
#pragma unroll
        for (int dt = 0; dt < 4; ++dt) gv[dt] = *(const u32x2*)(c.Gt + grow * 1024 + h * 64 + 4 * quad + 16 * dt); }
    const bool zpre = (qi0 < 128);
    f32x4 sc[9];
#pragma unroll
    for (int kt = 0; kt < 9; ++kt) { const int T = w + kt; const int ph = (T >> 3) ? cb : (cb ^ 1);
        const LAS unsigned char* kq = lds + ATT_K + (ph * 128 + (T & 7) * 16 + li) * AP2 + quad * 16;
        const bf16x8 a0 = *(const LAS bf16x8*)kq, a1 = *(const LAS bf16x8*)(kq + 64);
        f32x4 z = {0.f, 0.f, 0.f, 0.f}; z = MFMA16(a0, bq0, z); z = MFMA16(a1, bq1, z); sc[kt] = z; }
#pragma unroll
    for (int j = 0; j < 4; ++j) { if (4 * quad + j < li) sc[0][j] = -INFINITY; if (4 * quad + j > li) sc[8][j] = -INFINITY; }
    if (zpre) {
#pragma unroll
        for (int kt = 0; kt < 8; ++kt) if (w + kt < 8) sc[kt] = (f32x4){-INFINITY, -INFINITY, -INFINITY, -INFINITY}; }
    float mx = -INFINITY;
#pragma unroll
    for (int kt = 0; kt < 9; ++kt) mx = fmaxf(fmaxf(mx, fmaxf(sc[kt][0], sc[kt][1])), fmaxf(sc[kt][2], sc[kt][3]));
    mx = fmaxf(mx, __shfl_xor(mx, 16)); mx = fmaxf(mx, __shfl_xor(mx, 32));
    float l = 0.f;
#pragma unroll
    for (int kt = 0; kt < 9; ++kt)
#pragma unroll
        for (int j = 0; j < 4; ++j) { const float p = __builtin_amdgcn_exp2f(sc[kt][j] - mx); sc[kt][j] = p; l += p; }
    l += __shfl_xor(l, 16); l += __shfl_xor(l, 32);
    bf16x8 bp[5];
#pragma unroll
    for (int kp_ = 0; kp_ < 4; ++kp_) bp[kp_] = pack8(sc[2 * kp_], sc[2 * kp_ + 1]);
    bp[4] = pack8(sc[8], (f32x4){0.f, 0.f, 0.f, 0.f});
    f32x4 o[4];
#pragma unroll
    for (int dt = 0; dt < 4; ++dt) o[dt] = (f32x4){0.f, 0.f, 0.f, 0.f};
#pragma unroll
    for (int kp_ = 0; kp_ < 5; ++kp_) { const int T0 = w + 2 * kp_, T1 = T0 + 1; const int p0 = (T0 >> 3) ? cb : (cb ^ 1), p1 = (T1 >> 3) ? cb : (cb ^ 1);
        const LAS unsigned char* v0 = lds + ATT_V + (p0 * 128 + (T0 & 7) * 16 + 4 * quad + (li >> 2)) * AP2 + (li & 3) * 8;
        const LAS unsigned char* v1 = lds + ATT_V + (p1 * 128 + (T1 & 7) * 16 + 4 * quad + (li >> 2)) * AP2 + (li & 3) * 8;
#pragma unroll
        for (int dt = 0; dt < 4; ++dt) { const s16x4 lo = tr_read(v0 + dt * 32); const s16x4 hi = (kp_ < 4) ? tr_read(v1 + dt * 32) : (s16x4){0, 0, 0, 0};
            o[dt] = MFMA16(cat8(lo, hi), bp[kp_], o[dt]); } }
    const float lse_t = mx + __builtin_amdgcn_logf(l), inv_l = __builtin_amdgcn_rcpf(l);
    if (st < 16) {
#pragma unroll
        for (int dt = 0; dt < 4; ++dt) *(u32x2*)(mp + 16 * dt) = pack4(o[dt] * inv_l);
        if (quad == 0) c.LSE[grow * 16 + h] = lse_t;
    } else {
        const float mm = fmaxf(lse_p, lse_t), wa = __builtin_amdgcn_exp2f(lse_p - mm), wb = __builtin_amdgcn_exp2f(lse_t - mm);
        const float inv = __builtin_amdgcn_rcpf(wa + wb), ca = wa * inv, cbw = wb * inv * inv_l;
#pragma unroll
        for (int dt = 0; dt < 4; ++dt) { f32x4 v = unpack4(prv[dt]) * ca + o[dt] * cbw;
            if (st >= 32) { const f32x4 g = unpack4(gv[dt]); v[0] *= silu_f(g[0]); v[1] *= silu_f(g[1]); v[2] *= silu_f(g[2]); v[3] *= silu_f(g[3]); }
            *(u32x2*)(mp + 16 * dt) = pack4(v); }
        if (st < 32 && quad == 0) c.LSE[grow * 16 + h] = mm + __builtin_amdgcn_logf(wa + wb);
    }
}
__device__ __forceinline__ void phase_attn(const Args& a, LAS unsigned char* lds, int tid, int wave, int lane, int vc) {
    AttCtx c; c.Q = (const bf16*)a.out; c.K = c.Q + (size_t)M * 1024; c.V = (const bf16*)(a.ws + WS_V); c.Gt = (const bf16*)(a.ws + WS_G);
    c.MIX = (bf16*)(a.ws + WS_MIX); c.LSE = (float*)(a.ws + WS_LSE); c.lds = lds;
    c.li = lane & 15; c.quad = lane >> 4; c.w = wave; c.sc = tid & 7; c.sr0 = tid >> 3;
    for (int unit = vc; unit < NB * NH * 2; unit += gridDim.x) {
        const int bh = (unit & 7) | ((unit >> 4) << 3);
        c.half = (unit >> 3) & 1; c.h = bh & 15; const int b = bh >> 4;
        c.rowb = (size_t)b * SEQ; c.hb = (size_t)(b * NH + c.h) * SEQ;
        AttRegs R0, R1;
        att_fetch(R0, c, 0); att_fetch(R1, c, 1);
        for (int st = 0; st < 48; st += 2) { att_step(R0, c, st); att_step(R1, c, st + 1); }
    }
    __syncthreads();
}
#define LDS_BARRIER() do { asm volatile("s_waitcnt lgkmcnt(0)" ::: "memory"); __builtin_amdgcn_s_barrier(); asm volatile("" ::: "memory"); } while (0)
struct ConvRaw { u32x4 v[4]; };
__device__ __forceinline__ ConvRaw conv_load(const bf16* XBC, size_t row, int t, int ch0) {
    ConvRaw r;
#pragma unroll
    for (int k = 0; k < 4; ++k) r.v[k] = (t - 3 + k >= 0) ? *(const u32x4*)(XBC + (row - 3 + k) * DCONV + ch0) : (u32x4){0u, 0u, 0u, 0u};
    return r;
}
__device__ __forceinline__ void conv_apply(const ConvRaw& r, int ch0, const float* cw, const float* cb, f32x4& o0, f32x4& o1) {
    f32x4 a0 = *(const f32x4*)(cb + ch0), a1 = *(const f32x4*)(cb + ch0 + 4);
#pragma unroll
    for (int k = 0; k < 4; ++k) { const u32x4 v = r.v[k];
        const f32x4 w0 = *(const f32x4*)(cw + k * DCONV + ch0), w1 = *(const f32x4*)(cw + k * DCONV + ch0 + 4);
        a0 += w0 * unpack4((u32x2){v.x, v.y}); a1 += w1 * unpack4((u32x2){v.z, v.w}); }
    o0 = (f32x4){silu_f(a0[0]), silu_f(a0[1]), silu_f(a0[2]), silu_f(a0[3])}; o1 = (f32x4){silu_f(a1[0]), silu_f(a1[1]), silu_f(a1[2]), silu_f(a1[3])};
}
__device__ __forceinline__ void conv8(const bf16* XBC, size_t row, int t, int ch0, const float* cw, const float* cb, f32x4& o0, f32x4& o1) {
    const ConvRaw r = conv_load(XBC, row, t, ch0); conv_apply(r, ch0, cw, cb, o0, o1);
}
constexpr int BP2 = 272;
constexpr int SS_B = 0, SS_C = 128 * BP2, SS_XS = 2 * 128 * BP2, SS_XD = SS_XS + 128 * AP2, SS_XW = SS_XD + 128 * AP2, SS_ACS = SS_XW + 128 * AP2, SS_DT = SS_ACS + 4096, SS_END = SS_DT + 4096;
static_assert(SS_END <= LDS_BYTES, "ssd LDS");

__device__ __forceinline__ void phase_ssd_chunk(const Args& a, LAS unsigned char* lds, int tid, int wave, int lane, int vc) {
    const bf16* XBC = (const bf16*)(a.ws + WS_XBC); const float* DTRAW = (const float*)(a.ws + WS_DTRAW); float* ACS = (float*)(a.ws + WS_ACS);
    bf16* MIX = (bf16*)(a.ws + WS_MIX); bf16* ST = (bf16*)(a.ws + WS_ST);
    const int li = lane & 15, quad = lane >> 4, w = wave;
    LAS float* ACSs = (LAS float*)(lds + SS_ACS); LAS float* DTs = (LAS float*)(lds + SS_DT);
    for (int unit = vc; unit < NB * NCHK * 2; unit += gridDim.x) {
        const int g = unit & 1, c = (unit >> 1) & 31, b = unit >> 6;
        const size_t row0 = (size_t)b * SEQ + c * CHK; const int t0 = c * CHK;
        LDS_BARRIER();
        const float dtr0 = DTRAW[(row0 + 2 * lane) * 16 + 8 * g + w], dtr1 = DTRAW[(row0 + 2 * lane + 1) * 16 + 8 * g + w];
#pragma unroll 4
        for (int i = 0; i < 8; ++i) { const int item = i * NT + tid, cc = item & 31, l = item >> 5;
            const int ch0 = (cc < 16) ? (1024 + g * 128 + cc * 8) : (1280 + g * 128 + (cc - 16) * 8);
            f32x4 o0, o1; conv8(XBC, row0 + l, t0 + l, ch0, a.conv_w, a.conv_b, o0, o1);
            *(LAS bf16x8*)(lds + ((cc < 16) ? SS_B : SS_C) + l * BP2 + (cc & 15) * 16) = pack8(o0, o1); }
        {   const int hh = 8 * g + w; const float av = -__expf(a.a_log[hh]), db = a.dt_bias[hh];
            const float d0 = softplus_f(dtr0 + db), d1 = softplus_f(dtr1 + db);
            const float s = (d0 + d1) * av; float inc = s;
#pragma unroll
            for (int o = 1; o < 64; o <<= 1) { const float t = __shfl_up(inc, o); if (lane >= o) inc += t; }
            const float c0 = inc - s + d0 * av, c1 = inc;
            ACSs[w * 128 + 2 * lane] = c0; ACSs[w * 128 + 2 * lane + 1] = c1; DTs[w * 128 + 2 * lane] = d0; DTs[w * 128 + 2 * lane + 1] = d1;
            ACS[(row0 + 2 * lane) * 16 + hh] = c0; ACS[(row0 + 2 * lane + 1) * 16 + hh] = c1; }
        LDS_BARRIER();
        const int npair = (w >> 1) + 1;
        f32x4 cbt[8];
        {   bf16x8 bc[4];
#pragma unroll
            for (int ks = 0; ks < 4; ++ks) bc[ks] = *(const LAS bf16x8*)(lds + SS_C + (16 * w + li) * BP2 + ks * 64 + quad * 16);
#pragma unroll
            for (int st = 0; st < 8; ++st) { f32x4 z = {0.f, 0.f, 0.f, 0.f};
                if (st < 2 * npair) {
#pragma unroll
                    for (int ks = 0; ks < 4; ++ks) z = MFMA16(*(const LAS bf16x8*)(lds + SS_B + (16 * st + li) * BP2 + ks * 64 + quad * 16), bc[ks], z); }
                cbt[st] = z; } }
        ConvRaw xr[2];
#pragma unroll
        for (int i = 0; i < 2; ++i) { const int item = i * NT + tid, cc = item & 7, l = item >> 3; xr[i] = conv_load(XBC, row0 + l, t0 + l, 8 * g * 64 + cc * 8); }
        for (int hh = 0; hh < 8; ++hh) {
            const int h = 8 * g + hh; const float dsk = a.d_skip[h];
            LDS_BARRIER();
            const float alast = ACSs[hh * 128 + 127];
#pragma unroll
            for (int i = 0; i < 2; ++i) { const int item = i * NT + tid, cc = item & 7, l = item >> 3;
                f32x4 o0, o1; conv_apply(xr[i], h * 64 + cc * 8, a.conv_w, a.conv_b, o0, o1);
                if (hh < 7) xr[i] = conv_load(XBC, row0 + l, t0 + l, (h + 1) * 64 + cc * 8);
                const float dt = DTs[hh * 128 + l], dw = dt * __expf(alast - ACSs[hh * 128 + l]);
                *(LAS bf16x8*)(lds + SS_XS + l * AP2 + cc * 16) = pack8(o0, o1);
                *(LAS bf16x8*)(lds + SS_XD + l * AP2 + cc * 16) = pack8(o0 * dt, o1 * dt);
                *(LAS bf16x8*)(lds + SS_XW + l * AP2 + cc * 16) = pack8(o0 * dw, o1 * dw); }
            LDS_BARRIER();
            const float al = ACSs[hh * 128 + 16 * w + li];
            f32x4 o[4];
#pragma unroll
            for (int pt = 0; pt < 4; ++pt) o[pt] = (f32x4){0.f, 0.f, 0.f, 0.f};
            const LAS unsigned char* xdb = lds + SS_XD + (4 * quad + (li >> 2)) * AP2 + (li & 3) * 8;
#pragma unroll
            for (int kp = 0; kp < 4; ++kp) {
                if (kp < npair) {
                    f32x4 lt[2];
#pragma unroll
                    for (int t = 0; t < 2; ++t) { const f32x4 as = *(const LAS f32x4*)(ACSs + hh * 128 + 16 * (2 * kp + t) + 4 * quad);
#pragma unroll
                        for (int e = 0; e < 4; ++e) { const int s = 16 * (2 * kp + t) + 4 * quad + e; lt[t][e] = (s <= 16 * w + li) ? cbt[2 * kp + t][e] * __expf(al - as[e]) : 0.f; } }
                    const bf16x8 bp = pack8(lt[0], lt[1]);
#pragma unroll
                    for (int pt = 0; pt < 4; ++pt) { const LAS unsigned char* p1 = xdb + (32 * kp) * AP2 + pt * 32;
                        o[pt] = MFMA16(cat8(tr_read(p1), tr_read(p1 + 16 * AP2)), bp, o[pt]); }
                }
            }
#pragma unroll
            for (int pt = 0; pt < 4; ++pt) { const f32x4 xs = unpack4(*(const LAS u32x2*)(lds + SS_XS + (16 * w + li) * AP2 + (16 * pt + 4 * quad) * 2));
                *(u32x2*)(MIX + (row0 + 16 * w + li) * DINNER + 1024 + h * 64 + 16 * pt + 4 * quad) = pack4(o[pt] + xs * dsk); }
            f32x4 sa[4];
#pragma unroll
            for (int pt = 0; pt < 4; ++pt) sa[pt] = (f32x4){0.f, 0.f, 0.f, 0.f};
            const LAS unsigned char* bb = lds + SS_B + (8 * quad + (li >> 2)) * BP2 + (16 * w + 4 * (li & 3)) * 2;
            const LAS unsigned char* xwb = lds + SS_XW + (8 * quad + (li >> 2)) * AP2 + (li & 3) * 8;
#pragma unroll
            for (int ks = 0; ks < 4; ++ks) { const bf16x8 aB = cat8(tr_read(bb + (32 * ks) * BP2), tr_read(bb + (32 * ks + 4) * BP2));
#pragma unroll
                for (int pt = 0; pt < 4; ++pt) { const LAS unsigned char* p1 = xwb + (32 * ks) * AP2 + pt * 32;
                    sa[pt] = MFMA16(aB, cat8(tr_read(p1), tr_read(p1 + 4 * AP2)), sa[pt]); } }
            bf16* stp = ST + ((((size_t)b * NCHK + c) * NH + h) * HD) * NST;
#pragma unroll
            for (int pt = 0; pt < 4; ++pt) *(u32x2*)(stp + (size_t)(16 * pt + li) * NST + 16 * w + 4 * quad) = pack4(sa[pt]);
        }
    }
    __syncthreads();
}
__device__ __forceinline__ void phase_scan(const Args& a, int gt, int NGT) {
    bf16* ST = (bf16*)(a.ws + WS_ST); const float* ACS = (const float*)(a.ws + WS_ACS);
    for (int idx = gt; idx < NB * NH * HD * 16; idx += NGT) {
        const int n8 = idx & 15, p = (idx >> 4) & 63, h = (idx >> 10) & 15, b = idx >> 14;
        f32x4 s0 = {0.f, 0.f, 0.f, 0.f}, s1 = {0.f, 0.f, 0.f, 0.f};
        for (int c0 = 0; c0 < NCHK; c0 += 8) {
            u32x4 v[8]; float dec[8];
#pragma unroll
            for (int j = 0; j < 8; ++j) { const int c = c0 + j; v[j] = *(const u32x4*)(ST + ((((size_t)b * NCHK + c) * NH + h) * HD + p) * NST + n8 * 8);
                dec[j] = __expf(ACS[((size_t)b * SEQ + c * CHK + 127) * 16 + h]); }
#pragma unroll
            for (int j = 0; j < 8; ++j) { const int c = c0 + j;
                u32x4 o; o.x = pk2(s0[0], s0[1]); o.y = pk2(s0[2], s0[3]); o.z = pk2(s1[0], s1[1]); o.w = pk2(s1[2], s1[3]);
                *(u32x4*)(ST + ((((size_t)b * NCHK + c) * NH + h) * HD + p) * NST + n8 * 8) = o;
                s0 = s0 * dec[j] + unpack4((u32x2){v[j].x, v[j].y});
                s1 = s1 * dec[j] + unpack4((u32x2){v[j].z, v[j].w}); }
        }
    }
}
constexpr int PVP = 272, PVH = 64 * PVP, SO_PV = 128 * BP2;
static_assert(SO_PV + 4 * PVH <= LDS_BYTES, "ssd_out LDS");
__device__ __forceinline__ void phase_ssd_out(const Args& a, LAS unsigned char* lds, int tid, int wave, int lane, int vc) {
    const bf16* XBC = (const bf16*)(a.ws + WS_XBC); const float* ACS = (const float*)(a.ws + WS_ACS); const bf16* Z = (const bf16*)(a.ws + WS_Z);
    bf16* MIX = (bf16*)(a.ws + WS_MIX); const bf16* ST = (const bf16*)(a.ws + WS_ST);
    const int li = lane & 15, quad = lane >> 4, w = wave;
    for (int unit = vc; unit < NB * NCHK * 2; unit += gridDim.x) {
        const int g = unit & 1, c = (unit >> 1) & 31, b = unit >> 6;
        const size_t row0 = (size_t)b * SEQ + c * CHK; const int t0 = c * CHK;
        const size_t row = row0 + 16 * w + li;
        u32x4 pr[4]; u32x2 ydn[2][4], zn[2][4]; float eln[2];
#define SO_PREFETCH(q) do { const int hb_ = 8 * g + 2 * (q); const u32x4* src_ = (const u32x4*)(ST + ((((size_t)b * NCHK + c) * NH + hb_) * HD) * NST); \
        _Pragma("unroll") for (int i = 0; i < 4; ++i) pr[i] = src_[i * NT + tid]; \
        _Pragma("unroll") for (int hh = 0; hh < 2; ++hh) { eln[hh] = ACS[row * 16 + hb_ + hh]; \
            _Pragma("unroll") for (int pt = 0; pt < 4; ++pt) { const int col_ = (hb_ + hh) * 64 + 16 * pt + 4 * quad; \
                ydn[hh][pt] = *(const u32x2*)(MIX + row * DINNER + 1024 + col_); zn[hh][pt] = *(const u32x2*)(Z + row * 1024 + col_); } } } while (0)
        LDS_BARRIER();
#pragma unroll
        for (int i = 0; i < 4; ++i) { const int item = i * NT + tid, cc = item & 15, l = item >> 4;
            f32x4 o0, o1; conv8(XBC, row0 + l, t0 + l, 1280 + g * 128 + cc * 8, a.conv_w, a.conv_b, o0, o1);
            *(LAS bf16x8*)(lds + 0 + l * BP2 + cc * 16) = pack8(o0, o1); }
        asm volatile("" ::: "memory");
        SO_PREFETCH(0);
        bf16x8 bc[4];
        u32x2 yzp[8][4]; float ss = 0.f;
#pragma unroll
        for (int q = 0; q < 4; ++q) {
#pragma unroll
            for (int i = 0; i < 4; ++i) { const int idx = i * NT + tid, rr = idx >> 4; *(LAS u32x4*)(lds + SO_PV + (q & 1) * 2 * PVH + (rr >> 6) * PVH + (rr & 63) * PVP + (idx & 15) * 16) = pr[i]; }
            u32x2 ydc[2][4], zc[2][4]; float elc[2];
#pragma unroll
            for (int hh = 0; hh < 2; ++hh) { elc[hh] = eln[hh];
#pragma unroll
                for (int pt = 0; pt < 4; ++pt) { ydc[hh][pt] = ydn[hh][pt]; zc[hh][pt] = zn[hh][pt]; } }
            LDS_BARRIER();
            if (q == 0) {
#pragma unroll
                for (int ks = 0; ks < 4; ++ks) bc[ks] = *(const LAS bf16x8*)(lds + 0 + (16 * w + li) * BP2 + ks * 64 + quad * 16); }
            if (q < 3) SO_PREFETCH(q + 1);
#pragma unroll
            for (int hh = 0; hh < 2; ++hh) { const float e = __expf(elc[hh]);
#pragma unroll
                for (int pt = 0; pt < 4; ++pt) { f32x4 acc = {0.f, 0.f, 0.f, 0.f}; if (pt & 1) asm volatile("" ::: "memory");
#pragma unroll
                    for (int ks = 0; ks < 4; ++ks) acc = MFMA16(*(const LAS bf16x8*)(lds + SO_PV + ((q & 1) * 2 + hh) * PVH + (16 * pt + li) * PVP + ks * 64 + quad * 16), bc[ks], acc);
                    const f32x4 z = unpack4(zc[hh][pt]);
                    f32x4 y = acc * e + unpack4(ydc[hh][pt]); y[0] *= silu_f(z[0]); y[1] *= silu_f(z[1]); y[2] *= silu_f(z[2]); y[3] *= silu_f(z[3]);
                    ss += (y[0] * y[0] + y[1] * y[1]) + (y[2] * y[2] + y[3] * y[3]); yzp[2 * q + hh][pt] = pack4(y); } }
        }
#undef SO_PREFETCH
        ss += __shfl_xor(ss, 16); ss += __shfl_xor(ss, 32);
        const float r = 1.f / sqrtf(ss * (1.f / 512.f) + EPS);
#pragma unroll
        for (int hh = 0; hh < 8; ++hh) { asm volatile("" ::: "memory");
#pragma unroll
            for (int pt = 0; pt < 4; ++pt) { const int col = (8 * g + hh) * 64 + 16 * pt + 4 * quad; const f32x4 wv = *(const f32x4*)(a.ssm_nw + col);
                *(u32x2*)(MIX + row * DINNER + 1024 + col) = pack4(unpack4(yzp[hh][pt]) * wv * r); } }
    }
    __syncthreads();
}
#ifndef ONE_LAUNCH
#define ONE_LAUNCH 1
#endif
constexpr int NPHASE = 8;
#ifndef REP_ATTN
#define REP_ATTN 1
#endif
#ifndef REP_P3
#define REP_P3 1
#endif
#ifndef REP_SSD
#define REP_SSD 1
#endif
template <bool FUSED> __global__ void __launch_bounds__(NT, 2) hybrid_fwd(Args a) {
    extern __shared__ __attribute__((aligned(16))) unsigned char lds_raw[];
    LAS unsigned char* lds = (LAS unsigned char*)lds_raw;
    const int tid = threadIdx.x, lane = tid & 63, wave = __builtin_amdgcn_readfirstlane(tid >> 6);
    const int G = gridDim.x, gw = blockIdx.x * NWV + wave, NGW = G * NWV, gt = blockIdx.x * NT + tid, NGT = G * NT;
    const int lo = a.ph_lo, hi = a.ph_hi;
    volatile LAS unsigned* bst = (volatile LAS unsigned*)(lds + LDS_BYTES - 64);
    if (tid < 16) bst[tid] = 0u;
    __syncthreads();
    const XcdBarrier bar = xcd_barrier_post((unsigned*)a.ws, bst);
    unsigned* XCNT = (unsigned*)(a.ws + WS_XCNT);
    const unsigned myx = xb_xcc_id();
    if (tid == 0) bst[4] = __hip_atomic_fetch_add(XCNT + myx * 16, 1u, __ATOMIC_RELAXED, __HIP_MEMORY_SCOPE_AGENT);
#define IN(k) (lo <= (k) && (k) < hi)
#ifdef PROBE_K
    unsigned long long* tsb = (unsigned long long*)(a.ws + 262144);
#define STAMP(i) do { if (blockIdx.x == 0 && tid == 0) tsb[i] = __builtin_amdgcn_s_memrealtime(); } while (0)
#else
#define STAMP(i) do { } while (0)
#endif
    STAMP(0);
#define SEAM(k) do { if (IN(k) && IN((k) + 1)) { xcd_barrier(bar); } } while (0)
    if (hi > NPHASE) cg::this_grid().sync();
    if (IN(0)) { phase_prep(a, lds, gw, NGW, wave, lane); __syncthreads(); } SEAM(0); STAMP(1);
    if (tid == 0) { unsigned base = 0, all32 = 1;
        for (unsigned j = 0; j < 16; ++j) { const unsigned cj = __hip_atomic_load(XCNT + j * 16, __ATOMIC_RELAXED, __HIP_MEMORY_SCOPE_AGENT); if (j < myx) base += cj; if (j < 8 ? cj != 32u : cj != 0u) all32 = 0; }
        const unsigned vcu = base + bst[4];
        bst[5] = (all32 && G == 256) ? (vcu & 31u) * 8u + (vcu >> 5) : vcu; }
    __syncthreads();
    const int vc = (int)bst[5];
    if (IN(1)) {
        pg8::Gemm g{(const bf16*)(a.ws + WS_XB), (const bf16*)(a.ws + WS_WINT), M, NPADN, DM}; pg8::StaticOrder S; S.init(M, NPADN, G, vc);
        pg8::EpiProj E; E.d0 = (bf16*)a.out; E.d1 = (bf16*)a.out + (size_t)M * 1024; E.d2 = (bf16*)(a.ws + WS_V); E.d3 = (bf16*)(a.ws + WS_G); E.d4 = (bf16*)(a.ws + WS_Z);
        E.xbc = (bf16*)(a.ws + WS_XBC); E.dtraw = (float*)(a.ws + WS_DTRAW); E.rstd = (const float*)(a.ws + WS_RSTD);
        pg8::gemm_phase<pg8::EpiProj, pg8::StaticOrder, true, true>(lds, g, S, E);
        if (G == 256 && vc >= 128) {
            constexpr int I_OUT = (DINNER / 64) * (DM / 32);
            LAS float* scr = (LAS float*)(lds + wave * 16384);
            for (int it = (vc - 128) * NWV + wave; it < I_OUT; it += 128 * NWV) transpose_item(a.w_out, DINNER, DM, (bf16*)(a.ws + WS_WOUTT), nullptr, scr, it, lane);
        }
    } SEAM(1); STAMP(2);
    if (IN(2)) { for (int rep = 0; rep < REP_ATTN; ++rep) phase_attn(a, lds, tid, wave, lane, vc); }   STAMP(3);
    for (int rep = 0; rep < REP_SSD; ++rep) {
        if (rep) xcd_barrier(bar);
        if (IN(3)) { for (int r3 = 0; r3 < REP_P3; ++r3) phase_ssd_chunk(a, lds, tid, wave, lane, vc); } SEAM(3); STAMP(4);
        if (IN(4)) phase_scan(a, gt, NGT); SEAM(4); STAMP(5);
        if (IN(5)) phase_ssd_out(a, lds, tid, wave, lane, vc);
    }
    SEAM(5); STAMP(6);
    if (IN(6)) {
        pg8::Gemm g{(const bf16*)(a.ws + WS_MIX), (const bf16*)(a.ws + WS_WOUTT), M, DM, DINNER}; pg8::StaticOrder S; S.init(M, DM, G, vc);
        if constexpr (FUSED) {
            pg8::EpiRmsRes E{a.out, a.x, a.npost_w, (float*)(a.ws + WS_ROWSS), (unsigned*)(a.ws + WS_PCNT)};
            pg8::gemm_phase<pg8::EpiRmsRes, pg8::StaticOrder, true, true>(lds, g, S, E);
        } else {
            pg8::EpiF32 E{(float*)(a.ws + WS_OUTPRE), DM};
            pg8::gemm_phase<pg8::EpiF32, pg8::StaticOrder, true, true>(lds, g, S, E);
            xcd_barrier(bar);
            phase_final(a, gw, NGW, lane);
        }
    }
#ifdef PROBE_K
    __syncthreads(); STAMP(7);
    if (blockIdx.x == 0 && tid == 0) { asm volatile("s_waitcnt vmcnt(0)" ::: "memory"); const float us_ = (float)(tsb[PROBE_K + 1] - tsb[PROBE_K]) * 0.01f; a.out[0] = 1000.f * floorf(us_ * (1.f / PROBE_BIN) + 0.5f); }
#endif
#undef IN
#undef SEAM
}

extern "C" void kernel_launch(void* const* d_in, const int* in_sizes, int n_in, void* d_out, int out_size, void* d_ws, size_t ws_size, hipStream_t stream) {
    static int grid = 0;
    if (grid == 0) {
        if (n_in != 11 || out_size != M * DM || ws_size < WS_END) { fprintf(stderr, "kernel_launch: unexpected shapes (n_in %d out %d ws %zu)\n", n_in, out_size, ws_size); grid = -1; return; }
        int dev = 0, cus = 0, per_cu = 0;
        (void)hipGetDevice(&dev); (void)hipDeviceGetAttribute(&cus, hipDeviceAttributeMultiprocessorCount, dev);
        const void* fn = (cus == 256) ? (const void*)hybrid_fwd<true> : (const void*)hybrid_fwd<false>;
        if (hipFuncSetAttribute(fn, hipFuncAttributeMaxDynamicSharedMemorySize, LDS_BYTES) != hipSuccess) { fprintf(stderr, "kernel_launch: hipFuncSetAttribute failed\n"); grid = -1; return; }
        if (hipOccupancyMaxActiveBlocksPerMultiprocessor(&per_cu, fn, NT, LDS_BYTES) != hipSuccess || per_cu < 1) { fprintf(stderr, "kernel_launch: occupancy query says %d\n", per_cu); per_cu = 1; }
        (void)hipGetLastError();
        grid = cus * 1;
        fprintf(stderr, "kernel_launch: cus %d per_cu %d grid %d\n", cus, per_cu, grid);
    }
    if (grid < 0) return;
    if (hipMemsetAsync(d_ws, 0, WS_ZERO_BYTES, stream) != hipSuccess) { fprintf(stderr, "kernel_launch: memset failed\n"); return; }
    Args a{};
    a.x = (const float*)d_in[0]; a.npw = (const float*)d_in[1]; a.w_in = (const float*)d_in[2]; a.conv_w = (const float*)d_in[3]; a.conv_b = (const float*)d_in[4];
    a.dt_bias = (const float*)d_in[5]; a.a_log = (const float*)d_in[6]; a.d_skip = (const float*)d_in[7]; a.ssm_nw = (const float*)d_in[8]; a.w_out = (const float*)d_in[9]; a.npost_w = (const float*)d_in[10];
    a.out = (float*)d_out; a.ws = (unsigned char*)d_ws;
#if ONE_LAUNCH
    a.ph_lo = 0; a.ph_hi = NPHASE;
    void* args[] = {&a};
    hipError_t e = hipLaunchCooperativeKernel((grid == 256) ? (const void*)hybrid_fwd<true> : (const void*)hybrid_fwd<false>, dim3(grid), dim3(NT), args, LDS_BYTES, stream);
    if (e != hipSuccess) fprintf(stderr, "cooperative launch failed: %s (grid %d)\n", hipGetErrorString(e), grid);
#else
    for (int p = 0; p < NPHASE; ++p) { a.ph_lo = p; a.ph_hi = p + 1; hipLaunchKernelGGL(hybrid_fwd<true>, dim3(grid), dim3(NT), LDS_BYTES, stream, a); }
#endif
}
```

```cpp
#include <hip/hip_runtime.h>
#include <hip/hip_cooperative_groups.h>
#include <cstdio>
#include <cstdint>
namespace cg = cooperative_groups;
namespace pg8 {
#define PG8_LAS __attribute__((address_space(3)))
typedef unsigned short bf16_t;
typedef short bf16x8 __attribute__((ext_vector_type(8)));
typedef float f32x4 __attribute__((ext_vector_type(4)));
typedef unsigned u32x4 __attribute__((ext_vector_type(4)));
constexpr int BM = 256, BK = 64, HALF = 128, HTB = HALF * BK * 2  , STAGE_BYTES = 8 * HTB, NXCD = 8, WGM = 4;

__host__ __device__ __forceinline__ int lds_byte(int r, int c) { const int st = (r >> 4) * 2 + (c >> 5), rr = r & 15, cc = c & 31, ob = rr * 64 + cc * 2; return st * 1024 + (ob ^ (((ob >> 9) & 1) << 5)); }
__host__ __device__ __forceinline__ void stage_rc(int b, int& R, int& C) { const int st = b / 1024, sb = b % 1024, swz = sb ^ (((sb >> 9) & 1) << 5); R = (st >> 1) * 16 + swz / 64; C = (st & 1) * 32 + (swz % 64) / 2; }
__host__ __device__ __forceinline__ int perm32(int rho) { const int n = rho >> 4, i = rho & 15; return 8 * (i >> 2) + 4 * n + (i & 3); }

struct Unit { int pm, pn; };
struct Gemm { const bf16_t* A; const bf16_t* Bt; int M, N, K; };

struct StaticOrder {
    int nM, nN, nwg, G, c;
    __host__ __device__ void init(int M, int N, int G_, int c_) { nM = M / BM; nN = N / BM; nwg = nM * nN; G = G_; c = c_; }
    __host__ __device__ bool next(int i, Unit& u) const {
        const long L = (long)i * G + c; if (L >= nwg) return false;
        int wgid = (int)L; { const int q = nwg / NXCD, r = nwg % NXCD, xcd = wgid % NXCD, off = wgid / NXCD; wgid = (xcd < r ? xcd * (q + 1) : r * (q + 1) + (xcd - r) * q) + off; }
        const int nig = WGM * nN, gid = wgid / nig, fm = gid * WGM, gsz = (nM - fm) < WGM ? (nM - fm) : WGM;
        u.pm = fm + ((wgid % nig) % gsz); u.pn = (wgid % nig) / gsz; return true;
    }
    __device__ __forceinline__ void a_ready(const Unit&) const {}
    __device__ __forceinline__ void done(const Unit&) const {}
};

__device__ __forceinline__ unsigned cvt_pk_bf16(float lo, float hi) { unsigned r; asm volatile("v_cvt_pk_bf16_f32 %0, %1, %2" : "=v"(r) : "v"(lo), "v"(hi)); return r; }
template <class Epi, class Sched, bool ALIGN_EPI = false, bool SP2 = false>
__device__ __forceinline__ void gemm_phase(PG8_LAS unsigned char* lds, const Gemm g, const Sched& S, const Epi& E) {
    const int tid = threadIdx.x, wid = __builtin_amdgcn_readfirstlane(tid >> 6), lane = tid & 63, wr = wid >> 2, wc = wid & 3, fr = lane & 15, fq = lane >> 4;
    const int K = g.K, nt = K / BK;
    unsigned voffA[2], voffB[2];
#pragma unroll
    for (int i = 0; i < 2; ++i) { int R, C; stage_rc(tid * 16 + i * 8192, R, C); const int Rb = Epi::PERM ? ((R & ~31) + perm32(R & 31)) : R;
        voffA[i] = (unsigned)(R * K + C) * 2u; voffB[i] = (unsigned)(Rb * K + C) * 2u; }
    const size_t kstep = (size_t)(BK * 2);
    const size_t hstep = (size_t)HALF * K * 2;
    const size_t tstep = 2 * hstep;
    const unsigned ldsw = (unsigned)wid * 1024u;
    const int aoff = lds_byte(wr * 64 + fr, fq * 8), boff = lds_byte(wc * 32 + fr, fq * 8);
#define PG8_SA(b, h) (((b) * 2 + (h)) * HTB)
#define PG8_SB(b, h) ((4 + (b) * 2 + (h)) * HTB)
#define PG8_STAGE(bufoff, gbase, voff) do { _Pragma("unroll") for (int _i = 0; _i < 2; ++_i) \
        __builtin_amdgcn_global_load_lds((const unsigned*)((const char*)(gbase) + (voff)[_i]), (PG8_LAS unsigned*)(lds + (bufoff) + ldsw + _i * 8192), 16, 0, 0); } while (0)
#define PG8_LDA(dst, b, h) do { _Pragma("unroll") for (int m = 0; m < 4; ++m) _Pragma("unroll") for (int k = 0; k < 2; ++k) dst[m][k] = *(const PG8_LAS bf16x8*)(lds + PG8_SA(b, h) + aoff + m * 2048 + k * 1024); } while (0)
#define PG8_LDB(dst, b, h) do { _Pragma("unroll") for (int n = 0; n < 2; ++n) _Pragma("unroll") for (int k = 0; k < 2; ++k) dst[n][k] = *(const PG8_LAS bf16x8*)(lds + PG8_SB(b, h) + boff + n * 2048 + k * 1024); } while (0)
#define PG8_MMA(ai, bj, At, Bt) do { __builtin_amdgcn_s_setprio(1); _Pragma("unroll") for (int m = 0; m < 4; ++m) _Pragma("unroll") for (int n = 0; n < 2; ++n) _Pragma("unroll") for (int k = 0; k < 2; ++k) \
        acc[ai][bj][m][n] = __builtin_amdgcn_mfma_f32_16x16x32_bf16(Bt[n][k], At[m][k], acc[ai][bj][m][n], 0, 0, 0); __builtin_amdgcn_s_setprio(0); } while (0)
#define PG8_WAIT_V(n) asm volatile("s_waitcnt vmcnt(" #n ")" ::: "memory")
#define PG8_WAIT_L(n) asm volatile("s_waitcnt lgkmcnt(" #n ")" ::: "memory")
#define PG8_BAR __builtin_amdgcn_s_barrier()
#define PG8_SCHED __builtin_amdgcn_sched_barrier(0)
    Unit cur, nxt; int ui = 0;
    if (!S.next(0, cur)) return;
    f32x4 acc[2][2][4][2];
#pragma unroll
    for (int a = 0; a < 2; ++a)
#pragma unroll
        for (int b = 0; b < 2; ++b)
#pragma unroll
            for (int m = 0; m < 4; ++m)
#pragma unroll
                for (int n = 0; n < 2; ++n) acc[a][b][m][n] = (f32x4){0.f, 0.f, 0.f, 0.f};
    bf16x8 At[4][2], B0[2][2], B1[2][2];
    const char* cA = (const char*)g.A + (size_t)cur.pm * tstep; const char* cB = (const char*)g.Bt + (size_t)cur.pn * tstep;
    S.a_ready(cur);
    if constexpr (SP2) {
        PG8_STAGE(PG8_SB(0, 0), cB, voffB); PG8_STAGE(PG8_SB(0, 1), cB + hstep, voffB); PG8_STAGE(PG8_SA(0, 0), cA, voffA); PG8_STAGE(PG8_SA(0, 1), cA + hstep, voffA);
        if (wr == 1) PG8_BAR;
        PG8_WAIT_V(2); PG8_BAR;
        PG8_STAGE(PG8_SB(1, 0), cB + kstep, voffB); PG8_STAGE(PG8_SA(1, 0), cA + kstep, voffA); PG8_STAGE(PG8_SB(1, 1), cB + hstep + kstep, voffB);
        PG8_WAIT_V(6); PG8_BAR;
    } else {
        PG8_STAGE(PG8_SB(0, 0), cB, voffB); PG8_STAGE(PG8_SA(0, 0), cA, voffA); PG8_STAGE(PG8_SB(0, 1), cB + hstep, voffB); PG8_STAGE(PG8_SA(0, 1), cA + hstep, voffA);
        if (wr == 1) PG8_BAR;
        PG8_WAIT_V(4); PG8_BAR;
        PG8_STAGE(PG8_SB(1, 0), cB + kstep, voffB); PG8_STAGE(PG8_SA(1, 0), cA + kstep, voffA); PG8_STAGE(PG8_SB(1, 1), cB + hstep + kstep, voffB);
        PG8_WAIT_V(6); PG8_BAR;
    }
    for (;;) {
        const bool has_next = S.next(ui + 1, nxt);
        const char* nA = has_next ? (const char*)g.A + (size_t)nxt.pm * tstep : cA; const char* nB = has_next ? (const char*)g.Bt + (size_t)nxt.pn * tstep : cB;
        for (int t = 0; t < nt; t += 2) {
            const bool last = (t == nt - 2);
            const char* a1 = cA + (size_t)(t + 1) * kstep;
            const char* a2 = last ? nA : cA + (size_t)(t + 2) * kstep; const char* b2 = last ? nB : cB + (size_t)(t + 2) * kstep;
            const char* a3 = a2 + kstep; const char* b3 = b2 + kstep;
            if (last && has_next) S.a_ready(nxt);
            if constexpr (SP2) {
            PG8_LDB(B0, 0, 0); PG8_LDB(B1, 0, 1); PG8_SCHED; PG8_LDA(At, 0, 0); PG8_STAGE(PG8_SA(1, 1), a1 + hstep, voffA);
            PG8_WAIT_V(8); PG8_WAIT_L(0); PG8_BAR; PG8_MMA(0, 0, At, B0); PG8_MMA(0, 1, At, B1); PG8_BAR; PG8_SCHED;
            PG8_LDA(At, 0, 1); PG8_STAGE(PG8_SB(0, 0), b2, voffB); PG8_STAGE(PG8_SB(0, 1), b2 + hstep, voffB); PG8_STAGE(PG8_SA(0, 0), a2, voffA);
            PG8_WAIT_V(8); PG8_WAIT_L(0); PG8_BAR; PG8_MMA(1, 0, At, B0); PG8_MMA(1, 1, At, B1); PG8_BAR; PG8_SCHED;
            PG8_LDB(B0, 1, 0); PG8_LDB(B1, 1, 1); PG8_SCHED; PG8_LDA(At, 1, 0); PG8_STAGE(PG8_SA(0, 1), a2 + hstep, voffA);
            PG8_WAIT_V(8); PG8_WAIT_L(0); PG8_BAR; PG8_MMA(0, 0, At, B0); PG8_MMA(0, 1, At, B1); PG8_BAR; PG8_SCHED;
            PG8_LDA(At, 1, 1); PG8_STAGE(PG8_SB(1, 0), b3, voffB); PG8_STAGE(PG8_SB(1, 1), b3 + hstep, voffB); PG8_STAGE(PG8_SA(1, 0), a3, voffA);
            PG8_WAIT_V(8); PG8_WAIT_L(0); PG8_BAR; PG8_MMA(1, 0, At, B0); PG8_MMA(1, 1, At, B1); PG8_BAR; PG8_SCHED;
            } else {
            PG8_LDB(B0, 0, 0); PG8_SCHED; PG8_LDA(At, 0, 0); PG8_STAGE(PG8_SA(1, 1), a1 + hstep, voffA);
            PG8_WAIT_L(8); PG8_BAR; PG8_WAIT_L(0); PG8_MMA(0, 0, At, B0); PG8_BAR; PG8_SCHED;
            PG8_LDB(B1, 0, 1); PG8_STAGE(PG8_SB(0, 0), b2, voffB);
            PG8_BAR; PG8_WAIT_L(0); PG8_MMA(0, 1, At, B1); PG8_BAR;
            PG8_LDA(At, 0, 1); PG8_STAGE(PG8_SA(0, 0), a2, voffA);
            PG8_BAR; PG8_WAIT_L(0); PG8_MMA(1, 0, At, B0); PG8_BAR; PG8_SCHED;
            PG8_STAGE(PG8_SB(0, 1), b2 + hstep, voffB);
            PG8_WAIT_V(6); PG8_BAR; PG8_MMA(1, 1, At, B1); PG8_BAR;
            PG8_LDB(B0, 1, 0); PG8_SCHED; PG8_LDA(At, 1, 0); PG8_STAGE(PG8_SA(0, 1), a2 + hstep, voffA);
            PG8_WAIT_L(8); PG8_BAR; PG8_WAIT_L(0); PG8_MMA(0, 0, At, B0); PG8_BAR; PG8_SCHED;
            PG8_LDB(B1, 1, 1); PG8_STAGE(PG8_SB(1, 0), b3, voffB);
            PG8_BAR; PG8_WAIT_L(0); PG8_MMA(0, 1, At, B1); PG8_BAR;
            PG8_LDA(At, 1, 1); PG8_STAGE(PG8_SA(1, 0), a3, voffA);
            PG8_BAR; PG8_WAIT_L(0); PG8_MMA(1, 0, At, B0); PG8_BAR; PG8_SCHED;
            PG8_STAGE(PG8_SB(1, 1), b3 + hstep, voffB);
            PG8_WAIT_V(6); PG8_BAR; PG8_MMA(1, 1, At, B1); PG8_BAR;
            }
        }
        if constexpr (ALIGN_EPI) { if (wr == 0) PG8_BAR; }
        if constexpr (!Epi::AFTER_DRAIN) { E(acc, cur, wr, wc, fr, fq); S.done(cur); }
        if (!has_next) break;
#pragma unroll
        for (int a = 0; a < 2; ++a)
#pragma unroll
            for (int b = 0; b < 2; ++b)
#pragma unroll
                for (int m = 0; m < 4; ++m)
#pragma unroll
                    for (int n = 0; n < 2; ++n) acc[a][b][m][n] = (f32x4){0.f, 0.f, 0.f, 0.f};
        cur = nxt; cA = nA; cB = nB; ++ui;
        if constexpr (ALIGN_EPI) { if (wr == 1) PG8_BAR; }
    }
    PG8_WAIT_V(0);
    if constexpr (!ALIGN_EPI) { if (wr == 0) PG8_BAR; }
    PG8_BAR;
    if constexpr (Epi::AFTER_DRAIN) { E.fused(acc, cur, wr, wc, fr, fq, lds, wid, lane); S.done(cur); }
#undef PG8_SA
#undef PG8_SB
#undef PG8_STAGE
#undef PG8_LDA
#undef PG8_LDB
#undef PG8_MMA
#undef PG8_WAIT_V
#undef PG8_WAIT_L
#undef PG8_BAR
#undef PG8_SCHED
}
}
#define GAS __attribute__((address_space(1)))
#define LAS __attribute__((address_space(3)))
typedef unsigned short bf16;
typedef float f32x4 __attribute__((ext_vector_type(4)));
typedef short bf16x8 __attribute__((ext_vector_type(8)));
typedef short s16x4 __attribute__((ext_vector_type(4)));
typedef unsigned u32x4 __attribute__((ext_vector_type(4)));
typedef unsigned u32x2 __attribute__((ext_vector_type(2)));
constexpr int NB = 8, SEQ = 4096, DM = 1024, M = NB * SEQ;
constexpr int NH = 16, HD = 64, DSSM = 1024, DCONV = 1536, NST = 128, CHK = 128, NCHK = SEQ / CHK, NPROJ = 6672, NPADN = 6912, DINNER = 2048;
constexpr float EPS = 1e-6f;
constexpr float LOG2E = 1.4426950408889634f;
constexpr float QSCALE = 0.125f * LOG2E;
constexpr int NT = 512, NWV = 8;
constexpr size_t MiB = 1u << 20;
constexpr size_t WS_PCNT = 16384;
constexpr size_t WS_XCNT = 32768;
constexpr size_t WS_ROWSS = 65536;
constexpr size_t WS_ZERO_BYTES = 65536 + 131072;
constexpr size_t WS_RSTD = MiB / 2;
constexpr size_t WS_WINT = 1 * MiB;
constexpr size_t WS_WOUTT = 15 * MiB;
constexpr size_t WS_DTRAW = 19 * MiB;
constexpr size_t WS_ACS = 21 * MiB;
constexpr size_t WS_DTS = 23 * MiB;
constexpr size_t WS_LSE = 25 * MiB;
constexpr size_t WS_XB = 32 * MiB;
constexpr size_t WS_ST = 32 * MiB;
constexpr size_t WS_V = 96 * MiB, WS_G = 160 * MiB;
constexpr size_t WS_OUTPRE = 96 * MiB;
constexpr size_t WS_Z = 224 * MiB;
constexpr size_t WS_XBC = 288 * MiB;
constexpr size_t WS_MIX = 384 * MiB;
constexpr size_t WS_END = 512 * MiB;
constexpr int LDS_BYTES = 147456;

struct Args { const float *x, *npw, *w_in, *conv_w, *conv_b, *dt_bias, *a_log, *d_skip, *ssm_nw, *w_out, *npost_w; float* out; unsigned char* ws; int ph_lo, ph_hi; };

__device__ __forceinline__ float bf2f(unsigned u) { return __builtin_bit_cast(float, u << 16); }
__device__ __forceinline__ unsigned f2bf(float f) { unsigned u = __builtin_bit_cast(unsigned, f); return (u + 0x7fffu + ((u >> 16) & 1u)) >> 16; }
typedef float f32x2_t __attribute__((ext_vector_type(2))); typedef __bf16 bf16x2_t __attribute__((ext_vector_type(2)));
__device__ __forceinline__ unsigned pk2(float lo, float hi) { f32x2_t v = {lo, hi}; bf16x2_t b = __builtin_convertvector(v, bf16x2_t); return __builtin_bit_cast(unsigned, b); }
__device__ __forceinline__ float wave_sum(float v) {
#pragma unroll
    for (int o = 1; o < 64; o <<= 1) v += __shfl_xor(v, o);
    return v;
}
__device__ __forceinline__ float silu_f(float v) { return v * __builtin_amdgcn_rcpf(1.f + __builtin_amdgcn_exp2f(-LOG2E * v)); }
__device__ __forceinline__ float softplus_f(float v) { return v > 20.f ? v : log1pf(__expf(v)); }
#define LDS_WAIT() asm volatile("s_waitcnt lgkmcnt(0)" ::: "memory")

namespace pg8 {
struct EpiProj {
    static constexpr bool PERM = true, AFTER_DRAIN = false;
    bf16 *d0, *d1, *d2, *d3, *d4; bf16* xbc; float* dtraw; const float* rstd;
    __device__ __forceinline__ void operator()(const f32x4 (&acc)[2][2][4][2], const Unit& u, int wr, int wc, int fr, int fq) const {
        const int row0 = u.pm * BM + wr * 64 + fr; const int pn = u.pn;
        if (pn == 26) {
            if (wc == 0 && fq < 2) {
#pragma unroll
                for (int ai = 0; ai < 2; ++ai)
#pragma unroll
                    for (int m = 0; m < 4; ++m) { const int row = row0 + ai * HALF + m * 16; const float rs = rstd[row];
                        float* p = dtraw + (size_t)row * 16 + 8 * fq; *(f32x4*)p = acc[ai][0][m][0] * rs; *(f32x4*)(p + 4) = acc[ai][0][m][1] * rs; }
            }
            return;
        }
        bf16* base; int ldc, colt; float sc = 1.f;
        if (pn < 20) { const int sel = pn >> 2; base = sel == 0 ? d0 : sel == 1 ? d1 : sel == 2 ? d2 : sel == 3 ? d3 : d4; ldc = 1024; colt = (pn & 3) * BM; if (pn < 4) sc = QSCALE; }
        else { base = xbc; ldc = DCONV; colt = (pn - 20) * BM; }
        const int col0 = colt + wc * 32 + 8 * fq; const bool hm = pn < 12;
#pragma unroll
        for (int ai = 0; ai < 2; ++ai)
#pragma unroll
            for (int m = 0; m < 4; ++m) { const int row = row0 + ai * HALF + m * 16; const float rs = rstd[row] * sc;
#pragma unroll
                for (int bj = 0; bj < 2; ++bj) { const f32x4 v0 = acc[ai][bj][m][0] * rs, v1 = acc[ai][bj][m][1] * rs; const int col = col0 + bj * HALF;
                    bf16* p = hm ? base + ((size_t)((row >> 12) * NH + (col >> 6)) * SEQ + (row & (SEQ - 1))) * HD + (col & 63) : base + (size_t)row * ldc + col;
                    u32x4 w; w.x = cvt_pk_bf16(v0[0], v0[1]); w.y = cvt_pk_bf16(v0[2], v0[3]); w.z = cvt_pk_bf16(v1[0], v1[1]); w.w = cvt_pk_bf16(v1[2], v1[3]);
                    __builtin_nontemporal_store(w, (u32x4*)p); } }
    }
};
struct EpiF32 {
    static constexpr bool PERM = true, AFTER_DRAIN = false;
    float* O; int ldc;
    __device__ __forceinline__ void operator()(const f32x4 (&acc)[2][2][4][2], const Unit& u, int wr, int wc, int fr, int fq) const {
        const int row0 = u.pm * BM + wr * 64 + fr, col0 = u.pn * BM + wc * 32 + 8 * fq;
#pragma unroll
        for (int ai = 0; ai < 2; ++ai)
#pragma unroll
            for (int m = 0; m < 4; ++m) { float* rowp = O + (size_t)(row0 + ai * HALF + m * 16) * ldc + col0;
#pragma unroll
                for (int bj = 0; bj < 2; ++bj) { *(f32x4*)(rowp + bj * HALF) = acc[ai][bj][m][0]; *(f32x4*)(rowp + bj * HALF + 4) = acc[ai][bj][m][1]; } }
    }
};
struct EpiRmsRes {
    static constexpr bool PERM = true, AFTER_DRAIN = false;
    float* O; const float* X; const float* W; float* rowss; unsigned* pcnt;
    __device__ __forceinline__ void operator()(const f32x4 (&acc)[2][2][4][2], const Unit& u, int wr, int wc, int fr, int fq) const {
        const int row0 = u.pm * BM + wr * 64 + fr, col0 = u.pn * BM + wc * 32 + 8 * fq;
#pragma unroll
        for (int ai = 0; ai < 2; ++ai)
#pragma unroll
            for (int m = 0; m < 4; ++m) { float s = 0.f;
#pragma unroll
                for (int bj = 0; bj < 2; ++bj)
#pragma unroll
                    for (int n = 0; n < 2; ++n) { const f32x4 v = acc[ai][bj][m][n]; s += (v[0] * v[0] + v[1] * v[1]) + (v[2] * v[2] + v[3] * v[3]); }
                s += __shfl_xor(s, 16); s += __shfl_xor(s, 32);
                if (fq == 0) (void)__hip_atomic_fetch_add(rowss + row0 + ai * HALF + m * 16, s, __ATOMIC_RELAXED, __HIP_MEMORY_SCOPE_AGENT); }
        unsigned* cnt = pcnt + u.pm * 16;
        asm volatile("s_waitcnt vmcnt(0)" ::: "memory");
        if (threadIdx.x % 64 == 0) {
            (void)__hip_atomic_fetch_add(cnt, 1u, __ATOMIC_RELAXED, __HIP_MEMORY_SCOPE_AGENT);
            unsigned spin = 0;
            while (__hip_atomic_load(cnt, __ATOMIC_RELAXED, __HIP_MEMORY_SCOPE_AGENT) < 32u && ++spin < (1u << 22)) __builtin_amdgcn_s_sleep(2);
        }
        asm volatile("" ::: "memory");
        f32x4 wv[2][2];
#pragma unroll
        for (int bj = 0; bj < 2; ++bj) { wv[bj][0] = *(const f32x4*)(W + col0 + bj * HALF); wv[bj][1] = *(const f32x4*)(W + col0 + bj * HALF + 4); }
#pragma unroll
        for (int ai = 0; ai < 2; ++ai)
#pragma unroll
            for (int m = 0; m < 4; ++m) { const int row = row0 + ai * HALF + m * 16;
                const float ss = __hip_atomic_load(rowss + row, __ATOMIC_RELAXED, __HIP_MEMORY_SCOPE_AGENT); const float rs = 1.f / sqrtf(ss * (1.f / 1024.f) + 1e-6f);
                const float* xp = X + (size_t)row * 1024 + col0; float* op = O + (size_t)row * 1024 + col0;
#pragma unroll
                for (int bj = 0; bj < 2; ++bj) { const f32x4 x0 = __builtin_nontemporal_load((const f32x4*)(xp + bj * HALF)), x1 = __builtin_nontemporal_load((const f32x4*)(xp + bj * HALF + 4));
                    *(f32x4*)(op + bj * HALF) = x0 + acc[ai][bj][m][0] * wv[bj][0] * rs; *(f32x4*)(op + bj * HALF + 4) = x1 + acc[ai][bj][m][1] * wv[bj][1] * rs; } }
    }
};
}
#define XB_TMO      128
#define XB_XCNT(j)  (256  + 64 * (j))
#define XB_XSUB(j)  (1280 + 64 * (j))
#define XB_XGEN(j)  (2304 + 64 * (j))
#define XB_TOP      3328
#define XB_TOPGEN   3392
#define XCD_BAR_WORDS 3456
#define XB_SPIN_CAP (1u << 18)

__device__ __forceinline__ unsigned xb_ld(unsigned* p)              { return __hip_atomic_load(p, __ATOMIC_RELAXED, __HIP_MEMORY_SCOPE_AGENT); }
__device__ __forceinline__ unsigned xb_add(unsigned* p, unsigned v) { return __hip_atomic_fetch_add(p, v, __ATOMIC_RELAXED, __HIP_MEMORY_SCOPE_AGENT); }
__device__ __forceinline__ unsigned xb_xcc_id() { return (unsigned)__builtin_amdgcn_s_getreg((3 << 11) | 20) & 0xFu; }
#define XB_SPIN(cond, bar) do { unsigned _sp = 0; while (cond) { __builtin_amdgcn_s_sleep(1); \
    if ((++_sp & 255u) == 0u) { if (xb_ld(&(bar)[XB_TMO])) break; if (_sp > XB_SPIN_CAP) { atomicAdd(&(bar)[XB_TMO], 1u); break; } } } } while (0)

struct XcdBarrier {
    unsigned* bar; unsigned x;
    volatile LAS unsigned* st;
};

__device__ __forceinline__ XcdBarrier xcd_barrier_post(unsigned* bar, volatile LAS unsigned* st) {
    XcdBarrier b; b.bar = bar; b.x = xb_xcc_id(); b.st = st;
    if (threadIdx.x == 0) (void)xb_add(&bar[XB_XCNT(b.x)], 1u);
    return b;
}
__device__ __forceinline__ void xcd_barrier_complete(unsigned* bar, unsigned x, unsigned& nloc, unsigned& nx) {
    const unsigned G = gridDim.x * gridDim.y * gridDim.z;
    unsigned sum, cnt, mine, sp = 0u;
    for (;;) {
        sum = 0u; cnt = 0u; mine = 0u;
#pragma unroll
        for (unsigned j = 0; j < 16; ++j) { const unsigned c = xb_ld(&bar[XB_XCNT(j)]); sum += c; cnt += (c > 0u) ? 1u : 0u; mine = (j == x) ? c : mine; }
        if (sum == G) break;
        __builtin_amdgcn_s_sleep(1);
        if ((++sp & 255u) == 0u) { if (xb_ld(&bar[XB_TMO])) break; if (sp > XB_SPIN_CAP) { atomicAdd(&bar[XB_TMO], 1u); break; } }
    }
    nloc = mine > 0u ? mine : 1u; nx = cnt > 0u ? cnt : 1u;
}

__device__ __forceinline__ void xcd_barrier(const XcdBarrier& b) {
    asm volatile("s_waitcnt vmcnt(0)" ::: "memory");
    __syncthreads();
    if (threadIdx.x == 0) {
        unsigned* bar = b.bar;
        __builtin_amdgcn_s_waitcnt(0);
        unsigned nloc = b.st[0], nx = b.st[1];
        if (nloc == 0u) { xcd_barrier_complete(bar, b.x, nloc, nx); b.st[0] = nloc; b.st[1] = nx; }
        const unsigned old = xb_add(&bar[XB_XSUB(b.x)], 1u);
        const unsigned gen = old / nloc;
        if (old + 1u == (gen + 1u) * nloc) {
            __builtin_amdgcn_fence(__ATOMIC_RELEASE, "agent");
            asm volatile("s_waitcnt vmcnt(0)" ::: "memory");
            const unsigned og = xb_add(&bar[XB_TOP], 1u);
            const unsigned tg = og / nx;
            if (og + 1u == (tg + 1u) * nx) xb_add(&bar[XB_TOPGEN], 1u);
            else XB_SPIN(xb_ld(&bar[XB_TOPGEN]) == tg, bar);
            __builtin_amdgcn_fence(__ATOMIC_ACQUIRE, "agent");
            xb_add(&bar[XB_XGEN(b.x)], 1u);
            asm volatile("s_waitcnt vmcnt(0)" ::: "memory");
        } else {
            XB_SPIN(xb_ld(&bar[XB_XGEN(b.x)]) == gen, bar);
            __builtin_amdgcn_fence(__ATOMIC_ACQUIRE, "agent");
            asm volatile("s_waitcnt vmcnt(0)" ::: "memory");
        }
    }
    __syncthreads();
}
__device__ __forceinline__ void transpose_item(const float* W, int K, int N, bf16* WT, const float* kscale, LAS float* scr, int item, int lane) {
    const int nblk = (N + 31) / 32, kb = item / nblk, nb = item % nblk, k0 = 64 * kb, n0 = 32 * nb;
    const int nn = n0 + (lane & 31);
#pragma unroll 8
    for (int i = 0; i < 32; ++i) { const int kk = 2 * i + (lane >> 5); float v = (nn < N) ? __builtin_nontemporal_load(W + (size_t)(k0 + kk) * N + nn) : 0.f; if (kscale) v *= kscale[k0 + kk]; scr[kk * 33 + (lane & 31)] = v; }
    LDS_WAIT();
    const int c = lane & 7;
#pragma unroll
    for (int j = 0; j < 4; ++j) { const int n = (lane >> 3) + 8 * j; const LAS float* s = scr + (8 * c) * 33 + n;
        u32x4 o; o.x = pk2(s[0 * 33], s[1 * 33]); o.y = pk2(s[2 * 33], s[3 * 33]); o.z = pk2(s[4 * 33], s[5 * 33]); o.w = pk2(s[6 * 33], s[7 * 33]);
        if (n0 + n < N) *(u32x4*)(WT + (size_t)(n0 + n) * K + k0 + 8 * c) = o; }
    LDS_WAIT();
}
__device__ __forceinline__ void phase_prep(const Args& a, LAS unsigned char* lds, int gw, int NGW, int wave, int lane) {
    LAS float* scr = (LAS float*)(lds + wave * 16384);
    bf16* WINT = (bf16*)(a.ws + WS_WINT); bf16* WOUTT = (bf16*)(a.ws + WS_WOUTT); bf16* XB = (bf16*)(a.ws + WS_XB); float* RSTD = (float*)(a.ws + WS_RSTD);
    constexpr int I_IN = (DM / 64) * ((NPROJ + 31) / 32), I_OUT = (DINNER / 64) * (DM / 32);
    const int n_items = (gridDim.x == 256) ? I_IN : I_IN + I_OUT;
    for (int it = gw; it < n_items; it += NGW) {
        if (it < I_IN) transpose_item(a.w_in, DM, NPROJ, WINT, a.npw, scr, it, lane);
        else transpose_item(a.w_out, DINNER, DM, WOUTT, nullptr, scr, it - I_IN, lane);
    }
    for (int m0 = gw * 4; m0 < M; m0 += NGW * 4) {
        f32x4 v[4][4];
#pragma unroll
        for (int r = 0; r < 4; ++r) { const f32x4* xr = (const f32x4*)(a.x + (size_t)(m0 + r) * DM) + lane;
#pragma unroll
            for (int j = 0; j < 4; ++j) v[r][j] = __builtin_nontemporal_load(xr + 64 * j); }
#pragma unroll
        for (int r = 0; r < 4; ++r) { float s = 0.f;
#pragma unroll
            for (int j = 0; j < 4; ++j) s += (v[r][j].x * v[r][j].x + v[r][j].y * v[r][j].y) + (v[r][j].z * v[r][j].z + v[r][j].w * v[r][j].w);
            s = wave_sum(s);
            if (lane == 0) RSTD[m0 + r] = 1.f / sqrtf(s * (1.f / DM) + EPS);
            u32x2* o8 = (u32x2*)(XB + (size_t)(m0 + r) * DM) + lane;
#pragma unroll
            for (int j = 0; j < 4; ++j) { u32x2 o; o.x = pk2(v[r][j].x, v[r][j].y); o.y = pk2(v[r][j].z, v[r][j].w); o8[64 * j] = o; } }
    }
}

__device__ __forceinline__ void naive_attn(const Args& a, int gw, int NGW, int lane) {
    const bf16* Q = (const bf16*)a.out; const bf16* K = Q + (size_t)M * 1024; const bf16* V = (const bf16*)(a.ws + WS_V); const bf16* G = (const bf16*)(a.ws + WS_G);
    bf16* MIX = (bf16*)(a.ws + WS_MIX);
    for (int it = gw; it < M * NH; it += NGW) {
        const int row = it >> 4, h = it & 15, t = row & (SEQ - 1), b = row >> 12;
        const float q = bf2f(Q[(size_t)row * 1024 + h * 64 + lane]);
        float op[3], lsep[3];
#pragma unroll
        for (int p = 0; p < 3; ++p) {
            const int d = (p == 0) ? 1 : (p == 1 ? 4 : 16);
            float m = -INFINITY, l = 0.f, o = 0.f;
            for (int j = 0; j <= 128; ++j) {
                const int tk = t - j * d; if (tk < 0) break;
                const size_t kr = ((size_t)(b * SEQ + tk)) * 1024 + h * 64 + lane;
                const float s = wave_sum(q * bf2f(K[kr]));
                const float mn = fmaxf(m, s), sc = exp2f(m - mn), pe = exp2f(s - mn);
                l = l * sc + pe; o = o * sc + pe * bf2f(V[kr]); m = mn;
            }
            op[p] = o / l; lsep[p] = m + log2f(l);
        }
        const float mm = fmaxf(lsep[0], fmaxf(lsep[1], lsep[2]));
        const float w0 = exp2f(lsep[0] - mm), w1 = exp2f(lsep[1] - mm), w2 = exp2f(lsep[2] - mm);
        float r = (w0 * op[0] + w1 * op[1] + w2 * op[2]) / (w0 + w1 + w2);
        r *= silu_f(bf2f(G[(size_t)row * 1024 + h * 64 + lane]));
        MIX[(size_t)row * DINNER + h * 64 + lane] = (bf16)f2bf(r);
    }
}
__device__ __forceinline__ void naive_conv(const Args& a, int gt, int NGT) {
    const bf16* XBC = (const bf16*)(a.ws + WS_XBC); bf16* XC = (bf16*)a.out; const float* DTRAW = (const float*)(a.ws + WS_DTRAW); float* DTS = (float*)(a.ws + WS_DTS);
    for (size_t i = gt; i < (size_t)M * DCONV; i += NGT) {
        const int row = (int)(i / DCONV), ch = (int)(i % DCONV), t = row & (SEQ - 1);
        float acc = a.conv_b[ch];
#pragma unroll
        for (int k = 0; k < 4; ++k) { const int tt = t - 3 + k; if (tt >= 0) acc += a.conv_w[k * DCONV + ch] * bf2f(XBC[(size_t)(row - 3 + k) * DCONV + ch]); }
        XC[i] = (bf16)f2bf(silu_f(acc));
    }
    for (int i = gt; i < M * NH; i += NGT) DTS[i] = softplus_f(DTRAW[i] + a.dt_bias[i & 15]);
}
__device__ __forceinline__ void naive_ssd(const Args& a, int gw, int NGW, int lane) {
    const bf16* XC = (const bf16*)a.out; const float* DTS = (const float*)(a.ws + WS_DTS); float* Y = (float*)(a.ws + WS_OUTPRE);
    for (int it = gw; it < NB * NH * HD; it += NGW) {
        const int p = it & 63, h = (it >> 6) & 15, b = it >> 10, g = h >> 3;
        const float av = -__expf(a.a_log[h]), dsk = a.d_skip[h];
        float h0 = 0.f, h1 = 0.f;
        for (int t = 0; t < SEQ; ++t) {
            const size_t row = (size_t)b * SEQ + t; const bf16* xr = XC + row * DCONV;
            const float dt = DTS[row * 16 + h], dA = __expf(dt * av), x = bf2f(xr[h * 64 + p]);
            const float B0 = bf2f(xr[1024 + g * 128 + lane]), B1 = bf2f(xr[1024 + g * 128 + 64 + lane]);
            const float C0 = bf2f(xr[1280 + g * 128 + lane]), C1 = bf2f(xr[1280 + g * 128 + 64 + lane]);
            h0 = h0 * dA + dt * x * B0; h1 = h1 * dA + dt * x * B1;
            const float y = wave_sum(C0 * h0 + C1 * h1) + dsk * x;
            if (lane == 0) Y[row * 1024 + h * 64 + p] = y;
        }
    }
}
__device__ __forceinline__ void naive_gnorm(const Args& a, int gw, int NGW, int lane) {
    const float* Y = (const float*)(a.ws + WS_OUTPRE); const bf16* Z = (const bf16*)(a.ws + WS_Z); bf16* MIX = (bf16*)(a.ws + WS_MIX);
    for (int it = gw; it < M * 2; it += NGW) {
        const int row = it >> 1, g = it & 1; const int c0 = g * 512 + lane * 8;
        float v[8]; float ss = 0.f;
#pragma unroll
        for (int j = 0; j < 8; ++j) { const float y = Y[(size_t)row * 1024 + c0 + j], z = bf2f(Z[(size_t)row * 1024 + c0 + j]); v[j] = y * silu_f(z); ss += v[j] * v[j]; }
        ss = wave_sum(ss); const float r = 1.f / sqrtf(ss * (1.f / 512.f) + EPS);
#pragma unroll
        for (int j = 0; j < 8; ++j) MIX[(size_t)row * DINNER + 1024 + c0 + j] = (bf16)f2bf(v[j] * r * a.ssm_nw[c0 + j]);
    }
}
__device__ __forceinline__ void phase_final(const Args& a, int gw, int NGW, int lane) {
    const float* OP = (const float*)(a.ws + WS_OUTPRE);
    for (int m = gw; m < M; m += NGW) {
        const f32x4* pr = (const f32x4*)(OP + (size_t)m * DM) + lane; const f32x4* xr = (const f32x4*)(a.x + (size_t)m * DM) + lane; const f32x4* wr = (const f32x4*)a.npost_w + lane;
        f32x4 v[4]; float s = 0.f;
#pragma unroll
        for (int j = 0; j < 4; ++j) { v[j] = pr[64 * j]; s += (v[j].x * v[j].x + v[j].y * v[j].y) + (v[j].z * v[j].z + v[j].w * v[j].w); }
        s = wave_sum(s); const float r = 1.f / sqrtf(s * (1.f / DM) + EPS);
        f32x4* orow = (f32x4*)(a.out + (size_t)m * DM) + lane;
#pragma unroll
        for (int j = 0; j < 4; ++j) orow[64 * j] = xr[64 * j] + v[j] * r * wr[64 * j];
    }
}
constexpr int AP2 = 144;
constexpr int ATT_K = 0, ATT_V = 256 * AP2, ATT_END = 512 * AP2;
static_assert(ATT_END <= 131072, "attention LDS");
#define MFMA16(a, b, c) __builtin_amdgcn_mfma_f32_16x16x32_bf16((a), (b), (c), 0, 0, 0)
__device__ __forceinline__ s16x4 tr_read(const LAS unsigned char* p) { return __builtin_bit_cast(s16x4, __builtin_amdgcn_ds_read_tr16_b64_v4i16((LAS s16x4*)p)); }
__device__ __forceinline__ bf16x8 cat8(s16x4 lo, s16x4 hi) { return (bf16x8){lo[0], lo[1], lo[2], lo[3], hi[0], hi[1], hi[2], hi[3]}; }
__device__ __forceinline__ bf16x8 pack8(f32x4 lo, f32x4 hi) { u32x4 w; w.x = pk2(lo[0], lo[1]); w.y = pk2(lo[2], lo[3]); w.z = pk2(hi[0], hi[1]); w.w = pk2(hi[2], hi[3]); return __builtin_bit_cast(bf16x8, w); }
__device__ __forceinline__ f32x4 unpack4(u32x2 v) { return (f32x4){__builtin_bit_cast(float, v.x << 16), __builtin_bit_cast(float, v.x & 0xffff0000u), __builtin_bit_cast(float, v.y << 16), __builtin_bit_cast(float, v.y & 0xffff0000u)}; }
__device__ __forceinline__ u32x2 pack4(f32x4 v) { u32x2 o; o.x = pk2(v[0], v[1]); o.y = pk2(v[2], v[3]); return o; }

__device__ __forceinline__ void attn_step(int st, int half, int& d, int& r, int& qi0, bool& fresh) {
    if (st < 16) { d = 16; r = st; qi0 = half * 128; fresh = true; }
    else if (st < 32) { d = 4; r = (st - 16) >> 2; qi0 = half * 512 + ((st - 16) & 3) * 128; fresh = ((st - 16) & 3) == 0; }
    else { d = 1; r = 0; qi0 = half * 2048 + (st - 32) * 128; fresh = (st == 32); }
}
struct AttRegs { u32x4 kc[2], vc[2], kp[2], vp[2]; bf16x8 bq[2]; };
struct AttCtx { const bf16 *Q, *K, *V, *Gt; bf16* MIX; float* LSE; LAS unsigned char* lds; size_t rowb, hb; int half, h, li, quad, w, sc, sr0; };
__device__ __forceinline__ void att_fetch(AttRegs& R, const AttCtx& c, int s) {
    int d, r, q0; bool fr; attn_step(s, c.half, d, r, q0, fr);
#pragma unroll
    for (int i = 0; i < 2; ++i) { const size_t gr = c.hb + (size_t)(q0 + c.sr0 + 64 * i) * d + r; R.kc[i] = *(const u32x4*)(c.K + gr * 64 + c.sc * 8); R.vc[i] = *(const u32x4*)(c.V + gr * 64 + c.sc * 8); }
    if (fr) {
#pragma unroll
        for (int i = 0; i < 2; ++i) { R.kp[i] = (u32x4){0u, 0u, 0u, 0u}; R.vp[i] = (u32x4){0u, 0u, 0u, 0u};
            if (q0 >= 128) { const size_t gr = c.hb + (size_t)(q0 - 128 + c.sr0 + 64 * i) * d + r; R.kp[i] = *(const u32x4*)(c.K + gr * 64 + c.sc * 8); R.vp[i] = *(const u32x4*)(c.V + gr * 64 + c.sc * 8); } } }
    const size_t gq = c.hb + (size_t)(q0 + 16 * c.w + c.li) * d + r; R.bq[0] = *(const bf16x8*)(c.Q + gq * 64 + c.quad * 8); R.bq[1] = *(const bf16x8*)(c.Q + gq * 64 + 32 + c.quad * 8);
}
__device__ __forceinline__ void att_step(AttRegs& R, const AttCtx& c, int st) {
    LAS unsigned char* lds = c.lds; const int li = c.li, quad = c.quad, w = c.w, h = c.h, sc_ = c.sc, sr0 = c.sr0;
    int d, r, qi0; bool fresh; attn_step(st, c.half, d, r, qi0, fresh);
    const int cb = st & 1;
    if (st == 16 || st == 32) asm volatile("s_waitcnt vmcnt(0)" ::: "memory");
    __syncthreads();
#pragma unroll
    for (int i = 0; i < 2; ++i) { const int rr = sr0 + 64 * i;
        *(LAS u32x4*)(lds + ATT_K + (cb * 128 + rr) * AP2 + sc_ * 16) = R.kc[i]; *(LAS u32x4*)(lds + ATT_V + (cb * 128 + rr) * AP2 + sc_ * 16) = R.vc[i];
        if (fresh) { *(LAS u32x4*)(lds + ATT_K + ((cb ^ 1) * 128 + rr) * AP2 + sc_ * 16) = R.kp[i]; *(LAS u32x4*)(lds + ATT_V + ((cb ^ 1) * 128 + rr) * AP2 + sc_ * 16) = R.vp[i]; } }
    const bf16x8 bq0 = R.bq[0], bq1 = R.bq[1];
    __syncthreads();
    if (st + 2 < 48) att_fetch(R, c, st + 2);
    const size_t grow = c.rowb + (size_t)(qi0 + 16 * w + li) * d + r;
    bf16* mp = c.MIX + grow * DINNER + h * 64 + 4 * quad;
    u32x2 prv[4], gv[4]; float lse_p = 0.f;
    if (st >= 16) { lse_p = c.LSE[grow * 16 + h];
#pragma unroll
        for (int dt = 0; dt < 4; ++dt) prv[dt] = *(const u32x2*)(mp + 16 * dt); }
    if (st >= 32) {
#pragma unroll
        for (int dt = 0; dt < 4; ++dt) gv[dt] = *(const u32x2*)(c.Gt + grow * 1024 + h * 64 + 4 * quad + 16 * dt); }
    const bool zpre = (qi0 < 128);
    f32x4 sc[9];
#pragma unroll
    for (int kt = 0; kt < 9; ++kt) { const int T = w + kt; const int ph = (T >> 3) ? cb : (cb ^ 1);
        const LAS unsigned char* kq = lds + ATT_K + (ph * 128 + (T & 7) * 16 + li) * AP2 + quad * 16;
        const bf16x8 a0 = *(const LAS bf16x8*)kq, a1 = *(const LAS bf16x8*)(kq + 64);
        f32x4 z = {0.f, 0.f, 0.f, 0.f}; z = MFMA16(a0, bq0, z); z = MFMA16(a1, bq1, z); sc[kt] = z; }
#pragma unroll
    for (int j = 0; j < 4; ++j) { if (4 * quad + j < li) sc[0][j] = -INFINITY; if (4 * quad + j > li) sc[8][j] = -INFINITY; }
    if (zpre) {
#pragma unroll
        for (int kt = 0; kt < 8; ++kt) if (w + kt < 8) sc[kt] = (f32x4){-INFINITY, -INFINITY, -INFINITY, -INFINITY}; }
    float mx = -INFINITY;
#pragma unroll
    for (int kt = 0; kt < 9; ++kt) mx = fmaxf(fmaxf(mx, fmaxf(sc[kt][0], sc[kt][1])), fmaxf(sc[kt][2], sc[kt][3]));
    mx = fmaxf(mx, __shfl_xor(mx, 16)); mx = fmaxf(mx, __shfl_xor(mx, 32));
    float l = 0.f;
#pragma unroll
    for (int kt = 0; kt < 9; ++kt)
#pragma unroll
        for (int j = 0; j < 4; ++j) { const float p = __builtin_amdgcn_exp2f(sc[kt][j] - mx); sc[kt][j] = p; l += p; }
    l += __shfl_xor(l, 16); l += __shfl_xor(l, 32);
    bf16x8 bp[5];
#pragma unroll
    for (int kp_ = 0; kp_ < 4; ++kp_) bp[kp_] = pack8(sc[2 * kp_], sc[2 * kp_ + 1]);
    bp[4] = pack8(sc[8], (f32x4){0.f, 0.f, 0.f, 0.f});
    f32x4 o[4];
#pragma unroll
    for (int dt = 0; dt < 4; ++dt) o[dt] = (f32x4){0.f, 0.f, 0.f, 0.f};
#pragma unroll
    for (int kp_ = 0; kp_ < 5; ++kp_) { const int T0 = w + 2 * kp_, T1 = T0 + 1; const int p0 = (T0 >> 3) ? cb : (cb ^ 1), p1 = (T1 >> 3) ? cb : (cb ^ 1);
        const LAS unsigned char* v0 = lds + ATT_V + (p0 * 128 + (T0 & 7) * 16 + 4 * quad + (li >> 2)) * AP2 + (li & 3) * 8;
        const LAS unsigned char* v1 = lds + ATT_V + (p1 * 128 + (T1 & 7) * 16 + 4 * quad + (li >> 2)) * AP2 + (li & 3) * 8;
#pragma unroll
        for (int dt = 0; dt < 4; ++dt) { const s16x4 lo = tr_read(v0 + dt * 32); const s16x4 hi = (kp_ < 4) ? tr_read(v1 + dt * 32) : (s16x4){0, 0, 0, 0};
            o[dt] = MFMA16(cat8(lo, hi), bp[kp_], o[dt]); } }
    const float lse_t = mx + __builtin_amdgcn_logf(l), inv_l = __builtin_amdgcn_rcpf(l);
    if (st < 16) {
#pragma unroll
        for (int dt = 0; dt < 4; ++dt) *(u32x2*)(mp + 16 * dt) = pack4(o[dt] * inv_l);
        if (quad == 0) c.LSE[grow * 16 + h] = lse_t;
    } else {
        const float mm = fmaxf(lse_p, lse_t), wa = __builtin_amdgcn_exp2f(lse_p - mm), wb = __builtin_amdgcn_exp2f(lse_t - mm);
        const float inv = __builtin_amdgcn_rcpf(wa + wb), ca = wa * inv, cbw = wb * inv * inv_l;
#pragma unroll
        for (int dt = 0; dt < 4; ++dt) { f32x4 v = unpack4(prv[dt]) * ca + o[dt] * cbw;
            if (st >= 32) { const f32x4 g = unpack4(gv[dt]); v[0] *= silu_f(g[0]); v[1] *= silu_f(g[1]); v[2] *= silu_f(g[2]); v[3] *= silu_f(g[3]); }
            *(u32x2*)(mp + 16 * dt) = pack4(v); }
        if (st < 32 && quad == 0) c.LSE[grow * 16 + h] = mm + __builtin_amdgcn_logf(wa + wb);
    }
}
__device__ __forceinline__ void phase_attn(const Args& a, LAS unsigned char* lds, int tid, int wave, int lane, int vc) {
    AttCtx c; c.Q = (const bf16*)a.out; c.K = c.Q + (size_t)M * 1024; c.V = (const bf16*)(a.ws + WS_V); c.Gt = (const bf16*)(a.ws + WS_G);
    c.MIX = (bf16*)(a.ws + WS_MIX); c.LSE = (float*)(a.ws + WS_LSE); c.lds = lds;
    c.li = lane & 15; c.quad = lane >> 4; c.w = wave; c.sc = tid & 7; c.sr0 = tid >> 3;
    for (int unit = vc; unit < NB * NH * 2; unit += gridDim.x) {
        const int bh = (unit & 7) | ((unit >> 4) << 3);
        c.half = (unit >> 3) & 1; c.h = bh & 15; const int b = bh >> 4;
        c.rowb = (size_t)b * SEQ; c.hb = (size_t)(b * NH + c.h) * SEQ;
        AttRegs R0, R1;
        att_fetch(R0, c, 0); att_fetch(R1, c, 1);
        for (int st = 0; st < 48; st += 2) { att_step(R0, c, st); att_step(R1, c, st + 1); }
    }
    __syncthreads();
}
#define LDS_BARRIER() do { asm volatile("s_waitcnt lgkmcnt(0)" ::: "memory"); __builtin_amdgcn_s_barrier(); asm volatile("" ::: "memory"); } while (0)
struct ConvRaw { u32x4 v[4]; };
__device__ __forceinline__ ConvRaw conv_load(const bf16* XBC, size_t row, int t, int ch0) {
    ConvRaw r;
#pragma unroll
    for (int k = 0; k < 4; ++k) r.v[k] = (t - 3 + k >= 0) ? *(const u32x4*)(XBC + (row - 3 + k) * DCONV + ch0) : (u32x4){0u, 0u, 0u, 0u};
    return r;
}
__device__ __forceinline__ void conv_apply(const ConvRaw& r, int ch0, const float* cw, const float* cb, f32x4& o0, f32x4& o1) {
    f32x4 a0 = *(const f32x4*)(cb + ch0), a1 = *(const f32x4*)(cb + ch0 + 4);
#pragma unroll
    for (int k = 0; k < 4; ++k) { const u32x4 v = r.v[k];
        const f32x4 w0 = *(const f32x4*)(cw + k * DCONV + ch0), w1 = *(const f32x4*)(cw + k * DCONV + ch0 + 4);
        a0 += w0 * unpack4((u32x2){v.x, v.y}); a1 += w1 * unpack4((u32x2){v.z, v.w}); }
    o0 = (f32x4){silu_f(a0[0]), silu_f(a0[1]), silu_f(a0[2]), silu_f(a0[3])}; o1 = (f32x4){silu_f(a1[0]), silu_f(a1[1]), silu_f(a1[2]), silu_f(a1[3])};
}
__device__ __forceinline__ void conv8(const bf16* XBC, size_t row, int t, int ch0, const float* cw, const float* cb, f32x4& o0, f32x4& o1) {
    const ConvRaw r = conv_load(XBC, row, t, ch0); conv_apply(r, ch0, cw, cb, o0, o1);
}
constexpr int BP2 = 272;
constexpr int SS_B = 0, SS_C = 128 * BP2, SS_XS = 2 * 128 * BP2, SS_XD = SS_XS + 128 * AP2, SS_XW = SS_XD + 128 * AP2, SS_ACS = SS_XW + 128 * AP2, SS_DT = SS_ACS + 4096, SS_END = SS_DT + 4096;
static_assert(SS_END <= LDS_BYTES, "ssd LDS");

__device__ __forceinline__ void phase_ssd_chunk(const Args& a, LAS unsigned char* lds, int tid, int wave, int lane, int vc) {
    const bf16* XBC = (const bf16*)(a.ws + WS_XBC); const float* DTRAW = (const float*)(a.ws + WS_DTRAW); float* ACS = (float*)(a.ws + WS_ACS);
    bf16* MIX = (bf16*)(a.ws + WS_MIX); bf16* ST = (bf16*)(a.ws + WS_ST);
    const int li = lane & 15, quad = lane >> 4, w = wave;
    LAS float* ACSs = (LAS float*)(lds + SS_ACS); LAS float* DTs = (LAS float*)(lds + SS_DT);
    for (int unit = vc; unit < NB * NCHK * 2; unit += gridDim.x) {
        const int g = unit & 1, c = (unit >> 1) & 31, b = unit >> 6;
        const size_t row0 = (size_t)b * SEQ + c * CHK; const int t0 = c * CHK;
        LDS_BARRIER();
        const float dtr0 = DTRAW[(row0 + 2 * lane) * 16 + 8 * g + w], dtr1 = DTRAW[(row0 + 2 * lane + 1) * 16 + 8 * g + w];
#pragma unroll 4
        for (int i = 0; i < 8; ++i) { const int item = i * NT + tid, cc = item & 31, l = item >> 5;
            const int ch0 = (cc < 16) ? (1024 + g * 128 + cc * 8) : (1280 + g * 128 + (cc - 16) * 8);
            f32x4 o0, o1; conv8(XBC, row0 + l, t0 + l, ch0, a.conv_w, a.conv_b, o0, o1);
            *(LAS bf16x8*)(lds + ((cc < 16) ? SS_B : SS_C) + l * BP2 + (cc & 15) * 16) = pack8(o0, o1); }
        {   const int hh = 8 * g + w; const float av = -__expf(a.a_log[hh]), db = a.dt_bias[hh];
            const float d0 = softplus_f(dtr0 + db), d1 = softplus_f(dtr1 + db);
            const float s = (d0 + d1) * av; float inc = s;
#pragma unroll
            for (int o = 1; o < 64; o <<= 1) { const float t = __shfl_up(inc, o); if (lane >= o) inc += t; }
            const float c0 = inc - s + d0 * av, c1 = inc;
            ACSs[w * 128 + 2 * lane] = c0; ACSs[w * 128 + 2 * lane + 1] = c1; DTs[w * 128 + 2 * lane] = d0; DTs[w * 128 + 2 * lane + 1] = d1;
            ACS[(row0 + 2 * lane) * 16 + hh] = c0; ACS[(row0 + 2 * lane + 1) * 16 + hh] = c1; }
        LDS_BARRIER();
        const int npair = (w >> 1) + 1;
        f32x4 cbt[8];
        {   bf16x8 bc[4];
#pragma unroll
            for (int ks = 0; ks < 4; ++ks) bc[ks] = *(const LAS bf16x8*)(lds + SS_C + (16 * w + li) * BP2 + ks * 64 + quad * 16);
#pragma unroll
            for (int st = 0; st < 8; ++st) { f32x4 z = {0.f, 0.f, 0.f, 0.f};
                if (st < 2 * npair) {
#pragma unroll
                    for (int ks = 0; ks < 4; ++ks) z = MFMA16(*(const LAS bf16x8*)(lds + SS_B + (16 * st + li) * BP2 + ks * 64 + quad * 16), bc[ks], z); }
                cbt[st] = z; } }
        ConvRaw xr[2];
#pragma unroll
        for (int i = 0; i < 2; ++i) { const int item = i * NT + tid, cc = item & 7, l = item >> 3; xr[i] = conv_load(XBC, row0 + l, t0 + l, 8 * g * 64 + cc * 8); }
        for (int hh = 0; hh < 8; ++hh) {
            const int h = 8 * g + hh; const float dsk = a.d_skip[h];
            LDS_BARRIER();
            const float alast = ACSs[hh * 128 + 127];
#pragma unroll
            for (int i = 0; i < 2; ++i) { const int item = i * NT + tid, cc = item & 7, l = item >> 3;
                f32x4 o0, o1; conv_apply(xr[i], h * 64 + cc * 8, a.conv_w, a.conv_b, o0, o1);
                if (hh < 7) xr[i] = conv_load(XBC, row0 + l, t0 + l, (h + 1) * 64 + cc * 8);
                const float dt = DTs[hh * 128 + l], dw = dt * __expf(alast - ACSs[hh * 128 + l]);
                *(LAS bf16x8*)(lds + SS_XS + l * AP2 + cc * 16) = pack8(o0, o1);
                *(LAS bf16x8*)(lds + SS_XD + l * AP2 + cc * 16) = pack8(o0 * dt, o1 * dt);
                *(LAS bf16x8*)(lds + SS_XW + l * AP2 + cc * 16) = pack8(o0 * dw, o1 * dw); }
            LDS_BARRIER();
            const float al = ACSs[hh * 128 + 16 * w + li];
            f32x4 o[4];
#pragma unroll
            for (int pt = 0; pt < 4; ++pt) o[pt] = (f32x4){0.f, 0.f, 0.f, 0.f};
            const LAS unsigned char* xdb = lds + SS_XD + (4 * quad + (li >> 2)) * AP2 + (li & 3) * 8;
#pragma unroll
            for (int kp = 0; kp < 4; ++kp) {
                if (kp < npair) {
                    f32x4 lt[2];
#pragma unroll
                    for (int t = 0; t < 2; ++t) { const f32x4 as = *(const LAS f32x4*)(ACSs + hh * 128 + 16 * (2 * kp + t) + 4 * quad);
#pragma unroll
                        for (int e = 0; e < 4; ++e) { const int s = 16 * (2 * kp + t) + 4 * quad + e; lt[t][e] = (s <= 16 * w + li) ? cbt[2 * kp + t][e] * __expf(al - as[e]) : 0.f; } }
                    const bf16x8 bp = pack8(lt[0], lt[1]);
#pragma unroll
                    for (int pt = 0; pt < 4; ++pt) { const LAS unsigned char* p1 = xdb + (32 * kp) * AP2 + pt * 32;
                        o[pt] = MFMA16(cat8(tr_read(p1), tr_read(p1 + 16 * AP2)), bp, o[pt]); }
                }
            }
#pragma unroll
            for (int pt = 0; pt < 4; ++pt) { const f32x4 xs = unpack4(*(const LAS u32x2*)(lds + SS_XS + (16 * w + li) * AP2 + (16 * pt + 4 * quad) * 2));
                *(u32x2*)(MIX + (row0 + 16 * w + li) * DINNER + 1024 + h * 64 + 16 * pt + 4 * quad) = pack4(o[pt] + xs * dsk); }
            f32x4 sa[4];
#pragma unroll
            for (int pt = 0; pt < 4; ++pt) sa[pt] = (f32x4){0.f, 0.f, 0.f, 0.f};
            const LAS unsigned char* bb = lds + SS_B + (8 * quad + (li >> 2)) * BP2 + (16 * w + 4 * (li & 3)) * 2;
            const LAS unsigned char* xwb = lds + SS_XW + (8 * quad + (li >> 2)) * AP2 + (li & 3) * 8;
#pragma unroll
            for (int ks = 0; ks < 4; ++ks) { const bf16x8 aB = cat8(tr_read(bb + (32 * ks) * BP2), tr_read(bb + (32 * ks + 4) * BP2));
#pragma unroll
                for (int pt = 0; pt < 4; ++pt) { const LAS unsigned char* p1 = xwb + (32 * ks) * AP2 + pt * 32;
                    sa[pt] = MFMA16(aB, cat8(tr_read(p1), tr_read(p1 + 4 * AP2)), sa[pt]); } }
            bf16* stp = ST + ((((size_t)b * NCHK + c) * NH + h) * HD) * NST;
#pragma unroll
            for (int pt = 0; pt < 4; ++pt) *(u32x2*)(stp + (size_t)(16 * pt + li) * NST + 16 * w + 4 * quad) = pack4(sa[pt]);
        }
    }
    __syncthreads();
}
__device__ __forceinline__ void phase_scan(const Args& a, int gt, int NGT) {
    bf16* ST = (bf16*)(a.ws + WS_ST); const float* ACS = (const float*)(a.ws + WS_ACS);
    for (int idx = gt; idx < NB * NH * HD * 16; idx += NGT) {
        const int n8 = idx & 15, p = (idx >> 4) & 63, h = (idx >> 10) & 15, b = idx >> 14;
        f32x4 s0 = {0.f, 0.f, 0.f, 0.f}, s1 = {0.f, 0.f, 0.f, 0.f};
        for (int c0 = 0; c0 < NCHK; c0 += 8) {
            u32x4 v[8]; float dec[8];
#pragma unroll
            for (int j = 0; j < 8; ++j) { const int c = c0 + j; v[j] = *(const u32x4*)(ST + ((((size_t)b * NCHK + c) * NH + h) * HD + p) * NST + n8 * 8);
                dec[j] = __expf(ACS[((size_t)b * SEQ + c * CHK + 127) * 16 + h]); }
#pragma unroll
            for (int j = 0; j < 8; ++j) { const int c = c0 + j;
                u32x4 o; o.x = pk2(s0[0], s0[1]); o.y = pk2(s0[2], s0[3]); o.z = pk2(s1[0], s1[1]); o.w = pk2(s1[2], s1[3]);
                *(u32x4*)(ST + ((((size_t)b * NCHK + c) * NH + h) * HD + p) * NST + n8 * 8) = o;
                s0 = s0 * dec[j] + unpack4((u32x2){v[j].x, v[j].y});
                s1 = s1 * dec[j] + unpack4((u32x2){v[j].z, v[j].w}); }
        }
    }
}
constexpr int PVP = 272, PVH = 64 * PVP, SO_PV = 128 * BP2;
static_assert(SO_PV + 4 * PVH <= LDS_BYTES, "ssd_out LDS");
__device__ __forceinline__ void phase_ssd_out(const Args& a, LAS unsigned char* lds, int tid, int wave, int lane, int vc) {
    const bf16* XBC = (const bf16*)(a.ws + WS_XBC); const float* ACS = (const float*)(a.ws + WS_ACS); const bf16* Z = (const bf16*)(a.ws + WS_Z);
    bf16* MIX = (bf16*)(a.ws + WS_MIX); const bf16* ST = (const bf16*)(a.ws + WS_ST);
    const int li = lane & 15, quad = lane >> 4, w = wave;
    for (int unit = vc; unit < NB * NCHK * 2; unit += gridDim.x) {
        const int g = unit & 1, c = (unit >> 1) & 31, b = unit >> 6;
        const size_t row0 = (size_t)b * SEQ + c * CHK; const int t0 = c * CHK;
        const size_t row = row0 + 16 * w + li;
        u32x4 pr[4]; u32x2 ydn[2][4], zn[2][4]; float eln[2];
#define SO_PREFETCH(q) do { const int hb_ = 8 * g + 2 * (q); const u32x4* src_ = (const u32x4*)(ST + ((((size_t)b * NCHK + c) * NH + hb_) * HD) * NST); \
        _Pragma("unroll") for (int i = 0; i < 4; ++i) pr[i] = src_[i * NT + tid]; \
        _Pragma("unroll") for (int hh = 0; hh < 2; ++hh) { eln[hh] = ACS[row * 16 + hb_ + hh]; \
            _Pragma("unroll") for (int pt = 0; pt < 4; ++pt) { const int col_ = (hb_ + hh) * 64 + 16 * pt + 4 * quad; \
                ydn[hh][pt] = *(const u32x2*)(MIX + row * DINNER + 1024 + col_); zn[hh][pt] = *(const u32x2*)(Z + row * 1024 + col_); } } } while (0)
        LDS_BARRIER();
#pragma unroll
        for (int i = 0; i < 4; ++i) { const int item = i * NT + tid, cc = item & 15, l = item >> 4;
            f32x4 o0, o1; conv8(XBC, row0 + l, t0 + l, 1280 + g * 128 + cc * 8, a.conv_w, a.conv_b, o0, o1);
            *(LAS bf16x8*)(lds + 0 + l * BP2 + cc * 16) = pack8(o0, o1); }
        asm volatile("" ::: "memory");
        SO_PREFETCH(0);
        bf16x8 bc[4];
        u32x2 yzp[8][4]; float ss = 0.f;
#pragma unroll
        for (int q = 0; q < 4; ++q) {
#pragma unroll
            for (int i = 0; i < 4; ++i) { const int idx = i * NT + tid, rr = idx >> 4; *(LAS u32x4*)(lds + SO_PV + (q & 1) * 2 * PVH + (rr >> 6) * PVH + (rr & 63) * PVP + (idx & 15) * 16) = pr[i]; }
            u32x2 ydc[2][4], zc[2][4]; float elc[2];
#pragma unroll
            for (int hh = 0; hh < 2; ++hh) { elc[hh] = eln[hh];
#pragma unroll
                for (int pt = 0; pt < 4; ++pt) { ydc[hh][pt] = ydn[hh][pt]; zc[hh][pt] = zn[hh][pt]; } }
            LDS_BARRIER();
            if (q == 0) {
#pragma unroll
                for (int ks = 0; ks < 4; ++ks) bc[ks] = *(const LAS bf16x8*)(lds + 0 + (16 * w + li) * BP2 + ks * 64 + quad * 16); }
            if (q < 3) SO_PREFETCH(q + 1);
#pragma unroll
            for (int hh = 0; hh < 2; ++hh) { const float e = __expf(elc[hh]);
#pragma unroll
                for (int pt = 0; pt < 4; ++pt) { f32x4 acc = {0.f, 0.f, 0.f, 0.f}; if (pt & 1) asm volatile("" ::: "memory");
#pragma unroll
                    for (int ks = 0; ks < 4; ++ks) acc = MFMA16(*(const LAS bf16x8*)(lds + SO_PV + ((q & 1) * 2 + hh) * PVH + (16 * pt + li) * PVP + ks * 64 + quad * 16), bc[ks], acc);
                    const f32x4 z = unpack4(zc[hh][pt]);
                    f32x4 y = acc * e + unpack4(ydc[hh][pt]); y[0] *= silu_f(z[0]); y[1] *= silu_f(z[1]); y[2] *= silu_f(z[2]); y[3] *= silu_f(z[3]);
                    ss += (y[0] * y[0] + y[1] * y[1]) + (y[2] * y[2] + y[3] * y[3]); yzp[2 * q + hh][pt] = pack4(y); } }
        }
#undef SO_PREFETCH
        ss += __shfl_xor(ss, 16); ss += __shfl_xor(ss, 32);
        const float r = 1.f / sqrtf(ss * (1.f / 512.f) + EPS);
#pragma unroll
        for (int hh = 0; hh < 8; ++hh) { asm volatile("" ::: "memory");
#pragma unroll
            for (int pt = 0; pt < 4; ++pt) { const int col = (8 * g + hh) * 64 + 16 * pt + 4 * quad; const f32x4 wv = *(const f32x4*)(a.ssm_nw + col);
                *(u32x2*)(MIX + row * DINNER + 1024 + col) = pack4(unpack4(yzp[hh][pt]) * wv * r); } }
    }
    __syncthreads();
}
#ifndef ONE_LAUNCH
#define ONE_LAUNCH 1
#endif
constexpr int NPHASE = 8;
#ifndef REP_ATTN
#define REP_ATTN 1
#endif
#ifndef REP_P3
#define REP_P3 1
#endif
#ifndef REP_SSD
#define REP_SSD 1
#endif
template <bool FUSED> __global__ void __launch_bounds__(NT, 2) hybrid_fwd(Args a) {
    extern __shared__ __attribute__((aligned(16))) unsigned char lds_raw[];
    LAS unsigned char* lds = (LAS unsigned char*)lds_raw;
    const int tid = threadIdx.x, lane = tid & 63, wave = __builtin_amdgcn_readfirstlane(tid >> 6);
    const int G = gridDim.x, gw = blockIdx.x * NWV + wave, NGW = G * NWV, gt = blockIdx.x * NT + tid, NGT = G * NT;
    const int lo = a.ph_lo, hi = a.ph_hi;
    volatile LAS unsigned* bst = (volatile LAS unsigned*)(lds + LDS_BYTES - 64);
    if (tid < 16) bst[tid] = 0u;
    __syncthreads();
    const XcdBarrier bar = xcd_barrier_post((unsigned*)a.ws, bst);
    unsigned* XCNT = (unsigned*)(a.ws + WS_XCNT);
    const unsigned myx = xb_xcc_id();
    if (tid == 0) bst[4] = __hip_atomic_fetch_add(XCNT + myx * 16, 1u, __ATOMIC_RELAXED, __HIP_MEMORY_SCOPE_AGENT);
#define IN(k) (lo <= (k) && (k) < hi)
#ifdef PROBE_K
    unsigned long long* tsb = (unsigned long long*)(a.ws + 262144);
#define STAMP(i) do { if (blockIdx.x == 0 && tid == 0) tsb[i] = __builtin_amdgcn_s_memrealtime(); } while (0)
#else
#define STAMP(i) do { } while (0)
#endif
    STAMP(0);
#define SEAM(k) do { if (IN(k) && IN((k) + 1)) { xcd_barrier(bar); } } while (0)
    if (hi > NPHASE) cg::this_grid().sync();
    if (IN(0)) { phase_prep(a, lds, gw, NGW, wave, lane); __syncthreads(); } SEAM(0); STAMP(1);
    if (tid == 0) { unsigned base = 0, all32 = 1;
        for (unsigned j = 0; j < 16; ++j) { const unsigned cj = __hip_atomic_load(XCNT + j * 16, __ATOMIC_RELAXED, __HIP_MEMORY_SCOPE_AGENT); if (j < myx) base += cj; if (j < 8 ? cj != 32u : cj != 0u) all32 = 0; }
        const unsigned vcu = base + bst[4];
        bst[5] = (all32 && G == 256) ? (vcu & 31u) * 8u + (vcu >> 5) : vcu; }
    __syncthreads();
    const int vc = (int)bst[5];
    if (IN(1)) {
        pg8::Gemm g{(const bf16*)(a.ws + WS_XB), (const bf16*)(a.ws + WS_WINT), M, NPADN, DM}; pg8::StaticOrder S; S.init(M, NPADN, G, vc);
        pg8::EpiProj E; E.d0 = (bf16*)a.out; E.d1 = (bf16*)a.out + (size_t)M * 1024; E.d2 = (bf16*)(a.ws + WS_V); E.d3 = (bf16*)(a.ws + WS_G); E.d4 = (bf16*)(a.ws + WS_Z);
        E.xbc = (bf16*)(a.ws + WS_XBC); E.dtraw = (float*)(a.ws + WS_DTRAW); E.rstd = (const float*)(a.ws + WS_RSTD);
        pg8::gemm_phase<pg8::EpiProj, pg8::StaticOrder, true, true>(lds, g, S, E);
        if (G == 256 && vc >= 128) {
            constexpr int I_OUT = (DINNER / 64) * (DM / 32);
            LAS float* scr = (LAS float*)(lds + wave * 16384);
            for (int it = (vc - 128) * NWV + wave; it < I_OUT; it += 128 * NWV) transpose_item(a.w_out, DINNER, DM, (bf16*)(a.ws + WS_WOUTT), nullptr, scr, it, lane);
        }
    } SEAM(1); STAMP(2);
    if (IN(2)) { for (int rep = 0; rep < REP_ATTN; ++rep) phase_attn(a, lds, tid, wave, lane, vc); }   STAMP(3);
    for (int rep = 0; rep < REP_SSD; ++rep) {
        if (rep) xcd_barrier(bar);
        if (IN(3)) { for (int r3 = 0; r3 < REP_P3; ++r3) phase_ssd_chunk(a, lds, tid, wave, lane, vc); } SEAM(3); STAMP(4);
        if (IN(4)) phase_scan(a, gt, NGT); SEAM(4); STAMP(5);
        if (IN(5)) phase_ssd_out(a, lds, tid, wave, lane, vc);
    }
    SEAM(5); STAMP(6);
    if (IN(6)) {
        pg8::Gemm g{(const bf16*)(a.ws + WS_MIX), (const bf16*)(a.ws + WS_WOUTT), M, DM, DINNER}; pg8::StaticOrder S; S.init(M, DM, G, vc);
        if constexpr (FUSED) {
            pg8::EpiRmsRes E{a.out, a.x, a.npost_w, (float*)(a.ws + WS_ROWSS), (unsigned*)(a.ws + WS_PCNT)};
            pg8::gemm_phase<pg8::EpiRmsRes, pg8::StaticOrder, true, true>(lds, g, S, E);
        } else {
            pg8::EpiF32 E{(float*)(a.ws + WS_OUTPRE), DM};
            pg8::gemm_phase<pg8::EpiF32, pg8::StaticOrder, true, true>(lds, g, S, E);
            xcd_barrier(bar);
            phase_final(a, gw, NGW, lane);
        }
    }
#ifdef PROBE_K
    __syncthreads(); STAMP(7);
    if (blockIdx.x == 0 && tid == 0) { asm volatile("s_waitcnt vmcnt(0)" ::: "memory"); const float us_ = (float)(tsb[PROBE_K + 1] - tsb[PROBE_K]) * 0.01f; a.out[0] = 1000.f * floorf(us_ * (1.f / PROBE_BIN) + 0.5f); }
#endif
#undef IN
#undef SEAM
}

extern "C" void kernel_launch(void* const* d_in, const int* in_sizes, int n_in, void* d_out, int out_size, void* d_ws, size_t ws_size, hipStream_t stream) {
    static int grid = 0;
    if (grid == 0) {
        if (n_in != 11 || out_size != M * DM || ws_size < WS_END) { fprintf(stderr, "kernel_launch: unexpected shapes (n_in %d out %d ws %zu)\n", n_in, out_size, ws_size); grid = -1; return; }
        int dev = 0, cus = 0, per_cu = 0;
        (void)hipGetDevice(&dev); (void)hipDeviceGetAttribute(&cus, hipDeviceAttributeMultiprocessorCount, dev);
        const void* fn = (cus == 256) ? (const void*)hybrid_fwd<true> : (const void*)hybrid_fwd<false>;
        if (hipFuncSetAttribute(fn, hipFuncAttributeMaxDynamicSharedMemorySize, LDS_BYTES) != hipSuccess) { fprintf(stderr, "kernel_launch: hipFuncSetAttribute failed\n"); grid = -1; return; }
        if (hipOccupancyMaxActiveBlocksPerMultiprocessor(&per_cu, fn, NT, LDS_BYTES) != hipSuccess || per_cu < 1) { fprintf(stderr, "kernel_launch: occupancy query says %d\n", per_cu); per_cu = 1; }
        (void)hipGetLastError();
        grid = cus * 1;
        fprintf(stderr, "kernel_launch: cus %d per_cu %d grid %d\n", cus, per_cu, grid);
    }
    if (grid < 0) return;
    if (hipMemsetAsync(d_ws, 0, WS_ZERO_BYTES, stream) != hipSuccess) { fprintf(stderr, "kernel_launch: memset failed\n"); return; }
    Args a{};
    a.x = (const float*)d_in[0]; a.npw = (const float*)d_in[1]; a.w_in = (const float*)d_in[2]; a.conv_w = (const float*)d_in[3]; a.conv_b = (const float*)d_in[4];
    a.dt_bias = (const float*)d_in[5]; a.a_log = (const float*)d_in[6]; a.d_skip = (const float*)d_in[7]; a.ssm_nw = (const float*)d_in[8]; a.w_out = (const float*)d_in[9]; a.npost_w = (const float*)d_in[10];
    a.out = (float*)d_out; a.ws = (unsigned char*)d_ws;
#if ONE_LAUNCH
    a.ph_lo = 0; a.ph_hi = NPHASE;
    void* args[] = {&a};
    hipError_t e = hipLaunchCooperativeKernel((grid == 256) ? (const void*)hybrid_fwd<true> : (const void*)hybrid_fwd<false>, dim3(grid), dim3(NT), args, LDS_BYTES, stream);
    if (e != hipSuccess) fprintf(stderr, "cooperative launch failed: %s (grid %d)\n", hipGetErrorString(e), grid);
#else
    for (int p = 0; p < NPHASE; ++p) { a.ph_lo = p; a.ph_hi = p + 1; hipLaunchKernelGGL(hybrid_fwd<true>, dim3(grid), dim3(NT), LDS_BYTES, stream, a); }
#endif
}
```
